# Optimizing an MI355X kernel written in HIP

```python
import math
import jax, jax.numpy as jnp
from jax import lax
import numpy as np

D_MODEL = 2048
BATCH = 4
SEQ = 4096
DEPTH = 2

D_CONV = 512
N_CONV_GROUPS = 4
D_ATT = 1024
N_HEADS = 8
HEAD_DIM = 128
D_CFM = 512
N_CFM_GROUPS = 4
D_MIX = D_CONV + D_ATT + D_CFM
D_IN = 3 * D_CONV + 3 * D_ATT + 2 * D_CFM
SHORT_CONV_W = 3
CFM_CONV_W = 31
MOBA_BLOCK = 256
MOBA_TOPK = 3
Q_CHUNK = 64
N_GROUPS = 4
EXPERTS_PER_GROUP = 8
N_EXPERTS = N_GROUPS * EXPERTS_PER_GROUP
TOPK_IN_GROUP = 2
D_EXPERT = 512
ROW_BLOCK = 128
EPS = 1e-6
NEG = -1e30

kernel_name = 'hymba_parallel_conv_moba_conformer_hmoe'


def rmsnorm(x, g):
    x32 = x.astype(jnp.float32)
    y = x32 * lax.rsqrt(jnp.mean(x32 * x32, axis=-1, keepdims=True) + EPS)
    return (y * g.astype(jnp.float32)).astype(x.dtype)


def causal_depthwise_conv(x, w):
    width, ch = w.shape
    return lax.conv_general_dilated(
        x, w[:, None, :].astype(x.dtype), window_strides=(1,),
        padding=[(width - 1, 0)], dimension_numbers=('NWC', 'WIO', 'NWC'),
        feature_group_count=ch)


def alibi_slopes(n):
    return jnp.exp2(-8.0 * jnp.arange(1, n + 1, dtype=jnp.float32) / n)


def short_conv_mixer(u, conv_w):
    bg, cg, xv = jnp.split(u, 3, axis=-1)
    return bg * causal_depthwise_conv(cg * xv, conv_w)


def conformer_conv_mixer(u, conv_w, conv_b, ln_g, ln_b):
    a, gate = jnp.split(u, 2, axis=-1)
    h = a * jax.nn.sigmoid(gate)
    h = causal_depthwise_conv(h, conv_w) + conv_b.astype(h.dtype)
    h32 = h.astype(jnp.float32)
    mu = jnp.mean(h32, axis=-1, keepdims=True)
    var = jnp.mean(jnp.square(h32 - mu), axis=-1, keepdims=True)
    hn = (h32 - mu) * lax.rsqrt(var + EPS) * ln_g.astype(jnp.float32) + ln_b.astype(jnp.float32)
    return jax.nn.silu(hn).astype(u.dtype)


def moba_attention(q, k, v):
    bn, s, _ = q.shape
    nb = -(-s // MOBA_BLOCK)
    s_pad = nb * MOBA_BLOCK
    k_top = min(MOBA_TOPK, nb)
    n_chunks = s // Q_CHUNK

    def heads(t):
        return t.reshape(bn, s, N_HEADS, HEAD_DIM).transpose(0, 2, 1, 3)

    pad = ((0, 0), (0, 0), (0, s_pad - s), (0, 0))
    qh = heads(q) * (HEAD_DIM ** -0.5)
    kh = jnp.pad(heads(k), pad)
    vh = jnp.pad(heads(v), pad)
    kb = kh.reshape(bn, N_HEADS, nb, MOBA_BLOCK, HEAD_DIM)
    vb = vh.reshape(bn, N_HEADS, nb, MOBA_BLOCK, HEAD_DIM)
    kmean = jnp.mean(kb.astype(jnp.float32), axis=3)

    qblk = jnp.arange(s) // MOBA_BLOCK
    gate = jnp.einsum('bhsd,bhnd->bhsn', qh.astype(jnp.float32), kmean)
    fully_past = jnp.arange(nb)[None, :] < qblk[:, None]
    gate = jnp.where(fully_past, gate, NEG)
    _, sel = lax.top_k(gate, k_top)
    slopes = alibi_slopes(N_HEADS)

    def chunk(bc):
        b = bc // n_chunks
        t0 = (bc % n_chunks) * Q_CHUNK
        blk = t0 // MOBA_BLOCK
        qc = lax.dynamic_slice_in_dim(lax.dynamic_index_in_dim(qh, b, 0, False), t0, Q_CHUNK, 1)
        selc = lax.dynamic_slice_in_dim(lax.dynamic_index_in_dim(sel, b, 0, False), t0, Q_CHUNK, 1)
        kb_b = lax.dynamic_index_in_dim(kb, b, 0, False)
        vb_b = lax.dynamic_index_in_dim(vb, b, 0, False)
        gather = jax.vmap(lambda xh, ih: xh[ih])
        ks = gather(kb_b, selc)
        vs = gather(vb_b, selc)
        tpos = t0 + jnp.arange(Q_CHUNK)
        kpos = selc[..., None] * MOBA_BLOCK + jnp.arange(MOBA_BLOCK)
        valid = jnp.arange(k_top) < blk
        s_sel = jnp.einsum('hqd,hqrsd->hqrs', qc, ks).astype(jnp.float32)
        s_sel = s_sel - slopes[:, None, None, None] * (tpos[None, :, None, None] - kpos).astype(jnp.float32)
        s_sel = jnp.where(valid[None, None, :, None], s_sel, NEG)
        ko = lax.dynamic_slice_in_dim(lax.dynamic_index_in_dim(kh, b, 0, False), blk * MOBA_BLOCK, MOBA_BLOCK, 1)
        vo = lax.dynamic_slice_in_dim(lax.dynamic_index_in_dim(vh, b, 0, False), blk * MOBA_BLOCK, MOBA_BLOCK, 1)
        kpos_own = blk * MOBA_BLOCK + jnp.arange(MOBA_BLOCK)
        s_own = jnp.einsum('hqd,hsd->hqs', qc, ko).astype(jnp.float32)
        s_own = s_own - slopes[:, None, None] * (tpos[:, None] - kpos_own[None, :]).astype(jnp.float32)
        s_own = jnp.where(kpos_own[None, :] <= tpos[:, None], s_own, NEG)
        logits = jnp.concatenate([s_sel.reshape(N_HEADS, Q_CHUNK, k_top * MOBA_BLOCK), s_own], axis=-1)
        p = jax.nn.softmax(logits, axis=-1)
        p_sel = p[..., :k_top * MOBA_BLOCK].reshape(N_HEADS, Q_CHUNK, k_top, MOBA_BLOCK).astype(vs.dtype)
        p_own = p[..., k_top * MOBA_BLOCK:].astype(vo.dtype)
        return jnp.einsum('hqrs,hqrsd->hqd', p_sel, vs) + jnp.einsum('hqs,hsd->hqd', p_own, vo)

    o = lax.map(chunk, jnp.arange(bn * n_chunks))
    o = o.reshape(bn, n_chunks, N_HEADS, Q_CHUNK, HEAD_DIM).transpose(0, 1, 3, 2, 4)
    return o.reshape(bn, s, D_ATT)


def hierarchical_moe(x, rg_w, rg_b, re_w, re_b, w_gate, w_up, w_down):
    bn, s, d = x.shape
    t = bn * s
    xt = x.reshape(t, d)
    pg = jax.nn.softmax((xt @ rg_w).astype(jnp.float32) + rg_b.astype(jnp.float32), axis=-1)
    grp = jnp.argmax(pg, axis=-1)
    p_grp = jnp.take_along_axis(pg, grp[:, None], axis=1)[:, 0]
    le = ((xt @ re_w).astype(jnp.float32) + re_b.astype(jnp.float32)).reshape(t, N_GROUPS, EXPERTS_PER_GROUP)
    le_g = jnp.take_along_axis(le, grp[:, None, None], axis=1)[:, 0]
    q_top, e_top = lax.top_k(jax.nn.softmax(le_g, axis=-1), TOPK_IN_GROUP)
    gates = p_grp[:, None] * q_top / jnp.sum(q_top, axis=-1, keepdims=True)
    expert = grp[:, None] * EXPERTS_PER_GROUP + e_top

    n_assign = t * TOPK_IN_GROUP
    e_flat = expert.reshape(-1)
    g_flat = gates.reshape(-1)
    tok_flat = jnp.repeat(jnp.arange(t, dtype=jnp.int32), TOPK_IN_GROUP)
    order = jnp.argsort(e_flat)
    e_s, tok_s, g_s = e_flat[order], tok_flat[order], g_flat[order]
    counts = jnp.bincount(e_flat, length=N_EXPERTS)
    padded = (counts + ROW_BLOCK - 1) // ROW_BLOCK * ROW_BLOCK
    start = jnp.cumsum(counts) - counts
    end_p = jnp.cumsum(padded)
    start_p = end_p - padded
    dest = start_p[e_s] + (jnp.arange(n_assign) - start[e_s])
    n_rows = n_assign + N_EXPERTS * ROW_BLOCK
    n_blocks = n_rows // ROW_BLOCK
    row_tok = jnp.zeros((n_rows,), jnp.int32).at[dest].set(tok_s)
    row_w = jnp.zeros((n_rows,), jnp.float32).at[dest].set(g_s)
    blk_expert = jnp.clip(jnp.searchsorted(end_p, jnp.arange(n_blocks) * ROW_BLOCK, side='right'), 0, N_EXPERTS - 1)

    def expert_block(args):
        tok, e = args
        xb = xt[tok]
        h = jax.nn.silu(xb @ w_gate[e]) * (xb @ w_up[e])
        return h @ w_down[e]

    y = lax.map(expert_block, (row_tok.reshape(n_blocks, ROW_BLOCK), blk_expert))
    y = y.reshape(n_rows, d) * row_w[:, None].astype(y.dtype)
    out = jax.ops.segment_sum(y, row_tok, num_segments=t)
    return out.reshape(bn, s, d).astype(x.dtype)


def setup_inputs(seed: int = 0) -> dict:
    key = jax.random.key(seed)
    ks = jax.random.split(key, 20)
    L, D = DEPTH, D_MODEL

    def nrm(k, shape, scale):
        return jax.random.normal(k, shape, jnp.float32) * scale

    return {
        'x': nrm(ks[0], (BATCH, SEQ, D), 1.0),
        'norm1_g': 1.0 + nrm(ks[1], (L, D), 0.01),
        'w_in': nrm(ks[2], (L, D, D_IN), D ** -0.5),
        'conv_a_w': nrm(ks[3], (L, SHORT_CONV_W, D_CONV), SHORT_CONV_W ** -0.5),
        'conv_c_w': nrm(ks[4], (L, CFM_CONV_W, D_CFM), CFM_CONV_W ** -0.5),
        'conv_c_b': nrm(ks[5], (L, D_CFM), 0.01),
        'ln_c_g': 1.0 + nrm(ks[6], (L, D_CFM), 0.01),
        'ln_c_b': nrm(ks[7], (L, D_CFM), 0.01),
        'w_out': nrm(ks[8], (L, D_MIX, D), D_MIX ** -0.5),
        'norm2_g': 1.0 + nrm(ks[9], (L, D), 0.01),
        'router_g_w': nrm(ks[10], (L, D, N_GROUPS), D ** -0.5),
        'router_g_b': nrm(ks[11], (L, N_GROUPS), 0.01),
        'router_e_w': nrm(ks[12], (L, D, N_EXPERTS), D ** -0.5),
        'router_e_b': nrm(ks[13], (L, N_EXPERTS), 0.01),
        'w_gate': nrm(ks[14], (L, N_EXPERTS, D, D_EXPERT), D ** -0.5),
        'w_up': nrm(ks[15], (L, N_EXPERTS, D, D_EXPERT), D ** -0.5),
        'w_down': nrm(ks[16], (L, N_EXPERTS, D_EXPERT, D), D_EXPERT ** -0.5),
        'final_g': 1.0 + nrm(ks[17], (D,), 0.01),
    }


def reference(x, norm1_g, w_in, conv_a_w, conv_c_w, conv_c_b, ln_c_g, ln_c_b, w_out,
              norm2_g, router_g_w, router_g_b, router_e_w, router_e_b,
              w_gate, w_up, w_down, final_g):
    splits = [3 * D_CONV, 3 * D_CONV + D_ATT, 3 * D_CONV + 2 * D_ATT,
              3 * D_CONV + 3 * D_ATT]
    for l in range(DEPTH):
        h = rmsnorm(x, norm1_g[l])
        u = h @ w_in[l]
        u_a, u_q, u_k, u_v, u_c = jnp.split(u, splits, axis=-1)
        y_a = short_conv_mixer(u_a, conv_a_w[l])
        y_b = moba_attention(u_q, u_k, u_v)
        y_c = conformer_conv_mixer(u_c, conv_c_w[l], conv_c_b[l], ln_c_g[l], ln_c_b[l])
        x = x + jnp.concatenate([y_a, y_b, y_c], axis=-1) @ w_out[l]
        h = rmsnorm(x, norm2_g[l])
        x = x + hierarchical_moe(h, router_g_w[l], router_g_b[l], router_e_w[l], router_e_b[l],
                                 w_gate[l], w_up[l], w_down[l])
    return rmsnorm(x, final_g)
```

```cpp
#include <hip/hip_runtime.h>
#include <hip/hip_cooperative_groups.h>
#include <cstdio>
#include <cstdint>
namespace cg = cooperative_groups;

#ifndef MK_N_LAUNCHES
#define MK_N_LAUNCHES 1
#endif

#define LAS __attribute__((address_space(3)))
typedef unsigned short bf16_t;
typedef short bf16x8 __attribute__((ext_vector_type(8)));
typedef short s16x4 __attribute__((ext_vector_type(4)));
typedef float f32x2 __attribute__((ext_vector_type(2)));
typedef float f32x4 __attribute__((ext_vector_type(4)));
typedef float f32x16 __attribute__((ext_vector_type(16)));
typedef unsigned u32x2 __attribute__((ext_vector_type(2)));
typedef unsigned u32x4 __attribute__((ext_vector_type(4)));

constexpr int T_TOK = 16384, DM = 2048, DIN = 5632, SEQ = 4096, NBATCH = 4, NHEAD = 8, HD = 128, DEPTH = 2;
constexpr int COL_BG = 0, COL_CG = 512, COL_XV = 1024, COL_Q = 1536, COL_K = 2560, COL_V = 3584, COL_CA = 4608, COL_CGATE = 5120;
constexpr int NEXP = 32, DEXP = 512, NRW = 48;
constexpr int MAXTILES = 160;
constexpr float EPS = 1e-6f;
constexpr int NWAVES = 8, NTHREADS = 512;
constexpr int RING_BYTES = 131072, SCRATCH_BYTES = 147456, MISC_OFF = SCRATCH_BYTES, MISC_BYTES = 8192, LDS_BYTES = SCRATCH_BYTES + MISC_BYTES;

constexpr size_t MiB = 1u << 20;
constexpr size_t WS_CTL = 0;
constexpr size_t CTL_BYTES = 4096;
constexpr size_t SZ_WIN = (size_t)DIN * DM * 2, SZ_WOUT = (size_t)DM * DM * 2, SZ_WGU = (size_t)NEXP * 1024 * DM * 2, SZ_WD = (size_t)NEXP * DM * DEXP * 2, SZ_RW = (size_t)NRW * DM * 2;
constexpr size_t WS_W0 = 1 * MiB;
constexpr size_t OFF_WIN = 0, OFF_WOUT = OFF_WIN + SZ_WIN, OFF_WGU = OFF_WOUT + SZ_WOUT, OFF_WD = OFF_WGU + SZ_WGU, OFF_RW = OFF_WD + SZ_WD, SZ_LAYER = ((OFF_RW + SZ_RW + 4095) / 4096) * 4096;
constexpr size_t WS_U = WS_W0 + DEPTH * SZ_LAYER;
constexpr size_t SZ_U = (size_t)T_TOK * DIN * 2;
static_assert((size_t)MAXTILES * 256 * DM * 2 <= SZ_U, "ymoe overlays u");
constexpr size_t WS_Y = WS_U + SZ_U;
constexpr size_t WS_H = WS_Y + (size_t)T_TOK * DM * 2;
constexpr size_t WS_HM = WS_H + (size_t)T_TOK * DM * 2;
constexpr size_t WS_KS = WS_HM + (size_t)MAXTILES * 256 * DEXP * 2;
constexpr size_t WS_RS = WS_KS + (size_t)64 * 2 * 1024 * 4;
constexpr size_t WS_REC = WS_RS + (size_t)T_TOK * 4;
constexpr size_t WS_TM = WS_REC + (size_t)T_TOK * 32;
constexpr size_t WS_END = WS_TM + (size_t)NEXP * T_TOK * 4;

__device__ __forceinline__ unsigned cvt_pk_bf16(float lo, float hi) { unsigned r; asm volatile("v_cvt_pk_bf16_f32 %0, %1, %2" : "=v"(r) : "v"(lo), "v"(hi)); return r; }
__device__ __forceinline__ float bf_lo(unsigned w) { return __uint_as_float(w << 16); }
__device__ __forceinline__ float bf_hi(unsigned w) { return __uint_as_float(w & 0xffff0000u); }
__device__ __forceinline__ float wave_sum(float v) {
#pragma unroll
    for (int o = 1; o < 64; o <<= 1) v += __shfl_xor(v, o);
    return v;
}
__device__ __forceinline__ float fast_sigmoid(float x) { return __builtin_amdgcn_rcpf(1.f + __builtin_amdgcn_exp2f(-1.4426950408889634f * x)); }

namespace pg8 {
constexpr int BM = 256, BK = 64, HALF = 128, HTB = HALF * BK * 2, STAGE_BYTES = 8 * HTB, NXCD = 8, WGM = 8;
__host__ __device__ __forceinline__ int lds_byte(int r, int c) { const int st = (r >> 4) * 2 + (c >> 5), rr = r & 15, cc = c & 31, ob = rr * 64 + cc * 2; return st * 1024 + (ob ^ (((ob >> 9) & 1) << 5)); }
__host__ __device__ __forceinline__ void stage_rc(int b, int& R, int& C) { const int st = b / 1024, sb = b % 1024, swz = sb ^ (((sb >> 9) & 1) << 5); R = (st >> 1) * 16 + swz / 64; C = (st & 1) * 32 + (swz % 64) / 2; }
__host__ __device__ __forceinline__ int perm32(int rho) { const int n = rho >> 4, i = rho & 15; return 8 * (i >> 2) + 4 * n + (i & 3); }

struct Unit { int pm, pn, e; };

__device__ __forceinline__ bool order_next(int i, int G, int c, int nM, int nN, Unit& u) {
    const int nwg = nM * nN; const long L = (long)i * G + c; if (L >= nwg) return false;
    int wgid = (int)L; { const int q = nwg / NXCD, r = nwg % NXCD, xcd = wgid % NXCD, off = wgid / NXCD; wgid = (xcd < r ? xcd * (q + 1) : r * (q + 1) + (xcd - r) * q) + off; }
    const int nig = WGM * nN, gid = wgid / nig, fm = gid * WGM, gsz = (nM - fm) < WGM ? (nM - fm) : WGM;
    u.pm = fm + ((wgid % nig) % gsz); u.pn = (wgid % nig) / gsz; u.e = 0; return true;
}

struct DenseSched {
    const char* A; const char* Bt; int nM, nN, G, c, K;
    __device__ __forceinline__ bool next(int i, Unit& u) const { return order_next(i, G, c, nM, nN, u); }
    __device__ __forceinline__ const char* a_base(const Unit& u) const { return A + (size_t)u.pm * BM * K * 2; }
    __device__ __forceinline__ const char* b_base(const Unit& u) const { return Bt + (size_t)u.pn * BM * K * 2; }
    __device__ __forceinline__ void a_rows(const Unit&, const int (&RA)[2], const unsigned (&cofA)[2], unsigned (&g)[2][2]) const {
#pragma unroll
        for (int h = 0; h < 2; ++h)
#pragma unroll
            for (int i = 0; i < 2; ++i) g[h][i] = (unsigned)((h * HALF + RA[i]) * K) * 2u + cofA[i];
    }
};
struct MoeSched {
    const char* A; const char* Bt; size_t b_estride; int nM, nN, G, c, K; bool gather;
    const LAS int* tile_e; const LAS int* tstart; const LAS int* cnt; const int* tokmap;
    __device__ __forceinline__ bool next(int i, Unit& u) const { if (!order_next(i, G, c, nM, nN, u)) return false; u.e = tile_e[u.pm]; return true; }
    __device__ __forceinline__ const char* a_base(const Unit& u) const { return gather ? A : A + (size_t)u.pm * BM * K * 2; }
    __device__ __forceinline__ const char* b_base(const Unit& u) const { return Bt + (size_t)u.e * b_estride + (size_t)u.pn * BM * K * 2; }
    __device__ __forceinline__ void a_rows(const Unit& u, const int (&RA)[2], const unsigned (&cofA)[2], unsigned (&g)[2][2]) const {
        if (gather) {
            const int p0 = (u.pm - tstart[u.e]) * BM, cn = cnt[u.e];
#pragma unroll
            for (int h = 0; h < 2; ++h)
#pragma unroll
                for (int i = 0; i < 2; ++i) { int pos = p0 + h * HALF + RA[i]; pos = pos < cn ? pos : cn - 1; const int tok = tokmap[u.e * T_TOK + pos]; g[h][i] = (unsigned)(tok * K) * 2u + cofA[i]; }
        } else {
#pragma unroll
            for (int h = 0; h < 2; ++h)
#pragma unroll
                for (int i = 0; i < 2; ++i) g[h][i] = (unsigned)((h * HALF + RA[i]) * K) * 2u + cofA[i];
        }
    }
};

struct EpiInProj {
    static constexpr bool PERM = true;
    bf16_t* U; float* ksum;
    __device__ __forceinline__ void operator()(const f32x4 (&acc)[2][2][4][2], const Unit& u, int wr, int wc, int fr, int fq) const {
        const int row0 = u.pm * BM + wr * 64 + fr, col0 = u.pn * BM + wc * 32 + 8 * fq;
#pragma unroll
        for (int ai = 0; ai < 2; ++ai)
#pragma unroll
            for (int m = 0; m < 4; ++m) { bf16_t* rowp = U + (size_t)(row0 + ai * HALF + m * 16) * DIN + col0;
#pragma unroll
                for (int bj = 0; bj < 2; ++bj) { const f32x4 v0 = acc[ai][bj][m][0], v1 = acc[ai][bj][m][1]; u32x4 w;
                    w.x = cvt_pk_bf16(v0[0], v0[1]); w.y = cvt_pk_bf16(v0[2], v0[3]); w.z = cvt_pk_bf16(v1[0], v1[1]); w.w = cvt_pk_bf16(v1[2], v1[3]);
                    *(u32x4*)(rowp + bj * HALF) = w; } }
        if (u.pn >= COL_K / 256 && u.pn < COL_V / 256) {
            float* kp = ksum + (size_t)(u.pm * 2 + wr) * 1024 + (u.pn - COL_K / 256) * 256 + wc * 32 + 8 * fq;
#pragma unroll
            for (int bj = 0; bj < 2; ++bj)
#pragma unroll
                for (int n = 0; n < 2; ++n) { f32x4 s = (f32x4){0.f, 0.f, 0.f, 0.f};
#pragma unroll
                    for (int ai = 0; ai < 2; ++ai)
#pragma unroll
                        for (int m = 0; m < 4; ++m) s += acc[ai][bj][m][n];
#pragma unroll
                    for (int o = 1; o < 16; o <<= 1) { s[0] += __shfl_xor(s[0], o); s[1] += __shfl_xor(s[1], o); s[2] += __shfl_xor(s[2], o); s[3] += __shfl_xor(s[3], o); }
                    if (fr == 0) *(f32x4*)(kp + bj * HALF + 4 * n) = s; }
        }
    }
};
struct EpiResF32 {
    static constexpr bool PERM = false;
    const float* res; float* out;
    __device__ __forceinline__ void operator()(const f32x4 (&acc)[2][2][4][2], const Unit& u, int wr, int wc, int fr, int fq) const {
        const int row0 = u.pm * BM + wr * 64 + fr, col0 = u.pn * BM + wc * 32 + 4 * fq;
#pragma unroll
        for (int ai = 0; ai < 2; ++ai)
#pragma unroll
            for (int m = 0; m < 4; ++m) { const size_t off = (size_t)(row0 + ai * HALF + m * 16) * DM + col0;
#pragma unroll
                for (int bj = 0; bj < 2; ++bj)
#pragma unroll
                    for (int n = 0; n < 2; ++n) { const f32x4 r = *(const f32x4*)(res + off + bj * HALF + n * 16); *(f32x4*)(out + off + bj * HALF + n * 16) = r + acc[ai][bj][m][n]; } }
    }
};
struct EpiSwiglu {
    static constexpr bool PERM = true;
    bf16_t* HMo; const float* rs; const int* tokmap; const LAS int* tstart; const LAS int* cnt;
    __device__ __forceinline__ void operator()(const f32x4 (&acc)[2][2][4][2], const Unit& u, int wr, int wc, int fr, int fq) const {
        const int p0 = (u.pm - tstart[u.e]) * BM, cn = cnt[u.e];
#pragma unroll
        for (int ai = 0; ai < 2; ++ai)
#pragma unroll
            for (int m = 0; m < 4; ++m) { const int r = ai * HALF + wr * 64 + m * 16 + fr; int pos = p0 + r; pos = pos < cn ? pos : cn - 1;
                const float sc = rs[tokmap[u.e * T_TOK + pos]];
                bf16_t* rowp = HMo + (size_t)(u.pm * BM + r) * DEXP + ((u.pn * BM + wc * 32 + 8 * fq) >> 1);
#pragma unroll
                for (int bj = 0; bj < 2; ++bj) { const f32x4 v0 = acc[ai][bj][m][0] * sc, v1 = acc[ai][bj][m][1] * sc;
                    const float h0 = v0[0] * fast_sigmoid(v0[0]) * v0[1], h1 = v0[2] * fast_sigmoid(v0[2]) * v0[3], h2 = v1[0] * fast_sigmoid(v1[0]) * v1[1], h3 = v1[2] * fast_sigmoid(v1[2]) * v1[3];
                    u32x2 w; w.x = cvt_pk_bf16(h0, h1); w.y = cvt_pk_bf16(h2, h3); *(u32x2*)(rowp + bj * (HALF / 2)) = w; } }
    }
};
struct EpiBf16 {
    static constexpr bool PERM = true;
    bf16_t* O; int ldc;
    __device__ __forceinline__ void operator()(const f32x4 (&acc)[2][2][4][2], const Unit& u, int wr, int wc, int fr, int fq) const {
        const int row0 = u.pm * BM + wr * 64 + fr, col0 = u.pn * BM + wc * 32 + 8 * fq;
#pragma unroll
        for (int ai = 0; ai < 2; ++ai)
#pragma unroll
            for (int m = 0; m < 4; ++m) { bf16_t* rowp = O + (size_t)(row0 + ai * HALF + m * 16) * ldc + col0;
#pragma unroll
                for (int bj = 0; bj < 2; ++bj) { const f32x4 v0 = acc[ai][bj][m][0], v1 = acc[ai][bj][m][1]; u32x4 w;
                    w.x = cvt_pk_bf16(v0[0], v0[1]); w.y = cvt_pk_bf16(v0[2], v0[3]); w.z = cvt_pk_bf16(v1[0], v1[1]); w.w = cvt_pk_bf16(v1[2], v1[3]);
                    *(u32x4*)(rowp + bj * HALF) = w; } }
    }
};

template <class Epi, class Sched>
__device__ __forceinline__ void gemm_phase(LAS unsigned char* lds, const int tid, const int K, const Sched& S, const Epi& E) {
    const int wid = __builtin_amdgcn_readfirstlane(tid >> 6), lane = tid & 63, wr = wid >> 2, wc = wid & 3, fr = lane & 15, fq = lane >> 4;
    const int nt = K / BK;
    int RA[2]; unsigned cofA[2], voffB[2];
#pragma unroll
    for (int i = 0; i < 2; ++i) { int R, C; stage_rc(tid * 16 + i * 8192, R, C); const int Rb = Epi::PERM ? ((R & ~31) + perm32(R & 31)) : R;
        RA[i] = R; cofA[i] = (unsigned)C * 2u; voffB[i] = (unsigned)(Rb * K + C) * 2u; }
    const size_t kstep = (size_t)(BK * 2);
    const size_t hstep = (size_t)HALF * K * 2;
    const unsigned ldsw = (unsigned)wid * 1024u;
    const int aoff = lds_byte(wr * 64 + fr, fq * 8), boff = lds_byte(wc * 32 + fr, fq * 8);
#define PG8_SA(b, h) (((b) * 2 + (h)) * HTB)
#define PG8_SB(b, h) ((4 + (b) * 2 + (h)) * HTB)
#define PG8_STG(bufoff, gptr, v0, v1) do { \
        __builtin_amdgcn_global_load_lds((const unsigned*)((const char*)(gptr) + (v0)), (LAS unsigned*)(lds + (bufoff) + ldsw), 16, 0, 0); \
        __builtin_amdgcn_global_load_lds((const unsigned*)((const char*)(gptr) + (v1)), (LAS unsigned*)(lds + (bufoff) + ldsw + 8192), 16, 0, 0); } while (0)
#define PG8_LDA(dst, b, h) do { _Pragma("unroll") for (int m = 0; m < 4; ++m) _Pragma("unroll") for (int k = 0; k < 2; ++k) dst[m][k] = *(const LAS bf16x8*)(lds + PG8_SA(b, h) + aoff + m * 2048 + k * 1024); } while (0)
#define PG8_LDB(dst, b, h) do { _Pragma("unroll") for (int n = 0; n < 2; ++n) _Pragma("unroll") for (int k = 0; k < 2; ++k) dst[n][k] = *(const LAS bf16x8*)(lds + PG8_SB(b, h) + boff + n * 2048 + k * 1024); } while (0)
#define PG8_MMA(ai, bj, At, Bt) do { __builtin_amdgcn_s_setprio(1); _Pragma("unroll") for (int m = 0; m < 4; ++m) _Pragma("unroll") for (int n = 0; n < 2; ++n) _Pragma("unroll") for (int k = 0; k < 2; ++k) \
        acc[ai][bj][m][n] = __builtin_amdgcn_mfma_f32_16x16x32_bf16(Bt[n][k], At[m][k], acc[ai][bj][m][n], 0, 0, 0); __builtin_amdgcn_s_setprio(0); } while (0)
#define PG8_WAIT_V(n) asm volatile("s_waitcnt vmcnt(" #n ")" ::: "memory")
#define PG8_WAIT_L(n) asm volatile("s_waitcnt lgkmcnt(" #n ")" ::: "memory")
#define PG8_BAR __builtin_amdgcn_s_barrier()
#define PG8_SCHED __builtin_amdgcn_sched_barrier(0)
    Unit cur, nxt; int ui = 0;
    if (!S.next(0, cur)) return;
    f32x4 acc[2][2][4][2];
#pragma unroll
    for (int a = 0; a < 2; ++a)
#pragma unroll
        for (int b = 0; b < 2; ++b)
#pragma unroll
            for (int m = 0; m < 4; ++m)
#pragma unroll
                for (int n = 0; n < 2; ++n) acc[a][b][m][n] = (f32x4){0.f, 0.f, 0.f, 0.f};
    bf16x8 At[4][2], B0[2][2], B1[2][2];
    const char* cA = S.a_base(cur); const char* cB = S.b_base(cur);
    unsigned gc[2][2], gn[2][2];
    S.a_rows(cur, RA, cofA, gc);
    PG8_STG(PG8_SB(0, 0), cB, voffB[0], voffB[1]); PG8_STG(PG8_SB(0, 1), cB + hstep, voffB[0], voffB[1]); PG8_STG(PG8_SA(0, 0), cA, gc[0][0], gc[0][1]); PG8_STG(PG8_SA(0, 1), cA, gc[1][0], gc[1][1]);
    if (wr == 1) PG8_BAR;
    PG8_WAIT_V(2); PG8_BAR;
    PG8_STG(PG8_SB(1, 0), cB + kstep, voffB[0], voffB[1]); PG8_STG(PG8_SA(1, 0), cA + kstep, gc[0][0], gc[0][1]); PG8_STG(PG8_SB(1, 1), cB + hstep + kstep, voffB[0], voffB[1]);
    PG8_WAIT_V(6); PG8_BAR;
    for (;;) {
        const bool has_next = S.next(ui + 1, nxt);
        const char* nA = has_next ? S.a_base(nxt) : cA; const char* nB = has_next ? S.b_base(nxt) : cB;
        if (has_next) S.a_rows(nxt, RA, cofA, gn);
        else { gn[0][0] = gc[0][0]; gn[0][1] = gc[0][1]; gn[1][0] = gc[1][0]; gn[1][1] = gc[1][1]; }
        for (int t = 0; t < nt; t += 2) {
            const bool last = (t == nt - 2);
            const char* a1 = cA + (size_t)(t + 1) * kstep;
            const char* a2 = last ? nA : cA + (size_t)(t + 2) * kstep; const char* b2 = last ? nB : cB + (size_t)(t + 2) * kstep;
            const char* a3 = a2 + kstep; const char* b3 = b2 + kstep;
            const unsigned g00 = last ? gn[0][0] : gc[0][0], g01 = last ? gn[0][1] : gc[0][1], g10 = last ? gn[1][0] : gc[1][0], g11 = last ? gn[1][1] : gc[1][1];
            PG8_LDB(B0, 0, 0); PG8_LDB(B1, 0, 1); PG8_SCHED; PG8_LDA(At, 0, 0); PG8_STG(PG8_SA(1, 1), a1, gc[1][0], gc[1][1]);
            PG8_WAIT_V(8); PG8_WAIT_L(0); PG8_BAR; PG8_MMA(0, 0, At, B0); PG8_MMA(0, 1, At, B1); PG8_BAR; PG8_SCHED;
            PG8_LDA(At, 0, 1); PG8_STG(PG8_SB(0, 0), b2, voffB[0], voffB[1]); PG8_STG(PG8_SB(0, 1), b2 + hstep, voffB[0], voffB[1]); PG8_STG(PG8_SA(0, 0), a2, g00, g01);
            PG8_WAIT_V(8); PG8_WAIT_L(0); PG8_BAR; PG8_MMA(1, 0, At, B0); PG8_MMA(1, 1, At, B1); PG8_BAR; PG8_SCHED;
            PG8_LDB(B0, 1, 0); PG8_LDB(B1, 1, 1); PG8_SCHED; PG8_LDA(At, 1, 0); PG8_STG(PG8_SA(0, 1), a2, g10, g11);
            PG8_WAIT_V(8); PG8_WAIT_L(0); PG8_BAR; PG8_MMA(0, 0, At, B0); PG8_MMA(0, 1, At, B1); PG8_BAR; PG8_SCHED;
            PG8_LDA(At, 1, 1); PG8_STG(PG8_SB(1, 0), b3, voffB[0], voffB[1]); PG8_STG(PG8_SB(1, 1), b3 + hstep, voffB[0], voffB[1]); PG8_STG(PG8_SA(1, 0), a3, g00, g01);
            PG8_WAIT_V(8); PG8_WAIT_L(0); PG8_BAR; PG8_MMA(1, 0, At, B0); PG8_MMA(1, 1, At, B1); PG8_BAR; PG8_SCHED;
        }
        if (wr == 0) PG8_BAR;
        E(acc, cur, wr, wc, fr, fq);
        if (!has_next) break;
#pragma unroll
        for (int a = 0; a < 2; ++a)
#pragma unroll
            for (int b = 0; b < 2; ++b)
#pragma unroll
                for (int m = 0; m < 4; ++m)
#pragma unroll
                    for (int n = 0; n < 2; ++n) acc[a][b][m][n] = (f32x4){0.f, 0.f, 0.f, 0.f};
        cur = nxt; cA = nA; cB = nB; gc[0][0] = gn[0][0]; gc[0][1] = gn[0][1]; gc[1][0] = gn[1][0]; gc[1][1] = gn[1][1]; ++ui;
        if (wr == 1) PG8_BAR;
    }
    PG8_WAIT_V(0);
    PG8_BAR;
#undef PG8_SA
#undef PG8_SB
#undef PG8_STG
#undef PG8_LDA
#undef PG8_LDB
#undef PG8_MMA
#undef PG8_WAIT_V
#undef PG8_WAIT_L
#undef PG8_BAR
#undef PG8_SCHED
}
}

namespace att {
constexpr float SCALE = 0.088388347648318440f;
constexpr float THR = 8.f;
constexpr int KVBLK = 64, QBLK = 32;
constexpr size_t SHM_V = KVBLK * HD * 2, SHM_K = KVBLK * HD * 2;
constexpr int OFF_V = 0, OFF_K = 2 * SHM_V, OFF_WS = OFF_K + 2 * SHM_K, OFF_KM = OFF_WS + NWAVES * 64 * 4, OFF_Q = OFF_KM + 32 * 256, ATT_LDS = OFF_Q + 256 * 256;
#define KSWZ(row, colB) ((row) * 256 + ((colB) ^ (((row) & 7) << 4)))
#define SBAR() __builtin_amdgcn_sched_barrier(0)
__device__ __forceinline__ int crow(int r, int hi) { return (r & 3) + 8 * (r >> 2) + 4 * hi; }

__device__ __forceinline__ void partialSM(f32x16& p0, f32x16& p1, float& m_reg, float& mn, float& alpha, float slr, float lb, int mode, int thr) {
    constexpr float C = SCALE * 1.4426950408889634f;
#pragma unroll
    for (int r = 0; r < 16; ++r) { const float cr = (float)((r & 3) + 8 * (r >> 2)); p0[r] = fmaf(slr, cr, p0[r]); p1[r] = fmaf(slr, cr + 32.f, p1[r]); }
    if (mode) {
        if (mode == 1) {
#pragma unroll
            for (int r = 0; r < 16; ++r) { if ((r & 3) + 8 * (r >> 2) > thr) p0[r] = -3.0e38f; p1[r] = -3.0e38f; }
        } else {
#pragma unroll
            for (int r = 0; r < 16; ++r) { if ((r & 3) + 8 * (r >> 2) > thr) p1[r] = -3.0e38f; }
        }
    }
    float pmax = p0[0];
#pragma unroll
    for (int r = 1; r < 16; ++r) pmax = fmaxf(pmax, p0[r]);
#pragma unroll
    for (int r = 0; r < 16; ++r) pmax = fmaxf(pmax, p1[r]);
    pmax += lb;
    { auto rr = __builtin_amdgcn_permlane32_swap(__float_as_uint(pmax), __float_as_uint(pmax), false, false);
      pmax = fmaxf(__uint_as_float(rr[0]), __uint_as_float(rr[1])); }
    if (__builtin_expect(__all(pmax - m_reg <= THR / SCALE), 1)) { mn = m_reg; alpha = 1.f; }
    else { mn = fmaxf(m_reg, pmax); alpha = __builtin_amdgcn_exp2f((m_reg - mn) * C); m_reg = mn; }
    const float mnC = (lb - mn) * C;
#pragma unroll
    for (int r = 0; r < 16; ++r) p0[r] = fmaf(p0[r], C, mnC);
#pragma unroll
    for (int r = 0; r < 16; ++r) p1[r] = fmaf(p1[r], C, mnC);
#pragma unroll
    for (int r = 0; r < 16; ++r) p0[r] = __builtin_amdgcn_exp2f(p0[r]);
}
__device__ __forceinline__ void finishSM(f32x16& p0, f32x16& p1, float alpha, float& l_reg, bf16x8& pa0, bf16x8& pa1, bf16x8& pa2, bf16x8& pa3) {
#pragma unroll
    for (int r = 0; r < 16; ++r) p1[r] = __builtin_amdgcn_exp2f(p1[r]);
    float ps = 0;
#pragma unroll
    for (int r = 0; r < 16; ++r) ps += p0[r];
#pragma unroll
    for (int r = 0; r < 16; ++r) ps += p1[r];
    { auto rr = __builtin_amdgcn_permlane32_swap(__float_as_uint(ps), __float_as_uint(ps), false, false);
      ps = __uint_as_float(rr[0]) + __uint_as_float(rr[1]); }
    l_reg = l_reg * alpha + ps;
#define PK4(P, BASE, OUT) do { unsigned a0 = cvt_pk_bf16(P[BASE + 0], P[BASE + 1]), a1 = cvt_pk_bf16(P[BASE + 2], P[BASE + 3]);   \
    unsigned b0 = cvt_pk_bf16(P[BASE + 4], P[BASE + 5]), b1 = cvt_pk_bf16(P[BASE + 6], P[BASE + 7]);                              \
    auto r0 = __builtin_amdgcn_permlane32_swap(a0, b0, false, false); auto r1 = __builtin_amdgcn_permlane32_swap(a1, b1, false, false); \
    u32x4 w = {r0[0], r1[0], r0[1], r1[1]}; OUT = *reinterpret_cast<bf16x8*>(&w); } while (0)
    PK4(p0, 0, pa0); PK4(p0, 8, pa1); PK4(p1, 0, pa2); PK4(p1, 8, pa3);
#undef PK4
}
__device__ __forceinline__ void qkt(f32x16& p0, f32x16& p1, const char* Ks, const char* Qs, int qrow, int r32, int hi) {
    p0 = f32x16{}; p1 = f32x16{};
#pragma unroll
    for (int d0 = 0; d0 < 8; ++d0) { const int cb = (d0 * 16 + hi * 8) * 2;
        const bf16x8 b0 = *reinterpret_cast<const bf16x8*>(Ks + KSWZ(r32, cb));
        const bf16x8 b1 = *reinterpret_cast<const bf16x8*>(Ks + KSWZ(32 + r32, cb));
        const bf16x8 q = *reinterpret_cast<const bf16x8*>(Qs + KSWZ(qrow, cb));
        p0 = __builtin_amdgcn_mfma_f32_32x32x16_bf16(b0, q, p0, 0, 0, 0);
        p1 = __builtin_amdgcn_mfma_f32_32x32x16_bf16(b1, q, p1, 0, 0, 0); }
}
__device__ __forceinline__ int v_st(int k, int c) { const int kk = (k & ~0xC) | ((k & 4) << 1) | ((k & 8) >> 1); return ((kk >> 3) * 4 + (c >> 5)) * 512 + ((kk & 7) * 32 + (c & 31)) * 2; }
__device__ __forceinline__ int v_rd_base(int lane) { return ((lane & 3) << 3) | (((lane >> 2) & 3) << 6) | (((lane >> 4) & 1) << 5) | (((lane >> 5) & 1) << 8); }
constexpr int v_rd_off(int d0, int ks, int half) { return d0 * 512 + ks * 4096 + half * 2048; }
template <int OFF> __device__ __forceinline__ s16x4 tr_read(int vb) {
    s16x4 r; asm volatile("ds_read_b64_tr_b16 %0, %1 offset:%2" : "=&v"(r) : "v"(vb), "i"(OFF) : "memory"); return r;
}
template <int D0> __device__ __forceinline__ void pv_one(f32x16& od, int vb, bf16x8 pa0, bf16x8 pa1, bf16x8 pa2, bf16x8 pa3) {
    const s16x4 l0 = tr_read<v_rd_off(D0, 0, 0)>(vb), h0 = tr_read<v_rd_off(D0, 0, 1)>(vb), l1 = tr_read<v_rd_off(D0, 1, 0)>(vb), h1 = tr_read<v_rd_off(D0, 1, 1)>(vb);
    const s16x4 l2 = tr_read<v_rd_off(D0, 2, 0)>(vb), h2 = tr_read<v_rd_off(D0, 2, 1)>(vb), l3 = tr_read<v_rd_off(D0, 3, 0)>(vb), h3 = tr_read<v_rd_off(D0, 3, 1)>(vb);
    asm volatile("s_waitcnt lgkmcnt(0)" ::: "memory"); SBAR();
#define PK(L, H) (bf16x8){L[0], L[1], L[2], L[3], H[0], H[1], H[2], H[3]}
    od = __builtin_amdgcn_mfma_f32_32x32x16_bf16(pa0, PK(l0, h0), od, 0, 0, 0);
    od = __builtin_amdgcn_mfma_f32_32x32x16_bf16(pa1, PK(l1, h1), od, 0, 0, 0);
    od = __builtin_amdgcn_mfma_f32_32x32x16_bf16(pa2, PK(l2, h2), od, 0, 0, 0);
    od = __builtin_amdgcn_mfma_f32_32x32x16_bf16(pa3, PK(l3, h3), od, 0, 0, 0);
#undef PK
}
__device__ __forceinline__ void pv_d0(f32x16* o, int vb, bf16x8 pa0, bf16x8 pa1, bf16x8 pa2, bf16x8 pa3) {
    pv_one<0>(o[0], vb, pa0, pa1, pa2, pa3); pv_one<1>(o[1], vb, pa0, pa1, pa2, pa3); pv_one<2>(o[2], vb, pa0, pa1, pa2, pa3); pv_one<3>(o[3], vb, pa0, pa1, pa2, pa3);
}

__device__ __forceinline__ void attn_unit(const int tid, const int b, const int h, const int qb, const bf16_t* __restrict__ U, const float* __restrict__ ksum, bf16_t* __restrict__ Y, char* lds) {
    const int wid = tid >> 6, lane = tid & 63, r32 = lane & 31, hi = lane >> 5;
    char* V_lds = lds + OFF_V; char* K_lds = lds + OFF_K; char* KM = lds + OFF_KM;
    float* ws = (float*)(lds + OFF_WS) + wid * 64; float* li_l = ws; float* al_l = ws + 32;
    const bf16_t* Qb = U + (size_t)(b * SEQ + qb * 256) * DIN + COL_Q + h * HD;
    const bf16_t* Kh = U + (size_t)(b * SEQ) * DIN + COL_K + h * HD;
    const bf16_t* Vh = U + (size_t)(b * SEQ) * DIN + COL_V + h * HD;
    float m_reg = -1e30f, l_reg = 0; f32x16 o[4] = {};
    char* Q_lds = lds + OFF_Q; const int qrow = wid * QBLK + r32;
    { const int qr0 = tid >> 4, qc = (tid & 15) * 8;
#pragma unroll
      for (int i = 0; i < 8; ++i) { const int row = qr0 + 32 * i; *(bf16x8*)(Q_lds + KSWZ(row, qc * 2)) = *reinterpret_cast<const bf16x8*>(Qb + (size_t)row * DIN + qc); } }
    { const int n = tid >> 5, c4 = (tid & 31) * 4;
      const float* k0p = ksum + (size_t)((b * 16 + n) * 2) * 1024 + h * HD + c4;
      const f32x4 s0 = *(const f32x4*)k0p, s1 = *(const f32x4*)(k0p + 1024);
      u32x2 w; w.x = cvt_pk_bf16((s0[0] + s1[0]) * (1.f / 256.f), (s0[1] + s1[1]) * (1.f / 256.f)); w.y = cvt_pk_bf16((s0[2] + s1[2]) * (1.f / 256.f), (s0[3] + s1[3]) * (1.f / 256.f));
      *(u32x2*)(KM + KSWZ(n, c4 * 2)) = w;
      *(u32x2*)(KM + KSWZ(16 + n, c4 * 2)) = (u32x2){0u, 0u}; }
    __syncthreads();
    unsigned selmask = 0u;
    { f32x16 g = f32x16{};
#pragma unroll
      for (int d0 = 0; d0 < 8; ++d0) { const int cb = (d0 * 16 + hi * 8) * 2; const bf16x8 a = *reinterpret_cast<const bf16x8*>(KM + KSWZ(r32, cb)); const bf16x8 q = *reinterpret_cast<const bf16x8*>(Q_lds + KSWZ(qrow, cb)); g = __builtin_amdgcn_mfma_f32_32x32x16_bf16(a, q, g, 0, 0, 0); }
      float G[16];
#pragma unroll
      for (int r = 0; r < 8; ++r) { auto rr = __builtin_amdgcn_permlane32_swap(__float_as_uint(g[r]), __float_as_uint(g[r]), false, false);
          const float other = hi ? __uint_as_float(rr[0]) : __uint_as_float(rr[1]);
          const int nlo = (r & 3) + 8 * (r >> 2);
          G[nlo] = hi ? other : g[r]; G[nlo + 4] = hi ? g[r] : other; }
#pragma unroll
      for (int n = 0; n < 16; ++n) if (n >= qb) G[n] = -INFINITY;
      const int npick = qb < 3 ? qb : 3;
#pragma unroll
      for (int it = 0; it < 3; ++it) { if (it < npick) { float best = G[0]; int bi = 0;
#pragma unroll
          for (int n = 1; n < 16; ++n) if (G[n] > best) { best = G[n]; bi = n; }
          selmask |= 1u << bi;
#pragma unroll
          for (int n = 0; n < 16; ++n) if (n == bi) G[n] = -INFINITY; } } }
    const float slope = __builtin_amdgcn_exp2f(-(float)(h + 1)), slr = slope * (1.f / SCALE);
    const int qi = wid * QBLK + r32, tpos = qb * 256 + qi;
    const int NT = 4 * (qb + 1);
#define KST(j) ((j) < 4 ? qb * 256 + 64 * (j) : 64 * ((j) - 4))
#define LBV(j) ((j) < 4 ? ((j) > (wid >> 1) ? -1e30f : slr * (float)(64 * (j) + 4 * hi - qi)) : (((selmask >> (((j) - 4) >> 2)) & 1u) ? slr * (float)(64 * ((j) - 4) + 4 * hi - tpos) : -1e30f))
    const int vb0 = (int)(uintptr_t)V_lds + v_rd_base(lane);
    unsigned koff[2], voff[2];
#pragma unroll
    for (int i = 0; i < 2; ++i) { const int pc = wid * 2 + i;
        { const int row = 4 * pc + (lane >> 4), cc = lane & 15; koff[i] = (unsigned)(row * DIN * 2 + ((cc ^ (row & 7)) << 4)); }
        { const int st = 2 * pc + (lane >> 5), kk = (st >> 2) * 8 + ((lane & 31) >> 2), k = (kk & ~0xC) | ((kk & 4) << 1) | ((kk & 8) >> 1), col = 32 * (st & 3) + 8 * (lane & 3);
          voff[i] = (unsigned)(k * DIN * 2 + col * 2); } }
    const int wq = __builtin_amdgcn_readfirstlane(wid);
    LAS unsigned char* ldsL = (LAS unsigned char*)(unsigned)(uintptr_t)lds;
#define DMA(bb, k0) do { const char* kg = (const char*)(Kh + (size_t)(k0) * DIN); const char* vg = (const char*)(Vh + (size_t)(k0) * DIN); \
    _Pragma("unroll") for (int i_ = 0; i_ < 2; ++i_) { \
        __builtin_amdgcn_global_load_lds((const unsigned*)(kg + koff[i_]), (LAS unsigned*)(ldsL + OFF_K + (bb) * SHM_K + (wq * 2 + i_) * 1024), 16, 0, 0); \
        __builtin_amdgcn_global_load_lds((const unsigned*)(vg + voff[i_]), (LAS unsigned*)(ldsL + OFF_V + (bb) * SHM_V + (wq * 2 + i_) * 1024), 16, 0, 0); } } while (0)
#define DWAIT() do { asm volatile("s_waitcnt vmcnt(0)" ::: "memory"); __syncthreads(); } while (0)
#define RESC(a) do { if (__any((a) < 1.f)) { if (hi == 0) al_l[r32] = (a); asm volatile("s_waitcnt lgkmcnt(0)" ::: "memory"); \
    _Pragma("unroll") for (int d = 0; d < 4; ++d) _Pragma("unroll") for (int r = 0; r < 16; ++r) o[d][r] *= al_l[crow(r, hi)]; } } while (0)
    f32x16 p0, p1; float mn, al; bf16x8 pa0, pa1, pa2, pa3;
#define TILE(j, bb) do { SBAR(); qkt(p0, p1, K_lds + (bb) * SHM_K, Q_lds, qrow, r32, hi); \
        partialSM(p0, p1, m_reg, mn, al, slr, LBV(j), ((j) == (wid >> 1)) ? 1 + (wid & 1) : 0, r32 - 4 * hi); RESC(al); \
        finishSM(p0, p1, al, l_reg, pa0, pa1, pa2, pa3); SBAR(); \
        pv_d0(o, vb0 + (bb) * (int)SHM_V, pa0, pa1, pa2, pa3); } while (0)
    DMA(0, KST(0)); DWAIT();
    for (int j = 0; j < NT; j += 2) {
        DMA(1, KST(j + 1));
        TILE(j, 0);
        DWAIT();
        if (j + 2 < NT) DMA(0, KST(j + 2));
        TILE(j + 1, 1);
        DWAIT();
    }
#undef TILE
    if (hi == 0) li_l[r32] = l_reg; asm volatile("s_waitcnt lgkmcnt(0)" ::: "memory");
    float rli[16];
#pragma unroll
    for (int r = 0; r < 16; ++r) rli[r] = __builtin_amdgcn_rcpf(li_l[crow(r, hi)]);
    bf16_t* Ow = Y + (size_t)(b * SEQ + qb * 256 + wid * QBLK) * DM + 512 + h * HD;
#pragma unroll
    for (int r = 0; r < 16; ++r) { const int orow = crow(r, hi);
#pragma unroll
        for (int d0 = 0; d0 < 4; ++d0) { const float v = o[d0][r] * rli[r]; Ow[(size_t)orow * DM + d0 * 32 + r32] = (bf16_t)(cvt_pk_bf16(v, v) & 0xffffu); } }
    __syncthreads();
#undef KST
#undef LBV
#undef DMA
#undef DWAIT
#undef RESC
}
#undef KSWZ
#undef SBAR
}

struct Params { const float* in[18]; float* out; unsigned char* ws; int ph_lo, ph_hi; };
enum { IN_X = 0, IN_N1G, IN_WIN, IN_CAW, IN_CCW, IN_CCB, IN_LNG, IN_LNB, IN_WOUT, IN_N2G, IN_RGW, IN_RGB, IN_REW, IN_REB, IN_WG, IN_WU, IN_WD, IN_FG };

__device__ __forceinline__ void transpose_item(const float* __restrict__ W, int K, int N, bf16_t* __restrict__ WT, size_t dstb, int rmul, int radd, const float* __restrict__ scale,
                                               LAS float* scr, int item, int lane) {
    const int nkb = K / 64, nnb = N / 64, per = nkb * nnb, bt = item / per, rem = item - bt * per, kb = rem / nnb, nb = rem - kb * nnb, k0 = kb * 64, n0 = nb * 64;
    const float* src = W + (size_t)bt * K * N;
    bf16_t* dst = WT + (size_t)bt * dstb;
#pragma unroll 4
    for (int i = 0; i < 16; ++i) { const int k = 4 * i + (lane >> 4), n4 = (lane & 15) * 4; const f32x4 v = *(const f32x4*)(src + (size_t)(k0 + k) * N + n0 + n4);
        LAS float* s = scr + k * 65 + n4; s[0] = v[0]; s[1] = v[1]; s[2] = v[2]; s[3] = v[3]; }
    asm volatile("s_waitcnt lgkmcnt(0)" ::: "memory");
    const int c = lane & 7, nn = lane >> 3;
    float sc8[8];
#pragma unroll
    for (int i = 0; i < 8; ++i) sc8[i] = scale ? scale[k0 + 8 * c + i] : 1.f;
#pragma unroll
    for (int j = 0; j < 8; ++j) { const int n = nn + 8 * j; const LAS float* s = scr + (8 * c) * 65 + n;
        u32x4 o; o.x = cvt_pk_bf16(s[0] * sc8[0], s[65] * sc8[1]); o.y = cvt_pk_bf16(s[130] * sc8[2], s[195] * sc8[3]); o.z = cvt_pk_bf16(s[260] * sc8[4], s[325] * sc8[5]); o.w = cvt_pk_bf16(s[390] * sc8[6], s[455] * sc8[7]);
        *(u32x4*)(dst + (size_t)((n0 + n) * rmul + radd) * K + k0 + 8 * c) = o; }
    asm volatile("s_waitcnt lgkmcnt(0)" ::: "memory");
}

__device__ __forceinline__ void norm_row(const float* __restrict__ xrow, const bf16_t* __restrict__ y0, float g0, const bf16_t* __restrict__ y1, float g1, float* __restrict__ xout,
                                         bf16_t* __restrict__ hout, float* __restrict__ fout, const float* __restrict__ fgain, int lane) {
    f32x4 v[8]; float ss = 0.f;
#pragma unroll
    for (int j = 0; j < 8; ++j) { v[j] = *((const f32x4*)xrow + 64 * j + lane);
        if (y0) { const u32x2 a = *((const u32x2*)y0 + 64 * j + lane), c = *((const u32x2*)y1 + 64 * j + lane);
            v[j][0] += g0 * bf_lo(a.x) + g1 * bf_lo(c.x); v[j][1] += g0 * bf_hi(a.x) + g1 * bf_hi(c.x); v[j][2] += g0 * bf_lo(a.y) + g1 * bf_lo(c.y); v[j][3] += g0 * bf_hi(a.y) + g1 * bf_hi(c.y); }
        ss += (v[j][0] * v[j][0] + v[j][1] * v[j][1]) + (v[j][2] * v[j][2] + v[j][3] * v[j][3]); }
    const float rs = 1.0f / sqrtf(wave_sum(ss) * (1.f / DM) + EPS);
#pragma unroll
    for (int j = 0; j < 8; ++j) {
        if (xout) *((f32x4*)xout + 64 * j + lane) = v[j];
        if (fout) { const f32x4 g = *((const f32x4*)fgain + 64 * j + lane); *((f32x4*)fout + 64 * j + lane) = v[j] * rs * g; }
        else { u32x2 w; w.x = cvt_pk_bf16(v[j][0] * rs, v[j][1] * rs); w.y = cvt_pk_bf16(v[j][2] * rs, v[j][3] * rs); *((u32x2*)hout + 64 * j + lane) = w; } }
}

__global__ void __launch_bounds__(NTHREADS, 2) fwd_kernel(Params p) {
    extern __shared__ __attribute__((aligned(16))) unsigned char lds_raw[];
    LAS unsigned char* lds = (LAS unsigned char*)lds_raw;
    cg::grid_group grid = cg::this_grid();
    const int G = gridDim.x, bx = blockIdx.x;
    const int lo = p.ph_lo, hi = p.ph_hi;
    int ph = 0;
#ifndef PH_MASK
#define PH_MASK 0x7f
#endif
#define PHASE_BEGIN(k) if (((PH_MASK >> (k)) & 1) && lo <= ph && ph < hi) { \
    int tid = threadIdx.x; asm volatile("" : "+v"(tid)); unsigned char* ws = p.ws; asm volatile("" : "+s"(ws)); ws = (unsigned char*)(__attribute__((address_space(1))) unsigned char*)ws; \
    const int lane = tid & 63, wave = __builtin_amdgcn_readfirstlane(tid >> 6); \
    const int vcu = (G % 8 == 0) ? (bx % 8) * (G / 8) + bx / 8 : bx; const int gw = vcu * NWAVES + wave, NGW = G * NWAVES; \
    bf16_t* const Ub = (bf16_t*)(ws + WS_U); bf16_t* const YM = (bf16_t*)(ws + WS_U); bf16_t* const Yc = (bf16_t*)(ws + WS_Y); bf16_t* const Hb = (bf16_t*)(ws + WS_H); \
    bf16_t* const HMb = (bf16_t*)(ws + WS_HM); float* const KS = (float*)(ws + WS_KS); float* const RS = (float*)(ws + WS_RS); unsigned* const REC = (unsigned*)(ws + WS_REC); \
    int* const TM = (int*)(ws + WS_TM); int* const CNT = (int*)(ws + WS_CTL); float* const XR = p.out; \
    LAS int* const m_tile_e = (LAS int*)(lds + MISC_OFF); LAS int* const m_tstart = m_tile_e + MAXTILES; LAS int* const m_cnt = m_tstart + 40; \
    unsigned char* const wl = ws + WS_W0 + (size_t)l * SZ_LAYER; int* const cntg = CNT + l * 32; \
    (void)lane; (void)wave; (void)gw; (void)NGW; (void)Ub; (void)YM; (void)Yc; (void)Hb; (void)HMb; (void)KS; (void)RS; (void)REC; (void)TM; (void)XR; (void)m_tile_e; (void)m_tstart; (void)m_cnt; (void)wl; (void)cntg;
#define PHASE_END   if (ph + 1 < hi) grid.sync(); } ++ph;

    { const int l = 0;
    PHASE_BEGIN(0)
    {
        LAS float* scr = (LAS float*)(lds + wave * 16640);
        for (int l = 0; l < DEPTH; ++l) {
            unsigned char* wl = ws + WS_W0 + (size_t)l * SZ_LAYER;
            constexpr int I_IN = (DM / 64) * (DIN / 64), I_OUT = (DM / 64) * (DM / 64), I_G = NEXP * (DM / 64) * (DEXP / 64), I_D = NEXP * (DEXP / 64) * (DM / 64), I_ALL = I_IN + I_OUT + 2 * I_G + I_D;
            for (int it = gw; it < I_ALL; it += NGW) {
                int r = it;
                if (r < I_IN) { transpose_item(p.in[IN_WIN] + (size_t)l * DM * DIN, DM, DIN, (bf16_t*)(wl + OFF_WIN), 0, 1, 0, p.in[IN_N1G] + l * DM, scr, r, lane); continue; } r -= I_IN;
                if (r < I_OUT) { transpose_item(p.in[IN_WOUT] + (size_t)l * DM * DM, DM, DM, (bf16_t*)(wl + OFF_WOUT), 0, 1, 0, nullptr, scr, r, lane); continue; } r -= I_OUT;
                if (r < I_G) { transpose_item(p.in[IN_WG] + (size_t)l * NEXP * DM * DEXP, DM, DEXP, (bf16_t*)(wl + OFF_WGU), (size_t)1024 * DM, 2, 0, p.in[IN_N2G] + l * DM, scr, r, lane); continue; } r -= I_G;
                if (r < I_G) { transpose_item(p.in[IN_WU] + (size_t)l * NEXP * DM * DEXP, DM, DEXP, (bf16_t*)(wl + OFF_WGU), (size_t)1024 * DM, 2, 1, p.in[IN_N2G] + l * DM, scr, r, lane); continue; } r -= I_G;
                transpose_item(p.in[IN_WD] + (size_t)l * NEXP * DEXP * DM, DEXP, DM, (bf16_t*)(wl + OFF_WD), (size_t)DM * DEXP, 1, 0, nullptr, scr, r, lane);
            }
            bf16_t* RW = (bf16_t*)(wl + OFF_RW);
            for (int i = vcu * NTHREADS + tid; i < NRW * (DM / 8); i += G * NTHREADS) { const int n = i / (DM / 8), k8 = (i % (DM / 8)) * 8; float v[8];
#pragma unroll
                for (int j = 0; j < 8; ++j) { const int k = k8 + j; const float g = p.in[IN_N2G][l * DM + k];
                    v[j] = n < 4 ? g * p.in[IN_RGW][(size_t)l * DM * 4 + k * 4 + n] : (n < 36 ? g * p.in[IN_REW][(size_t)l * DM * 32 + k * 32 + (n - 4)] : 0.f); }
                u32x4 o; o.x = cvt_pk_bf16(v[0], v[1]); o.y = cvt_pk_bf16(v[2], v[3]); o.z = cvt_pk_bf16(v[4], v[5]); o.w = cvt_pk_bf16(v[6], v[7]);
                *(u32x4*)(RW + (size_t)n * DM + k8) = o; }
        }
        for (int m = gw; m < T_TOK; m += NGW) norm_row(p.in[IN_X] + (size_t)m * DM, nullptr, 0.f, nullptr, 0.f, nullptr, Hb + (size_t)m * DM, nullptr, nullptr, lane);
        __syncthreads();
    }
    PHASE_END
    }

    for (int l = 0; l < DEPTH; ++l) {
        PHASE_BEGIN(1)
        {
            pg8::DenseSched S{(const char*)Hb, (const char*)(wl + OFF_WIN), T_TOK / 256, DIN / 256, G, bx, DM};
            pg8::EpiInProj E{Ub, KS};
            pg8::gemm_phase(lds, tid, DM, S, E);
        }
        PHASE_END
        PHASE_BEGIN(2)
        {
            for (int i = vcu; i < 256; i += G) { const int bh = i >> 3, s = i & 7;
                for (int k = 0; k < 2; ++k) att::attn_unit(tid, bh >> 3, bh & 7, k ? s : 15 - s, Ub, KS, Yc, (char*)lds_raw); }
#ifndef NO_CONV
            { const float* cw = p.in[IN_CAW] + (size_t)l * 3 * 512;
              for (int it = vcu; it < T_TOK / 64; it += G) { const int c8 = (tid & 63) * 8, tg0 = it * 64 + (tid >> 6) * 8, bstart = tg0 & ~(SEQ - 1);
                float w0[8], w1[8], w2[8];
#pragma unroll
                for (int j = 0; j < 8; ++j) { w0[j] = cw[c8 + j]; w1[j] = cw[512 + c8 + j]; w2[j] = cw[1024 + c8 + j]; }
                float z[10][8];
#pragma unroll
                for (int i = 0; i < 10; ++i) { const int tt = tg0 - 2 + i;
                    if (tt >= bstart) { const u32x4 a = *(const u32x4*)(Ub + (size_t)tt * DIN + COL_CG + c8), c = *(const u32x4*)(Ub + (size_t)tt * DIN + COL_XV + c8);
                        z[i][0] = bf_lo(a.x) * bf_lo(c.x); z[i][1] = bf_hi(a.x) * bf_hi(c.x); z[i][2] = bf_lo(a.y) * bf_lo(c.y); z[i][3] = bf_hi(a.y) * bf_hi(c.y);
                        z[i][4] = bf_lo(a.z) * bf_lo(c.z); z[i][5] = bf_hi(a.z) * bf_hi(c.z); z[i][6] = bf_lo(a.w) * bf_lo(c.w); z[i][7] = bf_hi(a.w) * bf_hi(c.w); }
                    else {
#pragma unroll
                        for (int j = 0; j < 8; ++j) z[i][j] = 0.f; } }
#pragma unroll
                for (int o = 0; o < 8; ++o) { const int tt = tg0 + o; const u32x4 bg = *(const u32x4*)(Ub + (size_t)tt * DIN + COL_BG + c8); float y[8];
#pragma unroll
                    for (int j = 0; j < 8; ++j) y[j] = w0[j] * z[o][j] + w1[j] * z[o + 1][j] + w2[j] * z[o + 2][j];
                    u32x4 w; w.x = cvt_pk_bf16(bf_lo(bg.x) * y[0], bf_hi(bg.x) * y[1]); w.y = cvt_pk_bf16(bf_lo(bg.y) * y[2], bf_hi(bg.y) * y[3]);
                    w.z = cvt_pk_bf16(bf_lo(bg.z) * y[4], bf_hi(bg.z) * y[5]); w.w = cvt_pk_bf16(bf_lo(bg.w) * y[6], bf_hi(bg.w) * y[7]);
                    *(u32x4*)(Yc + (size_t)tt * DM + c8) = w; } } }
            { const float* cw = p.in[IN_CCW] + (size_t)l * 31 * 512; const float* cb = p.in[IN_CCB] + l * 512; const float* lg = p.in[IN_LNG] + l * 512; const float* lb = p.in[IN_LNB] + l * 512;
              LAS float* hh = (LAS float*)lds; LAS float* co = hh + 46 * 512;
              for (int it = vcu; it < T_TOK / 16; it += G) { const int t0 = it * 16, bstart = t0 & ~(SEQ - 1);
                { const int c8 = (tid & 63) * 8;
                  for (int i = tid >> 6; i < 46; i += 8) { const int tt = t0 - 30 + i; float v[8];
                    if (tt >= bstart) { const u32x4 a = *(const u32x4*)(Ub + (size_t)tt * DIN + COL_CA + c8), g = *(const u32x4*)(Ub + (size_t)tt * DIN + COL_CGATE + c8);
                        v[0] = bf_lo(a.x) * fast_sigmoid(bf_lo(g.x)); v[1] = bf_hi(a.x) * fast_sigmoid(bf_hi(g.x)); v[2] = bf_lo(a.y) * fast_sigmoid(bf_lo(g.y)); v[3] = bf_hi(a.y) * fast_sigmoid(bf_hi(g.y));
                        v[4] = bf_lo(a.z) * fast_sigmoid(bf_lo(g.z)); v[5] = bf_hi(a.z) * fast_sigmoid(bf_hi(g.z)); v[6] = bf_lo(a.w) * fast_sigmoid(bf_lo(g.w)); v[7] = bf_hi(a.w) * fast_sigmoid(bf_hi(g.w)); }
                    else {
#pragma unroll
                        for (int j = 0; j < 8; ++j) v[j] = 0.f; }
                    *(LAS f32x4*)(hh + i * 512 + c8) = (f32x4){v[0], v[1], v[2], v[3]}; *(LAS f32x4*)(hh + i * 512 + c8 + 4) = (f32x4){v[4], v[5], v[6], v[7]}; } }
                __syncthreads();
                { const int c = tid; float w[31];
#pragma unroll
                  for (int j = 0; j < 31; ++j) w[j] = cw[j * 512 + c];
                  const float bias = cb[c];
                  float win[46];
#pragma unroll
                  for (int i = 0; i < 46; ++i) win[i] = hh[i * 512 + c];
#pragma unroll
                  for (int o = 0; o < 16; ++o) { float a = bias;
#pragma unroll
                      for (int j = 0; j < 31; ++j) a = fmaf(w[j], win[o + j], a);
                      co[o * 512 + c] = a; } }
                __syncthreads();
                { const int c8 = lane * 8;
                  f32x4 ga = *(const f32x4*)(lg + c8), gb = *(const f32x4*)(lg + c8 + 4), ba = *(const f32x4*)(lb + c8), bb = *(const f32x4*)(lb + c8 + 4);
#pragma unroll
                  for (int q = 0; q < 2; ++q) { const int o = wave * 2 + q; const f32x4 xa = *(const LAS f32x4*)(co + o * 512 + c8), xb = *(const LAS f32x4*)(co + o * 512 + c8 + 4);
                    const float mu = wave_sum((xa[0] + xa[1]) + (xa[2] + xa[3]) + (xb[0] + xb[1]) + (xb[2] + xb[3])) * (1.f / 512.f);
                    const f32x4 da = xa - mu, db = xb - mu;
                    const float var = wave_sum((da[0] * da[0] + da[1] * da[1]) + (da[2] * da[2] + da[3] * da[3]) + (db[0] * db[0] + db[1] * db[1]) + (db[2] * db[2] + db[3] * db[3])) * (1.f / 512.f);
                    const float rstd = 1.0f / sqrtf(var + EPS);
                    f32x4 ya = da * rstd * ga + ba, yb = db * rstd * gb + bb;
#pragma unroll
                    for (int j = 0; j < 4; ++j) { ya[j] = ya[j] * fast_sigmoid(ya[j]); yb[j] = yb[j] * fast_sigmoid(yb[j]); }
                    u32x4 w; w.x = cvt_pk_bf16(ya[0], ya[1]); w.y = cvt_pk_bf16(ya[2], ya[3]); w.z = cvt_pk_bf16(yb[0], yb[1]); w.w = cvt_pk_bf16(yb[2], yb[3]);
                    *(u32x4*)(Yc + (size_t)(t0 + o) * DM + 1536 + c8) = w; } }
                __syncthreads();
              } }
#endif
        }
        PHASE_END
        PHASE_BEGIN(3)
        {
            pg8::DenseSched S{(const char*)Yc, (const char*)(wl + OFF_WOUT), T_TOK / 256, DM / 256, G, bx, DM};
            pg8::EpiResF32 E{l == 0 ? p.in[IN_X] : (const float*)XR, XR};
            pg8::gemm_phase(lds, tid, DM, S, E);
        }
        PHASE_END
        PHASE_BEGIN(4)
        {
            const bf16_t* RW = (const bf16_t*)(wl + OFF_RW);
            const float* rgb = p.in[IN_RGB] + l * 4; const float* reb = p.in[IN_REB] + l * 32;
            LAS float* lgs = (LAS float*)(lds + wave * 4096);
            const int r16 = lane & 15, q = lane >> 4;
            for (int task = gw; task < T_TOK / 16; task += NGW) {
                const int row = task * 16 + r16;
                const float* xr = XR + (size_t)row * DM + 8 * q; bf16_t* hr = Hb + (size_t)row * DM + 8 * q;
                f32x4 acc[3] = {(f32x4){0.f, 0.f, 0.f, 0.f}, (f32x4){0.f, 0.f, 0.f, 0.f}, (f32x4){0.f, 0.f, 0.f, 0.f}}; float ss = 0.f;
#pragma unroll 4
                for (int ks = 0; ks < DM / 32; ++ks) { const f32x4 xa = *(const f32x4*)(xr + ks * 32), xb = *(const f32x4*)(xr + ks * 32 + 4);
                    ss += (xa[0] * xa[0] + xa[1] * xa[1]) + (xa[2] * xa[2] + xa[3] * xa[3]) + (xb[0] * xb[0] + xb[1] * xb[1]) + (xb[2] * xb[2] + xb[3] * xb[3]);
                    u32x4 w; w.x = cvt_pk_bf16(xa[0], xa[1]); w.y = cvt_pk_bf16(xa[2], xa[3]); w.z = cvt_pk_bf16(xb[0], xb[1]); w.w = cvt_pk_bf16(xb[2], xb[3]);
                    *(u32x4*)(hr + ks * 32) = w; const bf16x8 a = *reinterpret_cast<const bf16x8*>(&w);
#pragma unroll
                    for (int nb = 0; nb < 3; ++nb) { const bf16x8 bfr = *reinterpret_cast<const bf16x8*>(RW + (size_t)(nb * 16 + r16) * DM + ks * 32 + 8 * q); acc[nb] = __builtin_amdgcn_mfma_f32_16x16x32_bf16(a, bfr, acc[nb], 0, 0, 0); } }
                ss += __shfl_xor(ss, 16); ss += __shfl_xor(ss, 32);
                const float rs = 1.0f / sqrtf(ss * (1.f / DM) + EPS);
#pragma unroll
                for (int nb = 0; nb < 3; ++nb)
#pragma unroll
                    for (int r = 0; r < 4; ++r) lgs[(4 * q + r) * 49 + nb * 16 + r16] = acc[nb][r];
                asm volatile("s_waitcnt lgkmcnt(0)" ::: "memory");
                if (lane < 16) {
                    const LAS float* lr = lgs + lane * 49;
                    float gl[4];
#pragma unroll
                    for (int j = 0; j < 4; ++j) gl[j] = lr[j] * rs + rgb[j];
                    int grp = 0; float gm = gl[0];
#pragma unroll
                    for (int j = 1; j < 4; ++j) if (gl[j] > gm) { gm = gl[j]; grp = j; }
                    float gsum = 0.f;
#pragma unroll
                    for (int j = 0; j < 4; ++j) gsum += __expf(gl[j] - gm);
                    const float pgrp = 1.0f / gsum;
                    float el[8];
#pragma unroll
                    for (int j = 0; j < 8; ++j) el[j] = lr[4 + grp * 8 + j] * rs + reb[grp * 8 + j];
                    int i1 = 0; float m1 = el[0];
#pragma unroll
                    for (int j = 1; j < 8; ++j) if (el[j] > m1) { m1 = el[j]; i1 = j; }
                    int i2 = -1; float m2 = -INFINITY;
#pragma unroll
                    for (int j = 0; j < 8; ++j) if (j != i1 && el[j] > m2) { m2 = el[j]; i2 = j; }
                    const float e2 = __expf(m2 - m1), inv = 1.0f / (1.0f + e2);
                    const float g1 = pgrp * inv, g2 = pgrp * e2 * inv;
                    const int E1 = grp * 8 + i1, E2 = grp * 8 + i2;
                    const int pos1 = atomicAdd(&cntg[E1], 1), pos2 = atomicAdd(&cntg[E2], 1);
                    TM[E1 * T_TOK + pos1] = row; TM[E2 * T_TOK + pos2] = row;
                    u32x4 ra = {(unsigned)E1, (unsigned)pos1, (unsigned)E2, (unsigned)pos2}; u32x4 rb = {__float_as_uint(g1), __float_as_uint(g2), 0u, 0u};
                    *(u32x4*)(REC + (size_t)row * 8) = ra; *(u32x4*)(REC + (size_t)row * 8 + 4) = rb;
                    RS[row] = rs;
                }
                asm volatile("s_waitcnt lgkmcnt(0)" ::: "memory");
            }
        }
        PHASE_END
        for (int pass = 0; pass < 2; ++pass) {
            PHASE_BEGIN(5)
            {
                if (tid < 64) { const int c = tid < NEXP ? __hip_atomic_load(&cntg[tid], __ATOMIC_RELAXED, __HIP_MEMORY_SCOPE_AGENT) : 0; const int nt_ = (c + 255) >> 8; int incl = nt_;
#pragma unroll
                    for (int o = 1; o < 64; o <<= 1) { const int v = __shfl_up(incl, o); if (lane >= o) incl += v; }
                    const int st = incl - nt_;
                    if (tid < NEXP) { m_tstart[tid] = st; m_cnt[tid] = c; for (int k = 0; k < nt_; ++k) m_tile_e[st + k] = tid; }
                    if (tid == NEXP) m_tstart[NEXP] = st; }
                __syncthreads();
                const int nM = m_tstart[NEXP];
#ifndef PASS_MASK
#define PASS_MASK 3
#endif
                if ((PASS_MASK & 1) && pass == 0) {
                    pg8::MoeSched S{(const char*)Hb, (const char*)(wl + OFF_WGU), (size_t)1024 * DM * 2, nM, 1024 / 256, G, bx, DM, true, m_tile_e, m_tstart, m_cnt, TM};
                    pg8::EpiSwiglu E{HMb, RS, TM, m_tstart, m_cnt};
                    pg8::gemm_phase(lds, tid, DM, S, E);
                } else if (PASS_MASK & 2) {
                    pg8::MoeSched S{(const char*)HMb, (const char*)(wl + OFF_WD), (size_t)DM * DEXP * 2, nM, DM / 256, G, bx, DEXP, false, m_tile_e, m_tstart, m_cnt, TM};
                    pg8::EpiBf16 E{YM, DM};
                    pg8::gemm_phase(lds, tid, DEXP, S, E);
                }
                __syncthreads();
            }
            PHASE_END
        }
        PHASE_BEGIN(6)
        {
            int tst; { const int c = lane < NEXP ? __hip_atomic_load(&cntg[lane], __ATOMIC_RELAXED, __HIP_MEMORY_SCOPE_AGENT) : 0; const int nt_ = (c + 255) >> 8; int incl = nt_;
#pragma unroll
                for (int o = 1; o < 64; o <<= 1) { const int v = __shfl_up(incl, o); if (lane >= o) incl += v; }
                tst = incl - nt_; }
            const bool fin = (l == DEPTH - 1);
            for (int m = gw; m < T_TOK; m += NGW) {
                const u32x4 ra = *(const u32x4*)(REC + (size_t)m * 8); const u32x2 rb = *(const u32x2*)(REC + (size_t)m * 8 + 4);
                const int r0 = __shfl(tst, (int)ra.x) * 256 + (int)ra.y, r1 = __shfl(tst, (int)ra.z) * 256 + (int)ra.w;
                float* xrow = XR + (size_t)m * DM;
                norm_row(xrow, YM + (size_t)r0 * DM, __uint_as_float(rb.x), YM + (size_t)r1 * DM, __uint_as_float(rb.y), fin ? nullptr : xrow,
                         Hb + (size_t)m * DM, fin ? xrow : nullptr, p.in[IN_FG], lane);
            }
        }
        PHASE_END
    }
#undef PHASE_BEGIN
#undef PHASE_END
}

constexpr int N_PHASES = 1 + 7 * DEPTH;

extern "C" void kernel_launch(void* const* d_in, const int* in_sizes, int n_in, void* d_out, int out_size, void* d_ws, size_t ws_size, hipStream_t stream) {
    static int grid = 0;
    if (grid == 0) {
        if (n_in != 18 || in_sizes[0] != T_TOK * DM || out_size != T_TOK * DM || ws_size < WS_END) {
            fprintf(stderr, "kernel_launch: unexpected shapes: n_in %d in0 %d out %d ws %zu (need >= %zu)\n", n_in, n_in > 0 ? in_sizes[0] : -1, out_size, ws_size, (size_t)WS_END); grid = -1; return; }
        int dev = 0, cus = 0, per_cu = 0;
        hipGetDevice(&dev); hipDeviceGetAttribute(&cus, hipDeviceAttributeMultiprocessorCount, dev);
        if (hipFuncSetAttribute((const void*)fwd_kernel, hipFuncAttributeMaxDynamicSharedMemorySize, LDS_BYTES) != hipSuccess) { fprintf(stderr, "kernel_launch: hipFuncSetAttribute failed\n"); grid = -1; return; }
        if (hipOccupancyMaxActiveBlocksPerMultiprocessor(&per_cu, (const void*)fwd_kernel, NTHREADS, LDS_BYTES) != hipSuccess || per_cu < 1) { fprintf(stderr, "kernel_launch: occupancy query says %d blocks/CU\n", per_cu); per_cu = 1; }
        (void)hipGetLastError();
        grid = cus;
        if (grid > 256) grid = 256;
    }
    if (grid < 0) return;
    hipMemsetAsync((char*)d_ws + WS_CTL, 0, CTL_BYTES, stream);
    Params p{};
    for (int i = 0; i < 18; ++i) p.in[i] = (const float*)d_in[i];
    p.out = (float*)d_out; p.ws = (unsigned char*)d_ws;
#if MK_N_LAUNCHES == 1
    p.ph_lo = 0; p.ph_hi = N_PHASES;
    void* args[] = {&p};
    hipError_t e = hipLaunchCooperativeKernel((const void*)fwd_kernel, dim3(grid), dim3(NTHREADS), args, LDS_BYTES, stream);
    if (e != hipSuccess) fprintf(stderr, "kernel_launch: cooperative launch failed: %s (grid %d)\n", hipGetErrorString(e), grid);
#else
    for (int ph = 0; ph < N_PHASES; ++ph) { p.ph_lo = ph; p.ph_hi = ph + 1;
        hipLaunchKernelGGL(fwd_kernel, dim3(grid), dim3(NTHREADS), LDS_BYTES, stream, p); }
    hipError_t e = hipPeekAtLastError();
    if (e != hipSuccess) fprintf(stderr, "kernel_launch: launch failed: %s\n", hipGetErrorName(e));
#endif
}
```

```cpp
#include <hip/hip_runtime.h>
#include <hip/hip_cooperative_groups.h>
#include <cstdio>
#include <cstdint>
namespace cg = cooperative_groups;

#ifndef ATT_REPORT
#define ATT_REPORT 0
#endif
#ifndef MK_N_LAUNCHES
#define MK_N_LAUNCHES 1
#endif

#define LAS __attribute__((address_space(3)))
typedef unsigned short bf16_t;
typedef short bf16x8 __attribute__((ext_vector_type(8)));
typedef short s16x4 __attribute__((ext_vector_type(4)));
typedef float f32x2 __attribute__((ext_vector_type(2)));
typedef float f32x4 __attribute__((ext_vector_type(4)));
typedef float f32x16 __attribute__((ext_vector_type(16)));
typedef unsigned u32x2 __attribute__((ext_vector_type(2)));
typedef unsigned u32x4 __attribute__((ext_vector_type(4)));

constexpr int T_TOK = 16384, DM = 2048, DIN = 5632, SEQ = 4096, NBATCH = 4, NHEAD = 8, HD = 128, DEPTH = 2;
constexpr int COL_BG = 0, COL_CG = 512, COL_XV = 1024, COL_Q = 1536, COL_K = 2560, COL_V = 3584, COL_CA = 4608, COL_CGATE = 5120;
constexpr int NEXP = 32, DEXP = 512, NRW = 48;
constexpr int MAXTILES = 160;
constexpr float EPS = 1e-6f;
constexpr int NWAVES = 8, NTHREADS = 512;
constexpr int RING_BYTES = 131072, SCRATCH_BYTES = 147456, MISC_OFF = SCRATCH_BYTES, MISC_BYTES = 8192, LDS_BYTES = SCRATCH_BYTES + MISC_BYTES;

constexpr size_t MiB = 1u << 20;
constexpr size_t WS_CTL = 0;
constexpr size_t CTL_BYTES = 32768;
constexpr size_t SZ_WIN = (size_t)DIN * DM * 2, SZ_WOUT = (size_t)DM * DM * 2, SZ_WGU = (size_t)NEXP * 1024 * DM * 2, SZ_WD = (size_t)NEXP * DM * DEXP * 2, SZ_RW = (size_t)NRW * DM * 2;
constexpr size_t WS_W0 = 1 * MiB;
constexpr size_t OFF_WIN = 0, OFF_WOUT = OFF_WIN + SZ_WIN, OFF_WGU = OFF_WOUT + SZ_WOUT, OFF_WD = OFF_WGU + SZ_WGU, OFF_RW = OFF_WD + SZ_WD, SZ_LAYER = ((OFF_RW + SZ_RW + 4095) / 4096) * 4096;
constexpr size_t WS_U = WS_W0 + DEPTH * SZ_LAYER;
constexpr size_t SZ_U = (size_t)T_TOK * DIN * 2;
static_assert((size_t)MAXTILES * 256 * DM * 2 <= SZ_U, "ymoe overlays u");
constexpr size_t WS_Y = WS_U + SZ_U;
constexpr size_t WS_H = WS_Y + (size_t)T_TOK * DM * 2;
constexpr size_t WS_HM = WS_H + (size_t)T_TOK * DM * 2;
constexpr size_t WS_KS = WS_HM + (size_t)MAXTILES * 256 * DEXP * 2;
constexpr size_t WS_RS = WS_KS + (size_t)64 * 2 * 1024 * 4;
constexpr size_t WS_REC = WS_RS + (size_t)T_TOK * 4;
constexpr size_t WS_TM = WS_REC + (size_t)T_TOK * 32;
constexpr size_t WS_END = WS_TM + (size_t)NEXP * T_TOK * 4;

__device__ __forceinline__ unsigned cvt_pk_bf16(float lo, float hi) { unsigned r; asm volatile("v_cvt_pk_bf16_f32 %0, %1, %2" : "=v"(r) : "v"(lo), "v"(hi)); return r; }
__device__ __forceinline__ float bf_lo(unsigned w) { return __uint_as_float(w << 16); }
__device__ __forceinline__ float bf_hi(unsigned w) { return __uint_as_float(w & 0xffff0000u); }
__device__ __forceinline__ float wave_sum(float v) {
#pragma unroll
    for (int o = 1; o < 64; o <<= 1) v += __shfl_xor(v, o);
    return v;
}
__device__ __forceinline__ float fast_sigmoid(float x) { return __builtin_amdgcn_rcpf(1.f + __builtin_amdgcn_exp2f(-1.4426950408889634f * x)); }

namespace pg8 {
constexpr int BM = 256, BK = 64, HALF = 128, HTB = HALF * BK * 2, STAGE_BYTES = 8 * HTB, NXCD = 8, WGM = 8;
__host__ __device__ __forceinline__ int lds_byte(int r, int c) { const int st = (r >> 4) * 2 + (c >> 5), rr = r & 15, cc = c & 31, ob = rr * 64 + cc * 2; return st * 1024 + (ob ^ (((ob >> 9) & 1) << 5)); }
__host__ __device__ __forceinline__ void stage_rc(int b, int& R, int& C) { const int st = b / 1024, sb = b % 1024, swz = sb ^ (((sb >> 9) & 1) << 5); R = (st >> 1) * 16 + swz / 64; C = (st & 1) * 32 + (swz % 64) / 2; }
__host__ __device__ __forceinline__ int perm32(int rho) { const int n = rho >> 4, i = rho & 15; return 8 * (i >> 2) + 4 * n + (i & 3); }

struct Unit { int pm, pn, e; };

__device__ __forceinline__ bool order_next(int i, int G, int c, int nM, int nN, Unit& u) {
    const int nwg = nM * nN; const long L = (long)i * G + c; if (L >= nwg) return false;
    int wgid = (int)L; { const int q = nwg / NXCD, r = nwg % NXCD, xcd = wgid % NXCD, off = wgid / NXCD; wgid = (xcd < r ? xcd * (q + 1) : r * (q + 1) + (xcd - r) * q) + off; }
    const int nig = WGM * nN, gid = wgid / nig, fm = gid * WGM, gsz = (nM - fm) < WGM ? (nM - fm) : WGM;
    u.pm = fm + ((wgid % nig) % gsz); u.pn = (wgid % nig) / gsz; u.e = 0; return true;
}

struct DenseSched {
    const char* A; const char* Bt; int nM, nN, G, c, K;
    __device__ __forceinline__ bool next(int i, Unit& u) const { return order_next(i, G, c, nM, nN, u); }
    __device__ __forceinline__ const char* a_base(const Unit& u) const { return A + (size_t)u.pm * BM * K * 2; }
    __device__ __forceinline__ const char* b_base(const Unit& u) const { return Bt + (size_t)u.pn * BM * K * 2; }
    __device__ __forceinline__ void a_rows(const Unit&, const int (&RA)[2], const unsigned (&cofA)[2], unsigned (&g)[2][2]) const {
#pragma unroll
        for (int h = 0; h < 2; ++h)
#pragma unroll
            for (int i = 0; i < 2; ++i) g[h][i] = (unsigned)((h * HALF + RA[i]) * K) * 2u + cofA[i];
    }
};
struct MoeSched {
    const char* A; const char* Bt; size_t b_estride; int nM, nN, G, c, K; bool gather;
    const LAS int* tile_e; const LAS int* tstart; const LAS int* cnt; const int* tokmap;
    __device__ __forceinline__ bool next(int i, Unit& u) const { if (!order_next(i, G, c, nM, nN, u)) return false; u.e = tile_e[u.pm]; return true; }
    __device__ __forceinline__ const char* a_base(const Unit& u) const { return gather ? A : A + (size_t)u.pm * BM * K * 2; }
    __device__ __forceinline__ const char* b_base(const Unit& u) const { return Bt + (size_t)u.e * b_estride + (size_t)u.pn * BM * K * 2; }
    __device__ __forceinline__ void a_rows(const Unit& u, const int (&RA)[2], const unsigned (&cofA)[2], unsigned (&g)[2][2]) const {
        if (gather) {
            const int p0 = (u.pm - tstart[u.e]) * BM, cn = cnt[u.e];
#pragma unroll
            for (int h = 0; h < 2; ++h)
#pragma unroll
                for (int i = 0; i < 2; ++i) { int pos = p0 + h * HALF + RA[i]; pos = pos < cn ? pos : cn - 1; const int tok = tokmap[u.e * T_TOK + pos]; g[h][i] = (unsigned)(tok * K) * 2u + cofA[i]; }
        } else {
#pragma unroll
            for (int h = 0; h < 2; ++h)
#pragma unroll
                for (int i = 0; i < 2; ++i) g[h][i] = (unsigned)((h * HALF + RA[i]) * K) * 2u + cofA[i];
        }
    }
};

struct EpiInProj {
    static constexpr bool PERM = true;
    bf16_t* U; float* ksum;
    __device__ __forceinline__ void operator()(const f32x4 (&acc)[2][2][4][2], const Unit& u, int wr, int wc, int fr, int fq) const {
        const int row0 = u.pm * BM + wr * 64 + fr, col0 = u.pn * BM + wc * 32 + 8 * fq;
#pragma unroll
        for (int ai = 0; ai < 2; ++ai)
#pragma unroll
            for (int m = 0; m < 4; ++m) { bf16_t* rowp = U + (size_t)(row0 + ai * HALF + m * 16) * DIN + col0;
#pragma unroll
                for (int bj = 0; bj < 2; ++bj) { const f32x4 v0 = acc[ai][bj][m][0], v1 = acc[ai][bj][m][1]; u32x4 w;
                    w.x = cvt_pk_bf16(v0[0], v0[1]); w.y = cvt_pk_bf16(v0[2], v0[3]); w.z = cvt_pk_bf16(v1[0], v1[1]); w.w = cvt_pk_bf16(v1[2], v1[3]);
                    *(u32x4*)(rowp + bj * HALF) = w; } }
        if (u.pn >= COL_K / 256 && u.pn < COL_V / 256) {
            float* kp = ksum + (size_t)(u.pm * 2 + wr) * 1024 + (u.pn - COL_K / 256) * 256 + wc * 32 + 8 * fq;
#pragma unroll
            for (int bj = 0; bj < 2; ++bj)
#pragma unroll
                for (int n = 0; n < 2; ++n) { f32x4 s = (f32x4){0.f, 0.f, 0.f, 0.f};
#pragma unroll
                    for (int ai = 0; ai < 2; ++ai)
#pragma unroll
                        for (int m = 0; m < 4; ++m) s += acc[ai][bj][m][n];
#pragma unroll
                    for (int o = 1; o < 16; o <<= 1) { s[0] += __shfl_xor(s[0], o); s[1] += __shfl_xor(s[1], o); s[2] += __shfl_xor(s[2], o); s[3] += __shfl_xor(s[3], o); }
                    if (fr == 0) *(f32x4*)(kp + bj * HALF + 4 * n) = s; }
        }
    }
};
struct EpiResF32 {
    static constexpr bool PERM = false;
    const float* res; float* out;
    __device__ __forceinline__ void operator()(const f32x4 (&acc)[2][2][4][2], const Unit& u, int wr, int wc, int fr, int fq) const {
        const int row0 = u.pm * BM + wr * 64 + fr, col0 = u.pn * BM + wc * 32 + 4 * fq;
#pragma unroll
        for (int ai = 0; ai < 2; ++ai)
#pragma unroll
            for (int m = 0; m < 4; ++m) { const size_t off = (size_t)(row0 + ai * HALF + m * 16) * DM + col0;
#pragma unroll
                for (int bj = 0; bj < 2; ++bj)
#pragma unroll
                    for (int n = 0; n < 2; ++n) { const f32x4 r = *(const f32x4*)(res + off + bj * HALF + n * 16); *(f32x4*)(out + off + bj * HALF + n * 16) = r + acc[ai][bj][m][n]; } }
    }
};
struct EpiSwiglu {
    static constexpr bool PERM = true;
    bf16_t* HMo; const float* rs; const int* tokmap; const LAS int* tstart; const LAS int* cnt;
    __device__ __forceinline__ void operator()(const f32x4 (&acc)[2][2][4][2], const Unit& u, int wr, int wc, int fr, int fq) const {
        const int p0 = (u.pm - tstart[u.e]) * BM, cn = cnt[u.e];
#pragma unroll
        for (int ai = 0; ai < 2; ++ai)
#pragma unroll
            for (int m = 0; m < 4; ++m) { const int r = ai * HALF + wr * 64 + m * 16 + fr; int pos = p0 + r; pos = pos < cn ? pos : cn - 1;
                const float sc = rs[tokmap[u.e * T_TOK + pos]];
                bf16_t* rowp = HMo + (size_t)(u.pm * BM + r) * DEXP + ((u.pn * BM + wc * 32 + 8 * fq) >> 1);
#pragma unroll
                for (int bj = 0; bj < 2; ++bj) { const f32x4 v0 = acc[ai][bj][m][0] * sc, v1 = acc[ai][bj][m][1] * sc;
                    const float h0 = v0[0] * fast_sigmoid(v0[0]) * v0[1], h1 = v0[2] * fast_sigmoid(v0[2]) * v0[3], h2 = v1[0] * fast_sigmoid(v1[0]) * v1[1], h3 = v1[2] * fast_sigmoid(v1[2]) * v1[3];
                    u32x2 w; w.x = cvt_pk_bf16(h0, h1); w.y = cvt_pk_bf16(h2, h3); *(u32x2*)(rowp + bj * (HALF / 2)) = w; } }
    }
};
struct EpiBf16 {
    static constexpr bool PERM = true;
    bf16_t* O; int ldc;
    __device__ __forceinline__ void operator()(const f32x4 (&acc)[2][2][4][2], const Unit& u, int wr, int wc, int fr, int fq) const {
        const int row0 = u.pm * BM + wr * 64 + fr, col0 = u.pn * BM + wc * 32 + 8 * fq;
#pragma unroll
        for (int ai = 0; ai < 2; ++ai)
#pragma unroll
            for (int m = 0; m < 4; ++m) { bf16_t* rowp = O + (size_t)(row0 + ai * HALF + m * 16) * ldc + col0;
#pragma unroll
                for (int bj = 0; bj < 2; ++bj) { const f32x4 v0 = acc[ai][bj][m][0], v1 = acc[ai][bj][m][1]; u32x4 w;
                    w.x = cvt_pk_bf16(v0[0], v0[1]); w.y = cvt_pk_bf16(v0[2], v0[3]); w.z = cvt_pk_bf16(v1[0], v1[1]); w.w = cvt_pk_bf16(v1[2], v1[3]);
                    *(u32x4*)(rowp + bj * HALF) = w; } }
    }
};

template <class Epi, class Sched>
__device__ __forceinline__ void gemm_phase(LAS unsigned char* lds, const int tid, const int K, const Sched& S, const Epi& E) {
    const int wid = __builtin_amdgcn_readfirstlane(tid >> 6), lane = tid & 63, wr = wid >> 2, wc = wid & 3, fr = lane & 15, fq = lane >> 4;
    const int nt = K / BK;
    int RA[2]; unsigned cofA[2], voffB[2];
#pragma unroll
    for (int i = 0; i < 2; ++i) { int R, C; stage_rc(tid * 16 + i * 8192, R, C); const int Rb = Epi::PERM ? ((R & ~31) + perm32(R & 31)) : R;
        RA[i] = R; cofA[i] = (unsigned)C * 2u; voffB[i] = (unsigned)(Rb * K + C) * 2u; }
    const size_t kstep = (size_t)(BK * 2);
    const size_t hstep = (size_t)HALF * K * 2;
    const unsigned ldsw = (unsigned)wid * 1024u;
    const int aoff = lds_byte(wr * 64 + fr, fq * 8), boff = lds_byte(wc * 32 + fr, fq * 8);
#define PG8_SA(b, h) (((b) * 2 + (h)) * HTB)
#define PG8_SB(b, h) ((4 + (b) * 2 + (h)) * HTB)
#define PG8_STG(bufoff, gptr, v0, v1) do { \
        __builtin_amdgcn_global_load_lds((const unsigned*)((const char*)(gptr) + (v0)), (LAS unsigned*)(lds + (bufoff) + ldsw), 16, 0, 0); \
        __builtin_amdgcn_global_load_lds((const unsigned*)((const char*)(gptr) + (v1)), (LAS unsigned*)(lds + (bufoff) + ldsw + 8192), 16, 0, 0); } while (0)
#define PG8_LDA(dst, b, h) do { _Pragma("unroll") for (int m = 0; m < 4; ++m) _Pragma("unroll") for (int k = 0; k < 2; ++k) dst[m][k] = *(const LAS bf16x8*)(lds + PG8_SA(b, h) + aoff + m * 2048 + k * 1024); } while (0)
#define PG8_LDB(dst, b, h) do { _Pragma("unroll") for (int n = 0; n < 2; ++n) _Pragma("unroll") for (int k = 0; k < 2; ++k) dst[n][k] = *(const LAS bf16x8*)(lds + PG8_SB(b, h) + boff + n * 2048 + k * 1024); } while (0)
#define PG8_MMA(ai, bj, At, Bt) do { __builtin_amdgcn_s_setprio(1); _Pragma("unroll") for (int m = 0; m < 4; ++m) _Pragma("unroll") for (int n = 0; n < 2; ++n) _Pragma("unroll") for (int k = 0; k < 2; ++k) \
        acc[ai][bj][m][n] = __builtin_amdgcn_mfma_f32_16x16x32_bf16(Bt[n][k], At[m][k], acc[ai][bj][m][n], 0, 0, 0); __builtin_amdgcn_s_setprio(0); } while (0)
#define PG8_WAIT_V(n) asm volatile("s_waitcnt vmcnt(" #n ")" ::: "memory")
#define PG8_WAIT_L(n) asm volatile("s_waitcnt lgkmcnt(" #n ")" ::: "memory")
#define PG8_BAR __builtin_amdgcn_s_barrier()
#define PG8_SCHED __builtin_amdgcn_sched_barrier(0)
    Unit cur, nxt; int ui = 0;
    if (!S.next(0, cur)) return;
    f32x4 acc[2][2][4][2];
#pragma unroll
    for (int a = 0; a < 2; ++a)
#pragma unroll
        for (int b = 0; b < 2; ++b)
#pragma unroll
            for (int m = 0; m < 4; ++m)
#pragma unroll
                for (int n = 0; n < 2; ++n) acc[a][b][m][n] = (f32x4){0.f, 0.f, 0.f, 0.f};
    bf16x8 At[4][2], B0[2][2], B1[2][2];
    const char* cA = S.a_base(cur); const char* cB = S.b_base(cur);
    unsigned gc[2][2], gn[2][2];
    S.a_rows(cur, RA, cofA, gc);
    PG8_STG(PG8_SB(0, 0), cB, voffB[0], voffB[1]); PG8_STG(PG8_SB(0, 1), cB + hstep, voffB[0], voffB[1]); PG8_STG(PG8_SA(0, 0), cA, gc[0][0], gc[0][1]); PG8_STG(PG8_SA(0, 1), cA, gc[1][0], gc[1][1]);
    if (wr == 1) PG8_BAR;
    PG8_WAIT_V(2); PG8_BAR;
    PG8_STG(PG8_SB(1, 0), cB + kstep, voffB[0], voffB[1]); PG8_STG(PG8_SA(1, 0), cA + kstep, gc[0][0], gc[0][1]); PG8_STG(PG8_SB(1, 1), cB + hstep + kstep, voffB[0], voffB[1]);
    PG8_WAIT_V(6); PG8_BAR;
    for (;;) {
        const bool has_next = S.next(ui + 1, nxt);
        const char* nA = has_next ? S.a_base(nxt) : cA; const char* nB = has_next ? S.b_base(nxt) : cB;
        if (has_next) S.a_rows(nxt, RA, cofA, gn);
        else { gn[0][0] = gc[0][0]; gn[0][1] = gc[0][1]; gn[1][0] = gc[1][0]; gn[1][1] = gc[1][1]; }
        for (int t = 0; t < nt; t += 2) {
            const bool last = (t == nt - 2);
            const char* a1 = cA + (size_t)(t + 1) * kstep;
            const char* a2 = last ? nA : cA + (size_t)(t + 2) * kstep; const char* b2 = last ? nB : cB + (size_t)(t + 2) * kstep;
            const char* a3 = a2 + kstep; const char* b3 = b2 + kstep;
            const unsigned g00 = last ? gn[0][0] : gc[0][0], g01 = last ? gn[0][1] : gc[0][1], g10 = last ? gn[1][0] : gc[1][0], g11 = last ? gn[1][1] : gc[1][1];
            PG8_LDB(B0, 0, 0); PG8_LDB(B1, 0, 1); PG8_SCHED; PG8_LDA(At, 0, 0); PG8_STG(PG8_SA(1, 1), a1, gc[1][0], gc[1][1]);
            PG8_WAIT_V(8); PG8_WAIT_L(0); PG8_BAR; PG8_MMA(0, 0, At, B0); PG8_MMA(0, 1, At, B1); PG8_BAR; PG8_SCHED;
            PG8_LDA(At, 0, 1); PG8_STG(PG8_SB(0, 0), b2, voffB[0], voffB[1]); PG8_STG(PG8_SB(0, 1), b2 + hstep, voffB[0], voffB[1]); PG8_STG(PG8_SA(0, 0), a2, g00, g01);
            PG8_WAIT_V(8); PG8_WAIT_L(0); PG8_BAR; PG8_MMA(1, 0, At, B0); PG8_MMA(1, 1, At, B1); PG8_BAR; PG8_SCHED;
            PG8_LDB(B0, 1, 0); PG8_LDB(B1, 1, 1); PG8_SCHED; PG8_LDA(At, 1, 0); PG8_STG(PG8_SA(0, 1), a2, g10, g11);
            PG8_WAIT_V(8); PG8_WAIT_L(0); PG8_BAR; PG8_MMA(0, 0, At, B0); PG8_MMA(0, 1, At, B1); PG8_BAR; PG8_SCHED;
            PG8_LDA(At, 1, 1); PG8_STG(PG8_SB(1, 0), b3, voffB[0], voffB[1]); PG8_STG(PG8_SB(1, 1), b3 + hstep, voffB[0], voffB[1]); PG8_STG(PG8_SA(1, 0), a3, g00, g01);
            PG8_WAIT_V(8); PG8_WAIT_L(0); PG8_BAR; PG8_MMA(1, 0, At, B0); PG8_MMA(1, 1, At, B1); PG8_BAR; PG8_SCHED;
        }
        if (wr == 0) PG8_BAR;
        E(acc, cur, wr, wc, fr, fq);
        if (!has_next) break;
#pragma unroll
        for (int a = 0; a < 2; ++a)
#pragma unroll
            for (int b = 0; b < 2; ++b)
#pragma unroll
                for (int m = 0; m < 4; ++m)
#pragma unroll
                    for (int n = 0; n < 2; ++n) acc[a][b][m][n] = (f32x4){0.f, 0.f, 0.f, 0.f};
        cur = nxt; cA = nA; cB = nB; gc[0][0] = gn[0][0]; gc[0][1] = gn[0][1]; gc[1][0] = gn[1][0]; gc[1][1] = gn[1][1]; ++ui;
        if (wr == 1) PG8_BAR;
    }
    PG8_WAIT_V(0);
    PG8_BAR;
#undef PG8_SA
#undef PG8_SB
#undef PG8_STG
#undef PG8_LDA
#undef PG8_LDB
#undef PG8_MMA
#undef PG8_WAIT_V
#undef PG8_WAIT_L
#undef PG8_BAR
#undef PG8_SCHED
}
}

namespace att {
constexpr float SCALE = 0.088388347648318440f;
constexpr float THR = 8.f;
constexpr int KVBLK = 64, QBLK = 32;
constexpr size_t SHM_V = KVBLK * HD * 2, SHM_K = KVBLK * HD * 2;
constexpr int OFF_V = 0, OFF_K = 2 * SHM_V, OFF_WS = OFF_K + 2 * SHM_K, OFF_KM = OFF_WS + NWAVES * 64 * 4, OFF_Q = OFF_KM + 32 * 256, ATT_LDS = OFF_Q + 256 * 256;
#define KSWZ(row, colB) ((row) * 256 + ((colB) ^ (((row) & 7) << 4)))
#define SBAR() __builtin_amdgcn_sched_barrier(0)
__device__ __forceinline__ int crow(int r, int hi) { return (r & 3) + 8 * (r >> 2) + 4 * hi; }

__device__ __forceinline__ void partialSM(f32x16& p0, f32x16& p1, float& m_reg, float& mn, float& alpha, float slr, float lb, int mode, int thr) {
    constexpr float C = SCALE * 1.4426950408889634f;
#pragma unroll
    for (int r = 0; r < 16; ++r) { const float cr = (float)((r & 3) + 8 * (r >> 2)); p0[r] = fmaf(slr, cr, p0[r]); p1[r] = fmaf(slr, cr + 32.f, p1[r]); }
    if (mode) {
        if (mode == 1) {
#pragma unroll
            for (int r = 0; r < 16; ++r) { if ((r & 3) + 8 * (r >> 2) > thr) p0[r] = -3.0e38f; p1[r] = -3.0e38f; }
        } else {
#pragma unroll
            for (int r = 0; r < 16; ++r) { if ((r & 3) + 8 * (r >> 2) > thr) p1[r] = -3.0e38f; }
        }
    }
    float pmax = p0[0];
#pragma unroll
    for (int r = 1; r < 16; ++r) pmax = fmaxf(pmax, p0[r]);
#pragma unroll
    for (int r = 0; r < 16; ++r) pmax = fmaxf(pmax, p1[r]);
    pmax += lb;
    { auto rr = __builtin_amdgcn_permlane32_swap(__float_as_uint(pmax), __float_as_uint(pmax), false, false);
      pmax = fmaxf(__uint_as_float(rr[0]), __uint_as_float(rr[1])); }
    if (__builtin_expect(__all(pmax - m_reg <= THR / SCALE), 1)) { mn = m_reg; alpha = 1.f; }
    else { mn = fmaxf(m_reg, pmax); alpha = __builtin_amdgcn_exp2f((m_reg - mn) * C); m_reg = mn; }
    const float mnC = (lb - mn) * C;
#pragma unroll
    for (int r = 0; r < 16; ++r) p0[r] = fmaf(p0[r], C, mnC);
#pragma unroll
    for (int r = 0; r < 16; ++r) p1[r] = fmaf(p1[r], C, mnC);
#pragma unroll
    for (int r = 0; r < 16; ++r) p0[r] = __builtin_amdgcn_exp2f(p0[r]);
}
__device__ __forceinline__ void finishSM(f32x16& p0, f32x16& p1, float alpha, float& l_reg, bf16x8& pa0, bf16x8& pa1, bf16x8& pa2, bf16x8& pa3) {
#pragma unroll
    for (int r = 0; r < 16; ++r) p1[r] = __builtin_amdgcn_exp2f(p1[r]);
    float ps = 0;
#pragma unroll
    for (int r = 0; r < 16; ++r) ps += p0[r];
#pragma unroll
    for (int r = 0; r < 16; ++r) ps += p1[r];
    { auto rr = __builtin_amdgcn_permlane32_swap(__float_as_uint(ps), __float_as_uint(ps), false, false);
      ps = __uint_as_float(rr[0]) + __uint_as_float(rr[1]); }
    l_reg = l_reg * alpha + ps;
#define PK4(P, BASE, OUT) do { unsigned a0 = cvt_pk_bf16(P[BASE + 0], P[BASE + 1]), a1 = cvt_pk_bf16(P[BASE + 2], P[BASE + 3]);   \
    unsigned b0 = cvt_pk_bf16(P[BASE + 4], P[BASE + 5]), b1 = cvt_pk_bf16(P[BASE + 6], P[BASE + 7]);                              \
    auto r0 = __builtin_amdgcn_permlane32_swap(a0, b0, false, false); auto r1 = __builtin_amdgcn_permlane32_swap(a1, b1, false, false); \
    u32x4 w = {r0[0], r1[0], r0[1], r1[1]}; OUT = *reinterpret_cast<bf16x8*>(&w); } while (0)
    PK4(p0, 0, pa0); PK4(p0, 8, pa1); PK4(p1, 0, pa2); PK4(p1, 8, pa3);
#undef PK4
}
__device__ __forceinline__ void qkt(f32x16& p0, f32x16& p1, const char* Ks, const char* Qs, int qrow, int r32, int hi) {
    p0 = f32x16{}; p1 = f32x16{};
#pragma unroll
    for (int d0 = 0; d0 < 8; ++d0) { const int cb = (d0 * 16 + hi * 8) * 2;
        const bf16x8 b0 = *reinterpret_cast<const bf16x8*>(Ks + KSWZ(r32, cb));
        const bf16x8 b1 = *reinterpret_cast<const bf16x8*>(Ks + KSWZ(32 + r32, cb));
        const bf16x8 q = *reinterpret_cast<const bf16x8*>(Qs + KSWZ(qrow, cb));
        p0 = __builtin_amdgcn_mfma_f32_32x32x16_bf16(b0, q, p0, 0, 0, 0);
        p1 = __builtin_amdgcn_mfma_f32_32x32x16_bf16(b1, q, p1, 0, 0, 0); }
}
__device__ __forceinline__ int v_st(int k, int c) { const int kk = (k & ~0xC) | ((k & 4) << 1) | ((k & 8) >> 1); return ((kk >> 3) * 4 + (c >> 5)) * 512 + ((kk & 7) * 32 + (c & 31)) * 2; }
__device__ __forceinline__ int v_rd_base(int lane) { return ((lane & 3) << 3) | (((lane >> 2) & 3) << 6) | (((lane >> 4) & 1) << 5) | (((lane >> 5) & 1) << 8); }
constexpr int v_rd_off(int d0, int ks, int half) { return d0 * 512 + ks * 4096 + half * 2048; }
template <int OFF> __device__ __forceinline__ s16x4 tr_read(int vb) {
    s16x4 r; asm volatile("ds_read_b64_tr_b16 %0, %1 offset:%2" : "=&v"(r) : "v"(vb), "i"(OFF) : "memory"); return r;
}
template <int D0> __device__ __forceinline__ void pv_one(f32x16& od, int vb, bf16x8 pa0, bf16x8 pa1, bf16x8 pa2, bf16x8 pa3) {
    const s16x4 l0 = tr_read<v_rd_off(D0, 0, 0)>(vb), h0 = tr_read<v_rd_off(D0, 0, 1)>(vb), l1 = tr_read<v_rd_off(D0, 1, 0)>(vb), h1 = tr_read<v_rd_off(D0, 1, 1)>(vb);
    const s16x4 l2 = tr_read<v_rd_off(D0, 2, 0)>(vb), h2 = tr_read<v_rd_off(D0, 2, 1)>(vb), l3 = tr_read<v_rd_off(D0, 3, 0)>(vb), h3 = tr_read<v_rd_off(D0, 3, 1)>(vb);
    asm volatile("s_waitcnt lgkmcnt(0)" ::: "memory"); SBAR();
#define PK(L, H) (bf16x8){L[0], L[1], L[2], L[3], H[0], H[1], H[2], H[3]}
    od = __builtin_amdgcn_mfma_f32_32x32x16_bf16(pa0, PK(l0, h0), od, 0, 0, 0);
    od = __builtin_amdgcn_mfma_f32_32x32x16_bf16(pa1, PK(l1, h1), od, 0, 0, 0);
    od = __builtin_amdgcn_mfma_f32_32x32x16_bf16(pa2, PK(l2, h2), od, 0, 0, 0);
    od = __builtin_amdgcn_mfma_f32_32x32x16_bf16(pa3, PK(l3, h3), od, 0, 0, 0);
#undef PK
}
__device__ __forceinline__ void pv_d0(f32x16* o, int vb, bf16x8 pa0, bf16x8 pa1, bf16x8 pa2, bf16x8 pa3) {
    pv_one<0>(o[0], vb, pa0, pa1, pa2, pa3); pv_one<1>(o[1], vb, pa0, pa1, pa2, pa3); pv_one<2>(o[2], vb, pa0, pa1, pa2, pa3); pv_one<3>(o[3], vb, pa0, pa1, pa2, pa3);
}

__device__ __forceinline__ void attn_unit(const int tid, const int b, const int h, const int qb, const bf16_t* __restrict__ U, const float* __restrict__ ksum, bf16_t* __restrict__ Y, char* lds) {
    const int wid = tid >> 6, lane = tid & 63, r32 = lane & 31, hi = lane >> 5;
    char* V_lds = lds + OFF_V; char* K_lds = lds + OFF_K; char* KM = lds + OFF_KM;
    float* ws = (float*)(lds + OFF_WS) + wid * 64; float* li_l = ws; float* al_l = ws + 32;
    const bf16_t* Qb = U + (size_t)(b * SEQ + qb * 256) * DIN + COL_Q + h * HD;
    const bf16_t* Kh = U + (size_t)(b * SEQ) * DIN + COL_K + h * HD;
    const bf16_t* Vh = U + (size_t)(b * SEQ) * DIN + COL_V + h * HD;
    float m_reg = -1e30f, l_reg = 0; f32x16 o[4] = {};
    char* Q_lds = lds + OFF_Q; const int qrow = wid * QBLK + r32;
    { const int qr0 = tid >> 4, qc = (tid & 15) * 8;
#pragma unroll
      for (int i = 0; i < 8; ++i) { const int row = qr0 + 32 * i; *(bf16x8*)(Q_lds + KSWZ(row, qc * 2)) = *reinterpret_cast<const bf16x8*>(Qb + (size_t)row * DIN + qc); } }
    { const int n = tid >> 5, c4 = (tid & 31) * 4;
      const float* k0p = ksum + (size_t)((b * 16 + n) * 2) * 1024 + h * HD + c4;
      const f32x4 s0 = *(const f32x4*)k0p, s1 = *(const f32x4*)(k0p + 1024);
      u32x2 w; w.x = cvt_pk_bf16((s0[0] + s1[0]) * (1.f / 256.f), (s0[1] + s1[1]) * (1.f / 256.f)); w.y = cvt_pk_bf16((s0[2] + s1[2]) * (1.f / 256.f), (s0[3] + s1[3]) * (1.f / 256.f));
      *(u32x2*)(KM + KSWZ(n, c4 * 2)) = w;
      *(u32x2*)(KM + KSWZ(16 + n, c4 * 2)) = (u32x2){0u, 0u}; }
    __syncthreads();
    unsigned selmask = 0u;
    { f32x16 g = f32x16{};
#pragma unroll
      for (int d0 = 0; d0 < 8; ++d0) { const int cb = (d0 * 16 + hi * 8) * 2; const bf16x8 a = *reinterpret_cast<const bf16x8*>(KM + KSWZ(r32, cb)); const bf16x8 q = *reinterpret_cast<const bf16x8*>(Q_lds + KSWZ(qrow, cb)); g = __builtin_amdgcn_mfma_f32_32x32x16_bf16(a, q, g, 0, 0, 0); }
      float G[16];
#pragma unroll
      for (int r = 0; r < 8; ++r) { auto rr = __builtin_amdgcn_permlane32_swap(__float_as_uint(g[r]), __float_as_uint(g[r]), false, false);
          const float other = hi ? __uint_as_float(rr[0]) : __uint_as_float(rr[1]);
          const int nlo = (r & 3) + 8 * (r >> 2);
          G[nlo] = hi ? other : g[r]; G[nlo + 4] = hi ? g[r] : other; }
#pragma unroll
      for (int n = 0; n < 16; ++n) if (n >= qb) G[n] = -INFINITY;
      const int npick = qb < 3 ? qb : 3;
#pragma unroll
      for (int it = 0; it < 3; ++it) { if (it < npick) { float best = G[0]; int bi = 0;
#pragma unroll
          for (int n = 1; n < 16; ++n) if (G[n] > best) { best = G[n]; bi = n; }
          selmask |= 1u << bi;
#pragma unroll
          for (int n = 0; n < 16; ++n) if (n == bi) G[n] = -INFINITY; } } }
    const float slope = __builtin_amdgcn_exp2f(-(float)(h + 1)), slr = slope * (1.f / SCALE);
    const int qi = wid * QBLK + r32, tpos = qb * 256 + qi;
    const int NT = 4 * (qb + 1);
#define KST(j) ((j) < 4 ? qb * 256 + 64 * (j) : 64 * ((j) - 4))
#define LBV(j) ((j) < 4 ? ((j) > (wid >> 1) ? -1e30f : slr * (float)(64 * (j) + 4 * hi - qi)) : (((selmask >> (((j) - 4) >> 2)) & 1u) ? slr * (float)(64 * ((j) - 4) + 4 * hi - tpos) : -1e30f))
    const int vb0 = (int)(uintptr_t)V_lds + v_rd_base(lane);
    unsigned koff[2], voff[2];
#pragma unroll
    for (int i = 0; i < 2; ++i) { const int pc = wid * 2 + i;
        { const int row = 4 * pc + (lane >> 4), cc = lane & 15; koff[i] = (unsigned)(row * DIN * 2 + ((cc ^ (row & 7)) << 4)); }
        { const int st = 2 * pc + (lane >> 5), kk = (st >> 2) * 8 + ((lane & 31) >> 2), k = (kk & ~0xC) | ((kk & 4) << 1) | ((kk & 8) >> 1), col = 32 * (st & 3) + 8 * (lane & 3);
          voff[i] = (unsigned)(k * DIN * 2 + col * 2); } }
    const int wq = __builtin_amdgcn_readfirstlane(wid);
    LAS unsigned char* ldsL = (LAS unsigned char*)(unsigned)(uintptr_t)lds;
#define DMA(bb, k0) do { const char* kg = (const char*)(Kh + (size_t)(k0) * DIN); const char* vg = (const char*)(Vh + (size_t)(k0) * DIN); \
    _Pragma("unroll") for (int i_ = 0; i_ < 2; ++i_) { \
        __builtin_amdgcn_global_load_lds((const unsigned*)(kg + koff[i_]), (LAS unsigned*)(ldsL + OFF_K + (bb) * SHM_K + (wq * 2 + i_) * 1024), 16, 0, 0); \
        __builtin_amdgcn_global_load_lds((const unsigned*)(vg + voff[i_]), (LAS unsigned*)(ldsL + OFF_V + (bb) * SHM_V + (wq * 2 + i_) * 1024), 16, 0, 0); } } while (0)
#define DWAIT() do { asm volatile("s_waitcnt vmcnt(0)" ::: "memory"); __syncthreads(); } while (0)
#define RESC(a) do { if (__any((a) < 1.f)) { if (hi == 0) al_l[r32] = (a); asm volatile("s_waitcnt lgkmcnt(0)" ::: "memory"); \
    _Pragma("unroll") for (int d = 0; d < 4; ++d) _Pragma("unroll") for (int r = 0; r < 16; ++r) o[d][r] *= al_l[crow(r, hi)]; } } while (0)
    f32x16 p0, p1; float mn, al; bf16x8 pa0, pa1, pa2, pa3;
#define TILE(j, bb) do { SBAR(); qkt(p0, p1, K_lds + (bb) * SHM_K, Q_lds, qrow, r32, hi); \
        partialSM(p0, p1, m_reg, mn, al, slr, LBV(j), ((j) == (wid >> 1)) ? 1 + (wid & 1) : 0, r32 - 4 * hi); RESC(al); \
        finishSM(p0, p1, al, l_reg, pa0, pa1, pa2, pa3); SBAR(); \
        pv_d0(o, vb0 + (bb) * (int)SHM_V, pa0, pa1, pa2, pa3); } while (0)
    DMA(0, KST(0)); DWAIT();
    for (int j = 0; j < NT; j += 2) {
        DMA(1, KST(j + 1));
        TILE(j, 0);
        DWAIT();
        if (j + 2 < NT) DMA(0, KST(j + 2));
        TILE(j + 1, 1);
        DWAIT();
    }
#undef TILE
    if (hi == 0) li_l[r32] = l_reg; asm volatile("s_waitcnt lgkmcnt(0)" ::: "memory");
    float rli[16];
#pragma unroll
    for (int r = 0; r < 16; ++r) rli[r] = __builtin_amdgcn_rcpf(li_l[crow(r, hi)]);
    bf16_t* Ow = Y + (size_t)(b * SEQ + qb * 256 + wid * QBLK) * DM + 512 + h * HD;
#pragma unroll
    for (int r = 0; r < 16; ++r) { const int orow = crow(r, hi);
#pragma unroll
        for (int d0 = 0; d0 < 4; ++d0) { const float v = o[d0][r] * rli[r]; Ow[(size_t)orow * DM + d0 * 32 + r32] = (bf16_t)(cvt_pk_bf16(v, v) & 0xffffu); } }
    __syncthreads();
#undef KST
#undef LBV
#undef DMA
#undef DWAIT
#undef RESC
}
#undef KSWZ
#undef SBAR
}


#define XB_TMO      128
#define XB_XCNT(j)  (256  + 64 * (j))
#define XB_XSUB(j)  (1280 + 64 * (j))
#define XB_XGEN(j)  (2304 + 64 * (j))
#define XB_TOP      3328
#define XB_TOPGEN   3392
#define XCD_BAR_WORDS 3456
#define XB_SPIN_CAP (1u << 18)
__device__ __forceinline__ unsigned xb_ld(unsigned* p)              { return __hip_atomic_load(p, __ATOMIC_RELAXED, __HIP_MEMORY_SCOPE_AGENT); }
__device__ __forceinline__ unsigned xb_add(unsigned* p, unsigned v) { return __hip_atomic_fetch_add(p, v, __ATOMIC_RELAXED, __HIP_MEMORY_SCOPE_AGENT); }
__device__ __forceinline__ unsigned xb_xcc_id() { return (unsigned)__builtin_amdgcn_s_getreg((3 << 11) | 20) & 0xFu; }
#define XB_SPIN(cond, bar) do { unsigned _sp = 0; while (cond) { __builtin_amdgcn_s_sleep(1); \
    if ((++_sp & 255u) == 0u) { if (xb_ld(&(bar)[XB_TMO])) break; if (_sp > XB_SPIN_CAP) { atomicAdd(&(bar)[XB_TMO], 1u); break; } } } } while (0)
struct XcdBarrier { unsigned* bar; unsigned x; volatile LAS unsigned* st; };
__device__ __forceinline__ XcdBarrier xcd_barrier_post(unsigned* bar, volatile LAS unsigned* st) {
    XcdBarrier b; b.bar = bar; b.x = xb_xcc_id(); b.st = st;
    if (threadIdx.x == 0) (void)xb_add(&bar[XB_XCNT(b.x)], 1u);
    return b;
}
__device__ __forceinline__ void xcd_barrier_complete(unsigned* bar, unsigned x, unsigned& nloc, unsigned& nx) {
    const unsigned G = gridDim.x * gridDim.y * gridDim.z;
    unsigned sum, cnt, mine, sp = 0u;
    for (;;) {
        sum = 0u; cnt = 0u; mine = 0u;
#pragma unroll
        for (unsigned j = 0; j < 16; ++j) { const unsigned c = xb_ld(&bar[XB_XCNT(j)]); sum += c; cnt += (c > 0u) ? 1u : 0u; mine = (j == x) ? c : mine; }
        if (sum == G) break;
        __builtin_amdgcn_s_sleep(1);
        if ((++sp & 255u) == 0u) { if (xb_ld(&bar[XB_TMO])) break; if (sp > XB_SPIN_CAP) { atomicAdd(&bar[XB_TMO], 1u); break; } }
    }
    nloc = mine > 0u ? mine : 1u; nx = cnt > 0u ? cnt : 1u;
}
__device__ __forceinline__ void xcd_barrier(const XcdBarrier& b) {
    asm volatile("s_waitcnt vmcnt(0)" ::: "memory");
    __syncthreads();
    if (threadIdx.x == 0) {
        unsigned* bar = b.bar;
        __builtin_amdgcn_s_waitcnt(0);
        unsigned nloc = b.st[0], nx = b.st[1];
        if (nloc == 0u) { xcd_barrier_complete(bar, b.x, nloc, nx); b.st[0] = nloc; b.st[1] = nx; }
        const unsigned old = xb_add(&bar[XB_XSUB(b.x)], 1u);
        const unsigned gen = old / nloc;
        if (old + 1u == (gen + 1u) * nloc) {
            __builtin_amdgcn_fence(__ATOMIC_RELEASE, "agent");
            asm volatile("s_waitcnt vmcnt(0)" ::: "memory");
            const unsigned og = xb_add(&bar[XB_TOP], 1u);
            const unsigned tg = og / nx;
            if (og + 1u == (tg + 1u) * nx) xb_add(&bar[XB_TOPGEN], 1u);
            else XB_SPIN(xb_ld(&bar[XB_TOPGEN]) == tg, bar);
            __builtin_amdgcn_fence(__ATOMIC_ACQUIRE, "agent");
            xb_add(&bar[XB_XGEN(b.x)], 1u);
            asm volatile("s_waitcnt vmcnt(0)" ::: "memory");
        } else {
            XB_SPIN(xb_ld(&bar[XB_XGEN(b.x)]) == gen, bar);
            __builtin_amdgcn_fence(__ATOMIC_ACQUIRE, "agent");
            asm volatile("s_waitcnt vmcnt(0)" ::: "memory");
        }
    }
    __syncthreads();
}

struct Params { const float* in[18]; float* out; unsigned char* ws; int ph_lo, ph_hi; };
enum { IN_X = 0, IN_N1G, IN_WIN, IN_CAW, IN_CCW, IN_CCB, IN_LNG, IN_LNB, IN_WOUT, IN_N2G, IN_RGW, IN_RGB, IN_REW, IN_REB, IN_WG, IN_WU, IN_WD, IN_FG };

__device__ __forceinline__ void transpose_item(const float* __restrict__ W, int K, int N, bf16_t* __restrict__ WT, size_t dstb, int rmul, int radd, const float* __restrict__ scale,
                                               LAS float* scr, int item, int lane) {
    const int nkb = K / 64, nnb = N / 64, per = nkb * nnb, bt = item / per, rem = item - bt * per, kb = rem / nnb, nb = rem - kb * nnb, k0 = kb * 64, n0 = nb * 64;
    const float* src = W + (size_t)bt * K * N;
    bf16_t* dst = WT + (size_t)bt * dstb;
#pragma unroll 4
    for (int i = 0; i < 16; ++i) { const int k = 4 * i + (lane >> 4), n4 = (lane & 15) * 4; const f32x4 v = *(const f32x4*)(src + (size_t)(k0 + k) * N + n0 + n4);
        LAS float* s = scr + k * 65 + n4; s[0] = v[0]; s[1] = v[1]; s[2] = v[2]; s[3] = v[3]; }
    asm volatile("s_waitcnt lgkmcnt(0)" ::: "memory");
    const int c = lane & 7, nn = lane >> 3;
    float sc8[8];
#pragma unroll
    for (int i = 0; i < 8; ++i) sc8[i] = scale ? scale[k0 + 8 * c + i] : 1.f;
#pragma unroll
    for (int j = 0; j < 8; ++j) { const int n = nn + 8 * j; const LAS float* s = scr + (8 * c) * 65 + n;
        u32x4 o; o.x = cvt_pk_bf16(s[0] * sc8[0], s[65] * sc8[1]); o.y = cvt_pk_bf16(s[130] * sc8[2], s[195] * sc8[3]); o.z = cvt_pk_bf16(s[260] * sc8[4], s[325] * sc8[5]); o.w = cvt_pk_bf16(s[390] * sc8[6], s[455] * sc8[7]);
        *(u32x4*)(dst + (size_t)((n0 + n) * rmul + radd) * K + k0 + 8 * c) = o; }
    asm volatile("s_waitcnt lgkmcnt(0)" ::: "memory");
}

__device__ __forceinline__ void norm_row(const float* __restrict__ xrow, const bf16_t* __restrict__ y0, float g0, const bf16_t* __restrict__ y1, float g1, float* __restrict__ xout,
                                         bf16_t* __restrict__ hout, float* __restrict__ fout, const float* __restrict__ fgain, int lane) {
    f32x4 v[8]; float ss = 0.f;
#pragma unroll
    for (int j = 0; j < 8; ++j) { v[j] = *((const f32x4*)xrow + 64 * j + lane);
        if (y0) { const u32x2 a = *((const u32x2*)y0 + 64 * j + lane), c = *((const u32x2*)y1 + 64 * j + lane);
            v[j][0] += g0 * bf_lo(a.x) + g1 * bf_lo(c.x); v[j][1] += g0 * bf_hi(a.x) + g1 * bf_hi(c.x); v[j][2] += g0 * bf_lo(a.y) + g1 * bf_lo(c.y); v[j][3] += g0 * bf_hi(a.y) + g1 * bf_hi(c.y); }
        ss += (v[j][0] * v[j][0] + v[j][1] * v[j][1]) + (v[j][2] * v[j][2] + v[j][3] * v[j][3]); }
    const float rs = 1.0f / sqrtf(wave_sum(ss) * (1.f / DM) + EPS);
#pragma unroll
    for (int j = 0; j < 8; ++j) {
        if (xout) *((f32x4*)xout + 64 * j + lane) = v[j];
        if (fout) { const f32x4 g = *((const f32x4*)fgain + 64 * j + lane); *((f32x4*)fout + 64 * j + lane) = v[j] * rs * g; }
        else { u32x2 w; w.x = cvt_pk_bf16(v[j][0] * rs, v[j][1] * rs); w.y = cvt_pk_bf16(v[j][2] * rs, v[j][3] * rs); *((u32x2*)hout + 64 * j + lane) = w; } }
}

__global__ void __launch_bounds__(NTHREADS, 2) fwd_kernel(Params p) {
    extern __shared__ __attribute__((aligned(16))) unsigned char lds_raw[];
    LAS unsigned char* lds = (LAS unsigned char*)lds_raw;
    cg::grid_group grid = cg::this_grid();
    const int G = gridDim.x, bx = blockIdx.x;
    const int lo = p.ph_lo, hi = p.ph_hi;
    int ph = 0;
    volatile LAS unsigned* bar_st = (volatile LAS unsigned*)(lds + MISC_OFF + 4096);
    if (threadIdx.x < 2) bar_st[threadIdx.x] = 0u;
    __syncthreads();
    XcdBarrier xbar; xbar.bar = (unsigned*)(p.ws + WS_CTL) + 1024; xbar.x = 0; xbar.st = bar_st;
    if (hi - lo > 1) xbar = xcd_barrier_post((unsigned*)(p.ws + WS_CTL) + 1024, bar_st);
#ifndef PH_MASK
#define PH_MASK 0x7f
#endif
#define PHASE_BEGIN(k) if (((PH_MASK >> (k)) & 1) && lo <= ph && ph < hi) { \
    int tid = threadIdx.x; asm volatile("" : "+v"(tid)); unsigned char* ws = p.ws; asm volatile("" : "+s"(ws)); ws = (unsigned char*)(__attribute__((address_space(1))) unsigned char*)ws; \
    const int lane = tid & 63, wave = __builtin_amdgcn_readfirstlane(tid >> 6); \
    const int vcu = (G % 8 == 0) ? (bx % 8) * (G / 8) + bx / 8 : bx; const int gw = vcu * NWAVES + wave, NGW = G * NWAVES; \
    bf16_t* const Ub = (bf16_t*)(ws + WS_U); bf16_t* const YM = (bf16_t*)(ws + WS_U); bf16_t* const Yc = (bf16_t*)(ws + WS_Y); bf16_t* const Hb = (bf16_t*)(ws + WS_H); \
    bf16_t* const HMb = (bf16_t*)(ws + WS_HM); float* const KS = (float*)(ws + WS_KS); float* const RS = (float*)(ws + WS_RS); unsigned* const REC = (unsigned*)(ws + WS_REC); \
    int* const TM = (int*)(ws + WS_TM); int* const CNT = (int*)(ws + WS_CTL); float* const XR = p.out; \
    LAS int* const m_tile_e = (LAS int*)(lds + MISC_OFF); LAS int* const m_tstart = m_tile_e + MAXTILES; LAS int* const m_cnt = m_tstart + 40; \
    unsigned char* const wl = ws + WS_W0 + (size_t)l * SZ_LAYER; int* const cntg = CNT + l * 32; \
    (void)lane; (void)wave; (void)gw; (void)NGW; (void)Ub; (void)YM; (void)Yc; (void)Hb; (void)HMb; (void)KS; (void)RS; (void)REC; (void)TM; (void)XR; (void)m_tile_e; (void)m_tstart; (void)m_cnt; (void)wl; (void)cntg;
#define PHASE_END   if (ph + 1 < hi) { if (ph == 0) grid.sync(); else xcd_barrier(xbar); } } ++ph;

    { const int l = 0;
    PHASE_BEGIN(0)
    {
        LAS float* scr = (LAS float*)(lds + wave * 16640);
        for (int l = 0; l < DEPTH; ++l) {
            unsigned char* wl = ws + WS_W0 + (size_t)l * SZ_LAYER;
            constexpr int I_IN = (DM / 64) * (DIN / 64), I_OUT = (DM / 64) * (DM / 64), I_G = NEXP * (DM / 64) * (DEXP / 64), I_D = NEXP * (DEXP / 64) * (DM / 64), I_ALL = I_IN + I_OUT + 2 * I_G + I_D;
            for (int it = gw; it < I_ALL; it += NGW) {
                int r = it;
                if (r < I_IN) { transpose_item(p.in[IN_WIN] + (size_t)l * DM * DIN, DM, DIN, (bf16_t*)(wl + OFF_WIN), 0, 1, 0, p.in[IN_N1G] + l * DM, scr, r, lane); continue; } r -= I_IN;
                if (r < I_OUT) { transpose_item(p.in[IN_WOUT] + (size_t)l * DM * DM, DM, DM, (bf16_t*)(wl + OFF_WOUT), 0, 1, 0, nullptr, scr, r, lane); continue; } r -= I_OUT;
                if (r < I_G) { transpose_item(p.in[IN_WG] + (size_t)l * NEXP * DM * DEXP, DM, DEXP, (bf16_t*)(wl + OFF_WGU), (size_t)1024 * DM, 2, 0, p.in[IN_N2G] + l * DM, scr, r, lane); continue; } r -= I_G;
                if (r < I_G) { transpose_item(p.in[IN_WU] + (size_t)l * NEXP * DM * DEXP, DM, DEXP, (bf16_t*)(wl + OFF_WGU), (size_t)1024 * DM, 2, 1, p.in[IN_N2G] + l * DM, scr, r, lane); continue; } r -= I_G;
                transpose_item(p.in[IN_WD] + (size_t)l * NEXP * DEXP * DM, DEXP, DM, (bf16_t*)(wl + OFF_WD), (size_t)DM * DEXP, 1, 0, nullptr, scr, r, lane);
            }
            bf16_t* RW = (bf16_t*)(wl + OFF_RW);
            for (int i = vcu * NTHREADS + tid; i < NRW * (DM / 8); i += G * NTHREADS) { const int n = i / (DM / 8), k8 = (i % (DM / 8)) * 8; float v[8];
#pragma unroll
                for (int j = 0; j < 8; ++j) { const int k = k8 + j; const float g = p.in[IN_N2G][l * DM + k];
                    v[j] = n < 4 ? g * p.in[IN_RGW][(size_t)l * DM * 4 + k * 4 + n] : (n < 36 ? g * p.in[IN_REW][(size_t)l * DM * 32 + k * 32 + (n - 4)] : 0.f); }
                u32x4 o; o.x = cvt_pk_bf16(v[0], v[1]); o.y = cvt_pk_bf16(v[2], v[3]); o.z = cvt_pk_bf16(v[4], v[5]); o.w = cvt_pk_bf16(v[6], v[7]);
                *(u32x4*)(RW + (size_t)n * DM + k8) = o; }
        }
        for (int m = gw; m < T_TOK; m += NGW) norm_row(p.in[IN_X] + (size_t)m * DM, nullptr, 0.f, nullptr, 0.f, nullptr, Hb + (size_t)m * DM, nullptr, nullptr, lane);
        __syncthreads();
    }
    PHASE_END
    }

    for (int l = 0; l < DEPTH; ++l) {
        PHASE_BEGIN(1)
        {
            pg8::DenseSched S{(const char*)Hb, (const char*)(wl + OFF_WIN), T_TOK / 256, DIN / 256, G, bx, DM};
            pg8::EpiInProj E{Ub, KS};
            pg8::gemm_phase(lds, tid, DM, S, E);
        }
        PHASE_END
        PHASE_BEGIN(2)
        {
            for (int i = vcu; i < 256; i += G) { const int bh = i >> 3, s = i & 7;
                for (int k = 0; k < 2; ++k) att::attn_unit(tid, bh >> 3, bh & 7, k ? s : 15 - s, Ub, KS, Yc, (char*)lds_raw); }
#ifndef NO_CONV
            { const float* cw = p.in[IN_CAW] + (size_t)l * 3 * 512;
              for (int it = vcu; it < T_TOK / 64; it += G) { const int c8 = (tid & 63) * 8, tg0 = it * 64 + (tid >> 6) * 8, bstart = tg0 & ~(SEQ - 1);
                float w0[8], w1[8], w2[8];
#pragma unroll
                for (int j = 0; j < 8; ++j) { w0[j] = cw[c8 + j]; w1[j] = cw[512 + c8 + j]; w2[j] = cw[1024 + c8 + j]; }
                float z[10][8];
#pragma unroll
                for (int i = 0; i < 10; ++i) { const int tt = tg0 - 2 + i;
                    if (tt >= bstart) { const u32x4 a = *(const u32x4*)(Ub + (size_t)tt * DIN + COL_CG + c8), c = *(const u32x4*)(Ub + (size_t)tt * DIN + COL_XV + c8);
                        z[i][0] = bf_lo(a.x) * bf_lo(c.x); z[i][1] = bf_hi(a.x) * bf_hi(c.x); z[i][2] = bf_lo(a.y) * bf_lo(c.y); z[i][3] = bf_hi(a.y) * bf_hi(c.y);
                        z[i][4] = bf_lo(a.z) * bf_lo(c.z); z[i][5] = bf_hi(a.z) * bf_hi(c.z); z[i][6] = bf_lo(a.w) * bf_lo(c.w); z[i][7] = bf_hi(a.w) * bf_hi(c.w); }
                    else {
#pragma unroll
                        for (int j = 0; j < 8; ++j) z[i][j] = 0.f; } }
#pragma unroll
                for (int o = 0; o < 8; ++o) { const int tt = tg0 + o; const u32x4 bg = *(const u32x4*)(Ub + (size_t)tt * DIN + COL_BG + c8); float y[8];
#pragma unroll
                    for (int j = 0; j < 8; ++j) y[j] = w0[j] * z[o][j] + w1[j] * z[o + 1][j] + w2[j] * z[o + 2][j];
                    u32x4 w; w.x = cvt_pk_bf16(bf_lo(bg.x) * y[0], bf_hi(bg.x) * y[1]); w.y = cvt_pk_bf16(bf_lo(bg.y) * y[2], bf_hi(bg.y) * y[3]);
                    w.z = cvt_pk_bf16(bf_lo(bg.z) * y[4], bf_hi(bg.z) * y[5]); w.w = cvt_pk_bf16(bf_lo(bg.w) * y[6], bf_hi(bg.w) * y[7]);
                    *(u32x4*)(Yc + (size_t)tt * DM + c8) = w; } } }
            { const float* cw = p.in[IN_CCW] + (size_t)l * 31 * 512; const float* cb = p.in[IN_CCB] + l * 512; const float* lg = p.in[IN_LNG] + l * 512; const float* lb = p.in[IN_LNB] + l * 512;
              LAS float* hh = (LAS float*)lds; LAS float* co = hh + 46 * 512;
              for (int it = vcu; it < T_TOK / 16; it += G) { const int t0 = it * 16, bstart = t0 & ~(SEQ - 1);
                { const int c8 = (tid & 63) * 8;
                  for (int i = tid >> 6; i < 46; i += 8) { const int tt = t0 - 30 + i; float v[8];
                    if (tt >= bstart) { const u32x4 a = *(const u32x4*)(Ub + (size_t)tt * DIN + COL_CA + c8), g = *(const u32x4*)(Ub + (size_t)tt * DIN + COL_CGATE + c8);
                        v[0] = bf_lo(a.x) * fast_sigmoid(bf_lo(g.x)); v[1] = bf_hi(a.x) * fast_sigmoid(bf_hi(g.x)); v[2] = bf_lo(a.y) * fast_sigmoid(bf_lo(g.y)); v[3] = bf_hi(a.y) * fast_sigmoid(bf_hi(g.y));
                        v[4] = bf_lo(a.z) * fast_sigmoid(bf_lo(g.z)); v[5] = bf_hi(a.z) * fast_sigmoid(bf_hi(g.z)); v[6] = bf_lo(a.w) * fast_sigmoid(bf_lo(g.w)); v[7] = bf_hi(a.w) * fast_sigmoid(bf_hi(g.w)); }
                    else {
#pragma unroll
                        for (int j = 0; j < 8; ++j) v[j] = 0.f; }
                    *(LAS f32x4*)(hh + i * 512 + c8) = (f32x4){v[0], v[1], v[2], v[3]}; *(LAS f32x4*)(hh + i * 512 + c8 + 4) = (f32x4){v[4], v[5], v[6], v[7]}; } }
                __syncthreads();
                { const int c = tid; float w[31];
#pragma unroll
                  for (int j = 0; j < 31; ++j) w[j] = cw[j * 512 + c];
                  const float bias = cb[c];
                  float win[46];
#pragma unroll
                  for (int i = 0; i < 46; ++i) win[i] = hh[i * 512 + c];
#pragma unroll
                  for (int o = 0; o < 16; ++o) { float a = bias;
#pragma unroll
                      for (int j = 0; j < 31; ++j) a = fmaf(w[j], win[o + j], a);
                      co[o * 512 + c] = a; } }
                __syncthreads();
                { const int c8 = lane * 8;
                  f32x4 ga = *(const f32x4*)(lg + c8), gb = *(const f32x4*)(lg + c8 + 4), ba = *(const f32x4*)(lb + c8), bb = *(const f32x4*)(lb + c8 + 4);
#pragma unroll
                  for (int q = 0; q < 2; ++q) { const int o = wave * 2 + q; const f32x4 xa = *(const LAS f32x4*)(co + o * 512 + c8), xb = *(const LAS f32x4*)(co + o * 512 + c8 + 4);
                    const float mu = wave_sum((xa[0] + xa[1]) + (xa[2] + xa[3]) + (xb[0] + xb[1]) + (xb[2] + xb[3])) * (1.f / 512.f);
                    const f32x4 da = xa - mu, db = xb - mu;
                    const float var = wave_sum((da[0] * da[0] + da[1] * da[1]) + (da[2] * da[2] + da[3] * da[3]) + (db[0] * db[0] + db[1] * db[1]) + (db[2] * db[2] + db[3] * db[3])) * (1.f / 512.f);
                    const float rstd = 1.0f / sqrtf(var + EPS);
                    f32x4 ya = da * rstd * ga + ba, yb = db * rstd * gb + bb;
#pragma unroll
                    for (int j = 0; j < 4; ++j) { ya[j] = ya[j] * fast_sigmoid(ya[j]); yb[j] = yb[j] * fast_sigmoid(yb[j]); }
                    u32x4 w; w.x = cvt_pk_bf16(ya[0], ya[1]); w.y = cvt_pk_bf16(ya[2], ya[3]); w.z = cvt_pk_bf16(yb[0], yb[1]); w.w = cvt_pk_bf16(yb[2], yb[3]);
                    *(u32x4*)(Yc + (size_t)(t0 + o) * DM + 1536 + c8) = w; } }
                __syncthreads();
              } }
#endif
        }
        PHASE_END
        PHASE_BEGIN(3)
        {

#ifdef ATT_CHECK
            if (l == ATT_CHECK) {
                LAS float* qs = (LAS float*)(lds + wave * 4608); LAS float* ps = qs + 128;
                const float SC = 0.088388347648318440f;
                for (int sidx = gw; sidx < 4096; sidx += NGW) {
                    const int b = sidx & 3, h = (sidx >> 2) & 7; const int t = (int)((((unsigned)sidx * 2654435761u) >> 12) & 4095u);
                    const int qblk = t >> 8; const float slope = exp2f(-(float)(h + 1));
                    const bf16_t* urow = Ub + (size_t)(b * SEQ + t) * DIN;
                    for (int d = lane; d < 128; d += 64) qs[d] = __uint_as_float((unsigned)urow[COL_Q + h * HD + d] << 16) * SC;
                    asm volatile("s_waitcnt lgkmcnt(0)" ::: "memory");
                    float gate[16];
#pragma unroll
                    for (int n = 0; n < 16; ++n) gate[n] = -1e30f;
                    for (int n = 0; n < qblk; ++n) { float sacc = 0.f;
                        for (int kk = lane; kk < 256; kk += 64) { const bf16_t* kr = Ub + (size_t)(b * SEQ + n * 256 + kk) * DIN + COL_K + h * HD; float dsum = 0.f;
                            for (int c = 0; c < 16; ++c) { const u32x4 w = *(const u32x4*)(kr + 8 * c);
                                dsum += qs[8 * c] * bf_lo(w.x) + qs[8 * c + 1] * bf_hi(w.x) + qs[8 * c + 2] * bf_lo(w.y) + qs[8 * c + 3] * bf_hi(w.y) + qs[8 * c + 4] * bf_lo(w.z) + qs[8 * c + 5] * bf_hi(w.z) + qs[8 * c + 6] * bf_lo(w.w) + qs[8 * c + 7] * bf_hi(w.w); }
                            sacc += dsum; }
                        const float gsum = wave_sum(sacc) * (1.f / 256.f);
#pragma unroll
                        for (int m = 0; m < 16; ++m) if (m == n) gate[m] = gsum; }
                    int sel[3] = {-1, -1, -1}; float sv[4] = {-1e30f, -1e30f, -1e30f, -1e30f};
                    { float gcopy[16];
#pragma unroll
                      for (int n = 0; n < 16; ++n) gcopy[n] = gate[n];
                      for (int it = 0; it < 4; ++it) { float best = gcopy[0]; int bi = 0;
#pragma unroll
                          for (int n = 1; n < 16; ++n) if (gcopy[n] > best) { best = gcopy[n]; bi = n; }
                          if (it < 3) sel[it] = bi; sv[it] = best;
#pragma unroll
                          for (int n = 0; n < 16; ++n) if (n == bi) gcopy[n] = -3e38f; } }
                    const int nsel = qblk < 3 ? qblk : 3;
                    const bool neartie = (qblk > 3) && (sv[2] - sv[3] < 1.5e-3f);
                    float mx = -1e30f;
                    for (int r = 0; r < 4; ++r) { const bool own = (r == 3); const int blkn = own ? qblk : sel[r]; const bool valid = own || r < nsel;
                        for (int kk = lane; kk < 256; kk += 64) { float lg = -1e30f;
                            if (valid) { const int kpos = blkn * 256 + kk;
                                if (!own || kpos <= t) { const bf16_t* kr = Ub + (size_t)(b * SEQ + kpos) * DIN + COL_K + h * HD; float dsum = 0.f;
                                    for (int c = 0; c < 16; ++c) { const u32x4 w = *(const u32x4*)(kr + 8 * c);
                                        dsum += qs[8 * c] * bf_lo(w.x) + qs[8 * c + 1] * bf_hi(w.x) + qs[8 * c + 2] * bf_lo(w.y) + qs[8 * c + 3] * bf_hi(w.y) + qs[8 * c + 4] * bf_lo(w.z) + qs[8 * c + 5] * bf_hi(w.z) + qs[8 * c + 6] * bf_lo(w.w) + qs[8 * c + 7] * bf_hi(w.w); }
                                    lg = dsum - slope * (float)(t - kpos); } }
                            ps[r * 256 + kk] = lg; mx = fmaxf(mx, lg); } }
#pragma unroll
                    for (int o = 1; o < 64; o <<= 1) mx = fmaxf(mx, __shfl_xor(mx, o));
                    float se = 0.f;
                    for (int i = lane; i < 1024; i += 64) { const float e = (ps[i] > -1e29f) ? __expf(ps[i] - mx) : 0.f; ps[i] = e; se += e; }
                    se = wave_sum(se);
                    asm volatile("s_waitcnt lgkmcnt(0)" ::: "memory");
                    float o0 = 0.f, o1 = 0.f;
                    for (int r = 0; r < 4; ++r) { const bool own = (r == 3); const int blkn = own ? qblk : sel[r]; const bool valid = own || r < nsel;
                        if (valid) for (int kk = 0; kk < 256; ++kk) { const float pp = ps[r * 256 + kk];
                            if (pp != 0.f) { const unsigned w = *(const unsigned*)(Ub + (size_t)(b * SEQ + blkn * 256 + kk) * DIN + COL_V + h * HD + 2 * lane); o0 += pp * bf_lo(w); o1 += pp * bf_hi(w); } } }
                    o0 /= se; o1 /= se;
                    const unsigned yw = *(const unsigned*)(Yc + (size_t)(b * SEQ + t) * DM + 512 + h * HD + 2 * lane);
                    float err = fmaxf(fabsf(o0 - bf_lo(yw)), fabsf(o1 - bf_hi(yw))), ref = fmaxf(fabsf(o0), fabsf(o1));
                    const bool isnan_ = !(err == err);
#pragma unroll
                    for (int o = 1; o < 64; o <<= 1) { err = fmaxf(err, __shfl_xor(err, o)); ref = fmaxf(ref, __shfl_xor(ref, o)); }
                    const bool bad = __any(isnan_) || !(err <= 0.03f * ref + 1e-4f);
                    if (lane == 0) { if (neartie) atomicAdd(&CNT[514], 1); else { atomicAdd(&CNT[513], 1); if (bad) atomicAdd(&CNT[512], 1); } }
                    asm volatile("s_waitcnt lgkmcnt(0)" ::: "memory");
                }
                __syncthreads();
            }
#endif
            pg8::DenseSched S{(const char*)Yc, (const char*)(wl + OFF_WOUT), T_TOK / 256, DM / 256, G, bx, DM};
            pg8::EpiResF32 E{l == 0 ? p.in[IN_X] : (const float*)XR, XR};
            pg8::gemm_phase(lds, tid, DM, S, E);
        }
        PHASE_END
        PHASE_BEGIN(4)
        {
            const bf16_t* RW = (const bf16_t*)(wl + OFF_RW);
            const float* rgb = p.in[IN_RGB] + l * 4; const float* reb = p.in[IN_REB] + l * 32;
            LAS float* lgs = (LAS float*)(lds + wave * 4096);
            const int r16 = lane & 15, q = lane >> 4;
            for (int task = gw; task < T_TOK / 16; task += NGW) {
                const int row = task * 16 + r16;
                const float* xr = XR + (size_t)row * DM + 8 * q; bf16_t* hr = Hb + (size_t)row * DM + 8 * q;
                f32x4 acc[3] = {(f32x4){0.f, 0.f, 0.f, 0.f}, (f32x4){0.f, 0.f, 0.f, 0.f}, (f32x4){0.f, 0.f, 0.f, 0.f}}; float ss = 0.f;
#pragma unroll 4
                for (int ks = 0; ks < DM / 32; ++ks) { const f32x4 xa = *(const f32x4*)(xr + ks * 32), xb = *(const f32x4*)(xr + ks * 32 + 4);
                    ss += (xa[0] * xa[0] + xa[1] * xa[1]) + (xa[2] * xa[2] + xa[3] * xa[3]) + (xb[0] * xb[0] + xb[1] * xb[1]) + (xb[2] * xb[2] + xb[3] * xb[3]);
                    u32x4 w; w.x = cvt_pk_bf16(xa[0], xa[1]); w.y = cvt_pk_bf16(xa[2], xa[3]); w.z = cvt_pk_bf16(xb[0], xb[1]); w.w = cvt_pk_bf16(xb[2], xb[3]);
                    *(u32x4*)(hr + ks * 32) = w; const bf16x8 a = *reinterpret_cast<const bf16x8*>(&w);
#pragma unroll
                    for (int nb = 0; nb < 3; ++nb) { const bf16x8 bfr = *reinterpret_cast<const bf16x8*>(RW + (size_t)(nb * 16 + r16) * DM + ks * 32 + 8 * q); acc[nb] = __builtin_amdgcn_mfma_f32_16x16x32_bf16(a, bfr, acc[nb], 0, 0, 0); } }
                ss += __shfl_xor(ss, 16); ss += __shfl_xor(ss, 32);
                const float rs = 1.0f / sqrtf(ss * (1.f / DM) + EPS);
#pragma unroll
                for (int nb = 0; nb < 3; ++nb)
#pragma unroll
                    for (int r = 0; r < 4; ++r) lgs[(4 * q + r) * 49 + nb * 16 + r16] = acc[nb][r];
                asm volatile("s_waitcnt lgkmcnt(0)" ::: "memory");
                if (lane < 16) {
                    const LAS float* lr = lgs + lane * 49;
                    float gl[4];
#pragma unroll
                    for (int j = 0; j < 4; ++j) gl[j] = lr[j] * rs + rgb[j];
                    int grp = 0; float gm = gl[0];
#pragma unroll
                    for (int j = 1; j < 4; ++j) if (gl[j] > gm) { gm = gl[j]; grp = j; }
                    float gsum = 0.f;
#pragma unroll
                    for (int j = 0; j < 4; ++j) gsum += __expf(gl[j] - gm);
                    const float pgrp = 1.0f / gsum;
                    float el[8];
#pragma unroll
                    for (int j = 0; j < 8; ++j) el[j] = lr[4 + grp * 8 + j] * rs + reb[grp * 8 + j];
                    int i1 = 0; float m1 = el[0];
#pragma unroll
                    for (int j = 1; j < 8; ++j) if (el[j] > m1) { m1 = el[j]; i1 = j; }
                    int i2 = -1; float m2 = -INFINITY;
#pragma unroll
                    for (int j = 0; j < 8; ++j) if (j != i1 && el[j] > m2) { m2 = el[j]; i2 = j; }
                    const float e2 = __expf(m2 - m1), inv = 1.0f / (1.0f + e2);
                    const float g1 = pgrp * inv, g2 = pgrp * e2 * inv;
                    const int E1 = grp * 8 + i1, E2 = grp * 8 + i2;
                    const int pos1 = atomicAdd(&cntg[E1], 1), pos2 = atomicAdd(&cntg[E2], 1);
                    TM[E1 * T_TOK + pos1] = row; TM[E2 * T_TOK + pos2] = row;
                    u32x4 ra = {(unsigned)E1, (unsigned)pos1, (unsigned)E2, (unsigned)pos2}; u32x4 rb = {__float_as_uint(g1), __float_as_uint(g2), 0u, 0u};
                    *(u32x4*)(REC + (size_t)row * 8) = ra; *(u32x4*)(REC + (size_t)row * 8 + 4) = rb;
                    RS[row] = rs;
                }
                asm volatile("s_waitcnt lgkmcnt(0)" ::: "memory");
            }
        }
        PHASE_END
        for (int pass = 0; pass < 2; ++pass) {
            PHASE_BEGIN(5)
            {
                if (tid < 64) { const int c = tid < NEXP ? __hip_atomic_load(&cntg[tid], __ATOMIC_RELAXED, __HIP_MEMORY_SCOPE_AGENT) : 0; const int nt_ = (c + 255) >> 8; int incl = nt_;
#pragma unroll
                    for (int o = 1; o < 64; o <<= 1) { const int v = __shfl_up(incl, o); if (lane >= o) incl += v; }
                    const int st = incl - nt_;
                    if (tid < NEXP) { m_tstart[tid] = st; m_cnt[tid] = c; for (int k = 0; k < nt_; ++k) m_tile_e[st + k] = tid; }
                    if (tid == NEXP) m_tstart[NEXP] = st; }
                __syncthreads();
                const int nM = m_tstart[NEXP];
#ifndef PASS_MASK
#define PASS_MASK 3
#endif
                if ((PASS_MASK & 1) && pass == 0) {
                    pg8::MoeSched S{(const char*)Hb, (const char*)(wl + OFF_WGU), (size_t)1024 * DM * 2, nM, 1024 / 256, G, bx, DM, true, m_tile_e, m_tstart, m_cnt, TM};
                    pg8::EpiSwiglu E{HMb, RS, TM, m_tstart, m_cnt};
                    pg8::gemm_phase(lds, tid, DM, S, E);
                } else if (PASS_MASK & 2) {
                    pg8::MoeSched S{(const char*)HMb, (const char*)(wl + OFF_WD), (size_t)DM * DEXP * 2, nM, DM / 256, G, bx, DEXP, false, m_tile_e, m_tstart, m_cnt, TM};
                    pg8::EpiBf16 E{YM, DM};
                    pg8::gemm_phase(lds, tid, DEXP, S, E);
                }
                __syncthreads();
            }
            PHASE_END
        }
        PHASE_BEGIN(6)
        {
            int tst; { const int c = lane < NEXP ? __hip_atomic_load(&cntg[lane], __ATOMIC_RELAXED, __HIP_MEMORY_SCOPE_AGENT) : 0; const int nt_ = (c + 255) >> 8; int incl = nt_;
#pragma unroll
                for (int o = 1; o < 64; o <<= 1) { const int v = __shfl_up(incl, o); if (lane >= o) incl += v; }
                tst = incl - nt_; }
            const bool fin = (l == DEPTH - 1);
            for (int m = gw; m < T_TOK; m += NGW) {
                const u32x4 ra = *(const u32x4*)(REC + (size_t)m * 8); const u32x2 rb = *(const u32x2*)(REC + (size_t)m * 8 + 4);
                const int r0 = __shfl(tst, (int)ra.x) * 256 + (int)ra.y, r1 = __shfl(tst, (int)ra.z) * 256 + (int)ra.w;
                float* xrow = XR + (size_t)m * DM;
                norm_row(xrow, YM + (size_t)r0 * DM, __uint_as_float(rb.x), YM + (size_t)r1 * DM, __uint_as_float(rb.y), fin ? nullptr : xrow,
                         Hb + (size_t)m * DM, fin ? xrow : nullptr, p.in[IN_FG], lane);
            }
        }
        PHASE_END
    }
#ifdef ATT_CHECK
    { grid.sync(); if (bx == 0 && threadIdx.x == 0) { int* CNTd = (int*)(p.ws + WS_CTL); const int bad = CNTd[512], tot = CNTd[513], nt_ = CNTd[514];
        float A = 10.f + 1000.f * (float)bad / (float)(tot > 0 ? tot : 1);
#if ATT_REPORT == 1
        A = 10.f + 1000.f * (float)nt_ / 4096.f;
#endif
        p.out[0] += A; } }
#endif
#undef PHASE_BEGIN
#undef PHASE_END
}

constexpr int N_PHASES = 1 + 7 * DEPTH;

extern "C" void kernel_launch(void* const* d_in, const int* in_sizes, int n_in, void* d_out, int out_size, void* d_ws, size_t ws_size, hipStream_t stream) {
    static int grid = 0;
    if (grid == 0) {
        if (n_in != 18 || in_sizes[0] != T_TOK * DM || out_size != T_TOK * DM || ws_size < WS_END) {
            fprintf(stderr, "kernel_launch: unexpected shapes: n_in %d in0 %d out %d ws %zu (need >= %zu)\n", n_in, n_in > 0 ? in_sizes[0] : -1, out_size, ws_size, (size_t)WS_END); grid = -1; return; }
        int dev = 0, cus = 0, per_cu = 0;
        hipGetDevice(&dev); hipDeviceGetAttribute(&cus, hipDeviceAttributeMultiprocessorCount, dev);
        if (hipFuncSetAttribute((const void*)fwd_kernel, hipFuncAttributeMaxDynamicSharedMemorySize, LDS_BYTES) != hipSuccess) { fprintf(stderr, "kernel_launch: hipFuncSetAttribute failed\n"); grid = -1; return; }
        if (hipOccupancyMaxActiveBlocksPerMultiprocessor(&per_cu, (const void*)fwd_kernel, NTHREADS, LDS_BYTES) != hipSuccess || per_cu < 1) { fprintf(stderr, "kernel_launch: occupancy query says %d blocks/CU\n", per_cu); per_cu = 1; }
        (void)hipGetLastError();
        grid = cus;
        if (grid > 256) grid = 256;
    }
    if (grid < 0) return;
    hipMemsetAsync((char*)d_ws + WS_CTL, 0, CTL_BYTES, stream);
    Params p{};
    for (int i = 0; i < 18; ++i) p.in[i] = (const float*)d_in[i];
    p.out = (float*)d_out; p.ws = (unsigned char*)d_ws;
#if MK_N_LAUNCHES == 1
    p.ph_lo = 0; p.ph_hi = N_PHASES;
    void* args[] = {&p};
    hipError_t e = hipLaunchCooperativeKernel((const void*)fwd_kernel, dim3(grid), dim3(NTHREADS), args, LDS_BYTES, stream);
    if (e != hipSuccess) fprintf(stderr, "kernel_launch: cooperative launch failed: %s (grid %d)\n", hipGetErrorString(e), grid);
#else
    for (int ph = 0; ph < N_PHASES; ++ph) { p.ph_lo = ph; p.ph_hi = ph + 1;
        hipLaunchKernelGGL(fwd_kernel, dim3(grid), dim3(NTHREADS), LDS_BYTES, stream, p); }
    hipError_t e = hipPeekAtLastError();
    if (e != hipSuccess) fprintf(stderr, "kernel_launch: launch failed: %s\n", hipGetErrorName(e));
#endif
}
```

```cpp
#include <hip/hip_runtime.h>
#include <hip/hip_cooperative_groups.h>
#include <cstdio>
#include <cstdint>
namespace cg = cooperative_groups;

#ifndef PROBE_ATT2
#define PROBE_ATT2 0
#endif
#ifndef ATT_REPORT
#define ATT_REPORT 0
#endif
#ifndef MK_N_LAUNCHES
#define MK_N_LAUNCHES 1
#endif

#define LAS __attribute__((address_space(3)))
typedef unsigned short bf16_t;
typedef short bf16x8 __attribute__((ext_vector_type(8)));
typedef short s16x4 __attribute__((ext_vector_type(4)));
typedef float f32x2 __attribute__((ext_vector_type(2)));
typedef float f32x4 __attribute__((ext_vector_type(4)));
typedef float f32x16 __attribute__((ext_vector_type(16)));
typedef unsigned u32x2 __attribute__((ext_vector_type(2)));
typedef unsigned u32x4 __attribute__((ext_vector_type(4)));

constexpr int T_TOK = 16384, DM = 2048, DIN = 5632, SEQ = 4096, NBATCH = 4, NHEAD = 8, HD = 128, DEPTH = 2;
constexpr int GC_Q = 1536, GC_K = 2560, GC_V = 3584;
constexpr int UP = 4608, COL_BG = 0, COL_Z = 512, COL_Q = 1024, COL_K = 2048, COL_V = 3072, COL_HH = 4096;
constexpr int NEXP = 32, DEXP = 512, NRW = 48;
constexpr int MAXTILES = 160;
constexpr float EPS = 1e-6f;
constexpr int NWAVES = 8, NTHREADS = 512;
constexpr int RING_BYTES = 131072, SCRATCH_BYTES = 147456, MISC_OFF = SCRATCH_BYTES, MISC_BYTES = 8192, LDS_BYTES = SCRATCH_BYTES + MISC_BYTES;

constexpr size_t MiB = 1u << 20;
constexpr size_t WS_CTL = 0;
constexpr size_t CTL_BYTES = 65536;
constexpr size_t SZ_WIN = (size_t)DIN * DM * 2, SZ_WOUT = (size_t)DM * DM * 2, SZ_WGU = (size_t)NEXP * 1024 * DM * 2, SZ_WD = (size_t)NEXP * DM * DEXP * 2, SZ_RW = (size_t)NRW * DM * 2;
constexpr size_t WS_W0 = 1 * MiB;
constexpr size_t OFF_WIN = 0, OFF_WOUT = OFF_WIN + SZ_WIN, OFF_WGU = OFF_WOUT + SZ_WOUT, OFF_WD = OFF_WGU + SZ_WGU, OFF_RW = OFF_WD + SZ_WD, SZ_LAYER = ((OFF_RW + SZ_RW + 4095) / 4096) * 4096;
constexpr size_t WS_U = WS_W0 + DEPTH * SZ_LAYER;
constexpr size_t SZ_U = (size_t)T_TOK * UP * 2;
static_assert((size_t)MAXTILES * 256 * DM <= SZ_U, "ymoe (fp8) overlays u");
constexpr size_t WS_Y = WS_U + SZ_U;
constexpr size_t WS_H = WS_Y + (size_t)T_TOK * DM * 2;
constexpr size_t WS_HM = WS_H + (size_t)T_TOK * DM * 2;
constexpr size_t WS_KS = WS_HM + (size_t)MAXTILES * 256 * DEXP * 2;
constexpr size_t WS_RS = WS_KS + (size_t)64 * 2 * 1024 * 4;
constexpr size_t WS_REC = WS_RS + (size_t)T_TOK * 4;
constexpr size_t WS_TM = WS_REC + (size_t)T_TOK * 32;
constexpr size_t WS_XB = WS_TM + (size_t)NEXP * T_TOK * 4;
constexpr size_t WS_NRM = WS_XB + (size_t)T_TOK * DM * 2;
constexpr size_t WS_PART = WS_NRM + 2 * 64 * 8 * 8 * 4;
constexpr size_t WS_END = WS_PART + (size_t)48 * 66 * 512 * 4;

__device__ __forceinline__ unsigned cvt_pk_bf16(float lo, float hi) { unsigned r; asm volatile("v_cvt_pk_bf16_f32 %0, %1, %2" : "=v"(r) : "v"(lo), "v"(hi)); return r; }
__device__ __forceinline__ float bf_lo(unsigned w) { return __uint_as_float(w << 16); }
__device__ __forceinline__ float bf_hi(unsigned w) { return __uint_as_float(w & 0xffff0000u); }
__device__ __forceinline__ float wave_sum(float v) {
#pragma unroll
    for (int o = 1; o < 64; o <<= 1) v += __shfl_xor(v, o);
    return v;
}
__device__ __forceinline__ float fast_sigmoid(float x) { return __builtin_amdgcn_rcpf(1.f + __builtin_amdgcn_exp2f(-1.4426950408889634f * x)); }

namespace pg8 {
constexpr int BM = 256, BK = 64, HALF = 128, HTB = HALF * BK * 2, STAGE_BYTES = 8 * HTB, NXCD = 8, WGM = 8;
__host__ __device__ __forceinline__ int lds_byte(int r, int c) { const int st = (r >> 4) * 2 + (c >> 5), rr = r & 15, cc = c & 31, ob = rr * 64 + cc * 2; return st * 1024 + (ob ^ (((ob >> 9) & 1) << 5)); }
__host__ __device__ __forceinline__ void stage_rc(int b, int& R, int& C) { const int st = b / 1024, sb = b % 1024, swz = sb ^ (((sb >> 9) & 1) << 5); R = (st >> 1) * 16 + swz / 64; C = (st & 1) * 32 + (swz % 64) / 2; }
__host__ __device__ __forceinline__ int perm32(int rho) { const int n = rho >> 4, i = rho & 15; return 8 * (i >> 2) + 4 * n + (i & 3); }

struct Unit { int pm, pn, e; };

__device__ __forceinline__ bool order_next(int i, int G, int c, int nM, int nN, Unit& u) {
    const int nwg = nM * nN; const long L = (long)i * G + c; if (L >= nwg) return false;
    int wgid = (int)L; { const int q = nwg / NXCD, r = nwg % NXCD, xcd = wgid % NXCD, off = wgid / NXCD; wgid = (xcd < r ? xcd * (q + 1) : r * (q + 1) + (xcd - r) * q) + off; }
    const int nig = WGM * nN, gid = wgid / nig, fm = gid * WGM, gsz = (nM - fm) < WGM ? (nM - fm) : WGM;
    u.pm = fm + ((wgid % nig) % gsz); u.pn = (wgid % nig) / gsz; u.e = 0; return true;
}

struct DenseSched {
    const char* A; const char* Bt; int nM, nN, G, c, K;
    __device__ __forceinline__ bool next(int i, Unit& u) const { return order_next(i, G, c, nM, nN, u); }
    __device__ __forceinline__ const char* a_base(const Unit& u) const { return A + (size_t)u.pm * BM * K * 2; }
    __device__ __forceinline__ const char* b_base(const Unit& u) const { return Bt + (size_t)u.pn * BM * K * 2; }
    __device__ __forceinline__ void a_rows(const Unit&, const int (&RA)[2], const unsigned (&cofA)[2], unsigned (&g)[2][2]) const {
#pragma unroll
        for (int h = 0; h < 2; ++h)
#pragma unroll
            for (int i = 0; i < 2; ++i) g[h][i] = (unsigned)((h * HALF + RA[i]) * K) * 2u + cofA[i];
    }
};
struct MoeSched {
    const char* A; const char* Bt; size_t b_estride; int nM, nN, G, c, K; bool gather;
    const LAS int* tile_e; const LAS int* tstart; const LAS int* cnt; const int* tokmap;
    __device__ __forceinline__ bool next(int i, Unit& u) const { if (!order_next(i, G, c, nM, nN, u)) return false; u.e = tile_e[u.pm]; return true; }
    __device__ __forceinline__ const char* a_base(const Unit& u) const { return gather ? A : A + (size_t)u.pm * BM * K * 2; }
    __device__ __forceinline__ const char* b_base(const Unit& u) const { return Bt + (size_t)u.e * b_estride + (size_t)u.pn * BM * K * 2; }
    __device__ __forceinline__ void a_rows(const Unit& u, const int (&RA)[2], const unsigned (&cofA)[2], unsigned (&g)[2][2]) const {
        if (gather) {
            const int p0 = (u.pm - tstart[u.e]) * BM, cn = cnt[u.e];
#pragma unroll
            for (int h = 0; h < 2; ++h)
#pragma unroll
                for (int i = 0; i < 2; ++i) { int pos = p0 + h * HALF + RA[i]; pos = pos < cn ? pos : cn - 1; const int tok = tokmap[u.e * T_TOK + pos]; g[h][i] = (unsigned)(tok * K) * 2u + cofA[i]; }
        } else {
#pragma unroll
            for (int h = 0; h < 2; ++h)
#pragma unroll
                for (int i = 0; i < 2; ++i) g[h][i] = (unsigned)((h * HALF + RA[i]) * K) * 2u + cofA[i];
        }
    }
};

__device__ __forceinline__ void acc_zero(f32x4 (&acc)[2][2][4][2]) {
#pragma unroll
    for (int a = 0; a < 2; ++a)
#pragma unroll
        for (int b = 0; b < 2; ++b)
#pragma unroll
            for (int m = 0; m < 4; ++m)
#pragma unroll
                for (int n = 0; n < 2; ++n) acc[a][b][m][n] = (f32x4){0.f, 0.f, 0.f, 0.f};
}
struct EpiInProj {
    static constexpr bool PERM = true;
    __device__ __forceinline__ void init(f32x4 (&acc)[2][2][4][2], const Unit&, int, int, int, int) const { acc_zero(acc); }
    bf16_t* U; float* ksum; float* nrm; const float* rs;
    __device__ __forceinline__ void operator()(const f32x4 (&acc_)[2][2][4][2], const Unit& u, int wr, int wc, int fr, int fq) const {
        const int row0 = u.pm * BM + wr * 64 + fr, col0 = u.pn * BM + wc * 32 + 8 * fq;
        f32x4 acc[2][2][4][2];
#pragma unroll
        for (int ai = 0; ai < 2; ++ai)
#pragma unroll
            for (int m = 0; m < 4; ++m) { const float sc = rs[row0 + ai * HALF + m * 16];
#pragma unroll
                for (int bj = 0; bj < 2; ++bj) { acc[ai][bj][m][0] = acc_[ai][bj][m][0] * sc; acc[ai][bj][m][1] = acc_[ai][bj][m][1] * sc; } }
        const bool paired = (u.pn >= 2 && u.pn < 6) || u.pn >= 18;
        if (!paired) { const int ocol = (u.pn < 2 ? u.pn * 256 : COL_Q + (u.pn - 6) * 256) + wc * 32 + 8 * fq;
#pragma unroll
          for (int ai = 0; ai < 2; ++ai)
#pragma unroll
            for (int m = 0; m < 4; ++m) { bf16_t* rowp = U + (size_t)(row0 + ai * HALF + m * 16) * UP + ocol;
#pragma unroll
                for (int bj = 0; bj < 2; ++bj) { const f32x4 v0 = acc[ai][bj][m][0], v1 = acc[ai][bj][m][1]; u32x4 w;
                    w.x = cvt_pk_bf16(v0[0], v0[1]); w.y = cvt_pk_bf16(v0[2], v0[3]); w.z = cvt_pk_bf16(v1[0], v1[1]); w.w = cvt_pk_bf16(v1[2], v1[3]);
                    *(u32x4*)(rowp + bj * HALF) = w; } }
        } else { const bool glu = u.pn >= 18; const int ocol = (glu ? COL_HH + (u.pn - 18) * 128 : COL_Z + (u.pn - 2) * 128) + wc * 16 + 4 * fq;
#pragma unroll
          for (int ai = 0; ai < 2; ++ai)
#pragma unroll
            for (int m = 0; m < 4; ++m) { bf16_t* rowp = U + (size_t)(row0 + ai * HALF + m * 16) * UP + ocol;
#pragma unroll
                for (int bj = 0; bj < 2; ++bj) { const f32x4 v0 = acc[ai][bj][m][0], v1 = acc[ai][bj][m][1];
                    float h0, h1, h2, h3;
                    if (glu) { h0 = v0[0] * fast_sigmoid(v0[1]); h1 = v0[2] * fast_sigmoid(v0[3]); h2 = v1[0] * fast_sigmoid(v1[1]); h3 = v1[2] * fast_sigmoid(v1[3]); }
                    else { h0 = v0[0] * v0[1]; h1 = v0[2] * v0[3]; h2 = v1[0] * v1[1]; h3 = v1[2] * v1[3]; }
                    u32x2 w; w.x = cvt_pk_bf16(h0, h1); w.y = cvt_pk_bf16(h2, h3); *(u32x2*)(rowp + bj * (HALF / 2)) = w; } }
        }
        if (u.pn >= GC_Q / 256 && u.pn < GC_V / 256) {
            const int kind = u.pn >= GC_K / 256, hb = 2 * (u.pn - (kind ? GC_K / 256 : GC_Q / 256));
#pragma unroll
            for (int bj = 0; bj < 2; ++bj) { float mx = 0.f;
#pragma unroll
                for (int ai = 0; ai < 2; ++ai)
#pragma unroll
                    for (int m = 0; m < 4; ++m) { const f32x4 a = acc[ai][bj][m][0], c = acc[ai][bj][m][1];
                        float q = (a[0] * a[0] + a[1] * a[1]) + (a[2] * a[2] + a[3] * a[3]) + (c[0] * c[0] + c[1] * c[1]) + (c[2] * c[2] + c[3] * c[3]);
                        q += __shfl_xor(q, 16); q += __shfl_xor(q, 32); mx = fmaxf(mx, q); }
#pragma unroll
                for (int o = 1; o < 16; o <<= 1) mx = fmaxf(mx, __shfl_xor(mx, o));
                if ((fr | fq) == 0) nrm[(((kind * 64 + u.pm) * 8 + hb + bj) * 2 + wr) * 4 + wc] = mx; }
        }
        if (u.pn >= GC_K / 256 && u.pn < GC_V / 256) {
            float* kp = ksum + (size_t)(u.pm * 2 + wr) * 1024 + (u.pn - GC_K / 256) * 256 + wc * 32 + 8 * fq;
#pragma unroll
            for (int bj = 0; bj < 2; ++bj)
#pragma unroll
                for (int n = 0; n < 2; ++n) { f32x4 s = (f32x4){0.f, 0.f, 0.f, 0.f};
#pragma unroll
                    for (int ai = 0; ai < 2; ++ai)
#pragma unroll
                        for (int m = 0; m < 4; ++m) s += acc[ai][bj][m][n];
#pragma unroll
                    for (int o = 1; o < 16; o <<= 1) { s[0] += __shfl_xor(s[0], o); s[1] += __shfl_xor(s[1], o); s[2] += __shfl_xor(s[2], o); s[3] += __shfl_xor(s[3], o); }
                    if (fr == 0) *(f32x4*)(kp + bj * HALF + 4 * n) = s; }
        }
    }
};
struct EpiResBf16 {
    static constexpr bool PERM = true;
    const float* resf; bf16_t* out;
    __device__ __forceinline__ void init(f32x4 (&acc)[2][2][4][2], const Unit& u, int wr, int wc, int fr, int fq) const {
        const int row0 = u.pm * BM + wr * 64 + fr, col0 = u.pn * BM + wc * 32 + 8 * fq;
#pragma unroll
        for (int ai = 0; ai < 2; ++ai)
#pragma unroll
            for (int m = 0; m < 4; ++m) { const size_t off = (size_t)(row0 + ai * HALF + m * 16) * DM + col0;
#pragma unroll
                for (int bj = 0; bj < 2; ++bj) {
                    if (resf) { acc[ai][bj][m][0] = __builtin_nontemporal_load((const f32x4*)(resf + off + bj * HALF)); acc[ai][bj][m][1] = __builtin_nontemporal_load((const f32x4*)(resf + off + bj * HALF + 4)); }
                    else { const u32x4 r = *(const u32x4*)(out + off + bj * HALF);
                        acc[ai][bj][m][0] = (f32x4){bf_lo(r.x), bf_hi(r.x), bf_lo(r.y), bf_hi(r.y)}; acc[ai][bj][m][1] = (f32x4){bf_lo(r.z), bf_hi(r.z), bf_lo(r.w), bf_hi(r.w)}; } } }
    }
    __device__ __forceinline__ void operator()(const f32x4 (&acc)[2][2][4][2], const Unit& u, int wr, int wc, int fr, int fq) const {
        const int row0 = u.pm * BM + wr * 64 + fr, col0 = u.pn * BM + wc * 32 + 8 * fq;
#pragma unroll
        for (int ai = 0; ai < 2; ++ai)
#pragma unroll
            for (int m = 0; m < 4; ++m) { const size_t off = (size_t)(row0 + ai * HALF + m * 16) * DM + col0;
#pragma unroll
                for (int bj = 0; bj < 2; ++bj) { const f32x4 v0 = acc[ai][bj][m][0], v1 = acc[ai][bj][m][1];
                    u32x4 w; w.x = cvt_pk_bf16(v0[0], v0[1]); w.y = cvt_pk_bf16(v0[2], v0[3]); w.z = cvt_pk_bf16(v1[0], v1[1]); w.w = cvt_pk_bf16(v1[2], v1[3]);
                    *(u32x4*)(out + off + bj * HALF) = w; } }
    }
};
struct EpiSwiglu {
    static constexpr bool PERM = true;
    __device__ __forceinline__ void init(f32x4 (&acc)[2][2][4][2], const Unit&, int, int, int, int) const { acc_zero(acc); }
    bf16_t* HMo; const float* rs; const int* tokmap; const LAS int* tstart; const LAS int* cnt;
    __device__ __forceinline__ void operator()(const f32x4 (&acc)[2][2][4][2], const Unit& u, int wr, int wc, int fr, int fq) const {
        const int p0 = (u.pm - tstart[u.e]) * BM, cn = cnt[u.e];
#pragma unroll
        for (int ai = 0; ai < 2; ++ai)
#pragma unroll
            for (int m = 0; m < 4; ++m) { const int r = ai * HALF + wr * 64 + m * 16 + fr; int pos = p0 + r; pos = pos < cn ? pos : cn - 1;
                const float sc = rs[tokmap[u.e * T_TOK + pos]];
                bf16_t* rowp = HMo + (size_t)(u.pm * BM + r) * DEXP + ((u.pn * BM + wc * 32 + 8 * fq) >> 1);
#pragma unroll
                for (int bj = 0; bj < 2; ++bj) { const f32x4 v0 = acc[ai][bj][m][0] * sc, v1 = acc[ai][bj][m][1] * sc;
                    const float h0 = v0[0] * fast_sigmoid(v0[0]) * v0[1], h1 = v0[2] * fast_sigmoid(v0[2]) * v0[3], h2 = v1[0] * fast_sigmoid(v1[0]) * v1[1], h3 = v1[2] * fast_sigmoid(v1[2]) * v1[3];
                    u32x2 w; w.x = cvt_pk_bf16(h0, h1); w.y = cvt_pk_bf16(h2, h3); *(u32x2*)(rowp + bj * (HALF / 2)) = w; } }
    }
};
constexpr float YM_SCALE = 8.f;
struct EpiFp8 {
    static constexpr bool PERM = true;
    __device__ __forceinline__ void init(f32x4 (&acc)[2][2][4][2], const Unit&, int, int, int, int) const { acc_zero(acc); }
    unsigned char* O; int ldc;
    __device__ __forceinline__ void operator()(const f32x4 (&acc)[2][2][4][2], const Unit& u, int wr, int wc, int fr, int fq) const {
        const int row0 = u.pm * BM + wr * 64 + fr, col0 = u.pn * BM + wc * 32 + 8 * fq;
#pragma unroll
        for (int ai = 0; ai < 2; ++ai)
#pragma unroll
            for (int m = 0; m < 4; ++m) { unsigned char* rowp = O + (size_t)(row0 + ai * HALF + m * 16) * ldc + col0;
#pragma unroll
                for (int bj = 0; bj < 2; ++bj) { f32x4 v0 = acc[ai][bj][m][0] * YM_SCALE, v1 = acc[ai][bj][m][1] * YM_SCALE;
#pragma unroll
                    for (int e = 0; e < 4; ++e) { v0[e] = __builtin_amdgcn_fmed3f(v0[e], -400.f, 400.f); v1[e] = __builtin_amdgcn_fmed3f(v1[e], -400.f, 400.f); }
                    int w0 = 0, w1 = 0;
                    w0 = __builtin_amdgcn_cvt_pk_fp8_f32(v0[0], v0[1], w0, false); w0 = __builtin_amdgcn_cvt_pk_fp8_f32(v0[2], v0[3], w0, true);
                    w1 = __builtin_amdgcn_cvt_pk_fp8_f32(v1[0], v1[1], w1, false); w1 = __builtin_amdgcn_cvt_pk_fp8_f32(v1[2], v1[3], w1, true);
                    *(u32x2*)(rowp + bj * HALF) = (u32x2){(unsigned)w0, (unsigned)w1}; } }
    }
};

template <class Epi, class Sched>
__device__ __forceinline__ void gemm_phase(LAS unsigned char* lds, const int tid, const int K, const Sched& S, const Epi& E) {
    const int wid = __builtin_amdgcn_readfirstlane(tid >> 6), lane = tid & 63, wr = wid >> 2, wc = wid & 3, fr = lane & 15, fq = lane >> 4;
    const int nt = K / BK;
    int RA[2]; unsigned cofA[2], voffB[2];
#pragma unroll
    for (int i = 0; i < 2; ++i) { int R, C; stage_rc(tid * 16 + i * 8192, R, C); const int Rb = Epi::PERM ? ((R & ~31) + perm32(R & 31)) : R;
        RA[i] = R; cofA[i] = (unsigned)C * 2u; voffB[i] = (unsigned)(Rb * K + C) * 2u; }
    const size_t kstep = (size_t)(BK * 2);
    const size_t hstep = (size_t)HALF * K * 2;
    const unsigned ldsw = (unsigned)wid * 1024u;
    const int aoff = lds_byte(wr * 64 + fr, fq * 8), boff = lds_byte(wc * 32 + fr, fq * 8);
#define PG8_SA(b, h) (((b) * 2 + (h)) * HTB)
#define PG8_SB(b, h) ((4 + (b) * 2 + (h)) * HTB)
#define PG8_STG(bufoff, gptr, v0, v1) do { \
        __builtin_amdgcn_global_load_lds((const unsigned*)((const char*)(gptr) + (v0)), (LAS unsigned*)(lds + (bufoff) + ldsw), 16, 0, 0); \
        __builtin_amdgcn_global_load_lds((const unsigned*)((const char*)(gptr) + (v1)), (LAS unsigned*)(lds + (bufoff) + ldsw + 8192), 16, 0, 0); } while (0)
#define PG8_LDA(dst, b, h) do { _Pragma("unroll") for (int m = 0; m < 4; ++m) _Pragma("unroll") for (int k = 0; k < 2; ++k) dst[m][k] = *(const LAS bf16x8*)(lds + PG8_SA(b, h) + aoff + m * 2048 + k * 1024); } while (0)
#define PG8_LDB(dst, b, h) do { _Pragma("unroll") for (int n = 0; n < 2; ++n) _Pragma("unroll") for (int k = 0; k < 2; ++k) dst[n][k] = *(const LAS bf16x8*)(lds + PG8_SB(b, h) + boff + n * 2048 + k * 1024); } while (0)
#define PG8_MMA(ai, bj, At, Bt) do { __builtin_amdgcn_s_setprio(1); _Pragma("unroll") for (int m = 0; m < 4; ++m) _Pragma("unroll") for (int n = 0; n < 2; ++n) _Pragma("unroll") for (int k = 0; k < 2; ++k) \
        acc[ai][bj][m][n] = __builtin_amdgcn_mfma_f32_16x16x32_bf16(Bt[n][k], At[m][k], acc[ai][bj][m][n], 0, 0, 0); __builtin_amdgcn_s_setprio(0); } while (0)
#define PG8_WAIT_V(n) asm volatile("s_waitcnt vmcnt(" #n ")" ::: "memory")
#define PG8_WAIT_L(n) asm volatile("s_waitcnt lgkmcnt(" #n ")" ::: "memory")
#define PG8_BAR __builtin_amdgcn_s_barrier()
#define PG8_SCHED __builtin_amdgcn_sched_barrier(0)
    Unit cur, nxt; int ui = 0;
    if (!S.next(0, cur)) return;
    f32x4 acc[2][2][4][2];
    E.init(acc, cur, wr, wc, fr, fq);
    bf16x8 At[4][2], B0[2][2], B1[2][2];
    const char* cA = S.a_base(cur); const char* cB = S.b_base(cur);
    unsigned gc[2][2], gn[2][2];
    S.a_rows(cur, RA, cofA, gc);
    PG8_STG(PG8_SB(0, 0), cB, voffB[0], voffB[1]); PG8_STG(PG8_SB(0, 1), cB + hstep, voffB[0], voffB[1]); PG8_STG(PG8_SA(0, 0), cA, gc[0][0], gc[0][1]); PG8_STG(PG8_SA(0, 1), cA, gc[1][0], gc[1][1]);
    if (wr == 1) PG8_BAR;
    PG8_WAIT_V(2); PG8_BAR;
    PG8_STG(PG8_SB(1, 0), cB + kstep, voffB[0], voffB[1]); PG8_STG(PG8_SA(1, 0), cA + kstep, gc[0][0], gc[0][1]); PG8_STG(PG8_SB(1, 1), cB + hstep + kstep, voffB[0], voffB[1]);
    PG8_WAIT_V(6); PG8_BAR;
    for (;;) {
        const bool has_next = S.next(ui + 1, nxt);
        const char* nA = has_next ? S.a_base(nxt) : cA; const char* nB = has_next ? S.b_base(nxt) : cB;
        if (has_next) S.a_rows(nxt, RA, cofA, gn);
        else { gn[0][0] = gc[0][0]; gn[0][1] = gc[0][1]; gn[1][0] = gc[1][0]; gn[1][1] = gc[1][1]; }
        for (int t = 0; t < nt; t += 2) {
            const bool last = (t == nt - 2);
            const char* a1 = cA + (size_t)(t + 1) * kstep;
            const char* a2 = last ? nA : cA + (size_t)(t + 2) * kstep; const char* b2 = last ? nB : cB + (size_t)(t + 2) * kstep;
            const char* a3 = a2 + kstep; const char* b3 = b2 + kstep;
            const unsigned g00 = last ? gn[0][0] : gc[0][0], g01 = last ? gn[0][1] : gc[0][1], g10 = last ? gn[1][0] : gc[1][0], g11 = last ? gn[1][1] : gc[1][1];
            PG8_LDB(B0, 0, 0); PG8_LDB(B1, 0, 1); PG8_SCHED; PG8_LDA(At, 0, 0); PG8_STG(PG8_SA(1, 1), a1, gc[1][0], gc[1][1]);
            PG8_WAIT_V(8); PG8_WAIT_L(0); PG8_BAR; PG8_MMA(0, 0, At, B0); PG8_MMA(0, 1, At, B1); PG8_BAR; PG8_SCHED;
            PG8_LDA(At, 0, 1); PG8_STG(PG8_SB(0, 0), b2, voffB[0], voffB[1]); PG8_STG(PG8_SB(0, 1), b2 + hstep, voffB[0], voffB[1]); PG8_STG(PG8_SA(0, 0), a2, g00, g01);
            PG8_WAIT_V(8); PG8_WAIT_L(0); PG8_BAR; PG8_MMA(1, 0, At, B0); PG8_MMA(1, 1, At, B1); PG8_BAR; PG8_SCHED;
            PG8_LDB(B0, 1, 0); PG8_LDB(B1, 1, 1); PG8_SCHED; PG8_LDA(At, 1, 0); PG8_STG(PG8_SA(0, 1), a2, g10, g11);
            PG8_WAIT_V(8); PG8_WAIT_L(0); PG8_BAR; PG8_MMA(0, 0, At, B0); PG8_MMA(0, 1, At, B1); PG8_BAR; PG8_SCHED;
            PG8_LDA(At, 1, 1); PG8_STG(PG8_SB(1, 0), b3, voffB[0], voffB[1]); PG8_STG(PG8_SB(1, 1), b3 + hstep, voffB[0], voffB[1]); PG8_STG(PG8_SA(1, 0), a3, g00, g01);
            PG8_WAIT_V(8); PG8_WAIT_L(0); PG8_BAR; PG8_MMA(1, 0, At, B0); PG8_MMA(1, 1, At, B1); PG8_BAR; PG8_SCHED;
        }
        if (wr == 0) PG8_BAR;
        E(acc, cur, wr, wc, fr, fq);
        if (!has_next) break;
        E.init(acc, nxt, wr, wc, fr, fq);
        cur = nxt; cA = nA; cB = nB; gc[0][0] = gn[0][0]; gc[0][1] = gn[0][1]; gc[1][0] = gn[1][0]; gc[1][1] = gn[1][1]; ++ui;
        if (wr == 1) PG8_BAR;
    }
    PG8_WAIT_V(0);
    PG8_BAR;
#undef PG8_SA
#undef PG8_SB
#undef PG8_STG
#undef PG8_LDA
#undef PG8_LDB
#undef PG8_MMA
#undef PG8_WAIT_V
#undef PG8_WAIT_L
#undef PG8_BAR
#undef PG8_SCHED
}
}

namespace att {
constexpr float SCALE = 0.088388347648318440f;
constexpr float THR = 8.f;
constexpr int KVBLK = 64, QBLK = 32;
constexpr size_t SHM_V = KVBLK * HD * 2, SHM_K = KVBLK * HD * 2;
constexpr int NRING = 2;
constexpr int OFF_V = 0, OFF_K = NRING * SHM_V, OFF_WS = OFF_K + NRING * SHM_K, OFF_KM = OFF_WS + NWAVES * 64 * 4, ATT_LDS = OFF_KM + 32 * 256;
#define KSWZ(row, colB) ((row) * 256 + ((colB) ^ (((row) & 7) << 4)))
#define SBAR() __builtin_amdgcn_sched_barrier(0)
__device__ __forceinline__ int crow(int r, int hi) { return (r & 3) + 8 * (r >> 2) + 4 * hi; }

__device__ __forceinline__ void partialSM(f32x16& p0, f32x16& p1, float& m_reg, float& mn, float& alpha, float slr, float lb, int mode, int thr) {
    constexpr float C = SCALE * 1.4426950408889634f;
#pragma unroll
    for (int r = 0; r < 16; ++r) { const float cr = (float)((r & 3) + 8 * (r >> 2)); p0[r] = fmaf(slr, cr, p0[r]); p1[r] = fmaf(slr, cr + 32.f, p1[r]); }
    if (mode) {
        if (mode == 1) {
#pragma unroll
            for (int r = 0; r < 16; ++r) { if ((r & 3) + 8 * (r >> 2) > thr) p0[r] = -3.0e38f; p1[r] = -3.0e38f; }
        } else {
#pragma unroll
            for (int r = 0; r < 16; ++r) { if ((r & 3) + 8 * (r >> 2) > thr) p1[r] = -3.0e38f; }
        }
    }
    float pmax = p0[0];
#pragma unroll
    for (int r = 1; r < 16; ++r) pmax = fmaxf(pmax, p0[r]);
#pragma unroll
    for (int r = 0; r < 16; ++r) pmax = fmaxf(pmax, p1[r]);
    pmax += lb;
    { auto rr = __builtin_amdgcn_permlane32_swap(__float_as_uint(pmax), __float_as_uint(pmax), false, false);
      pmax = fmaxf(__uint_as_float(rr[0]), __uint_as_float(rr[1])); }
    if (__builtin_expect(__all(pmax - m_reg <= THR / SCALE), 1)) { mn = m_reg; alpha = 1.f; }
    else { mn = fmaxf(m_reg, pmax); alpha = __builtin_amdgcn_exp2f((m_reg - mn) * C); m_reg = mn; }
    const float mnC = (lb - mn) * C;
#pragma unroll
    for (int r = 0; r < 16; ++r) p0[r] = fmaf(p0[r], C, mnC);
#pragma unroll
    for (int r = 0; r < 16; ++r) p1[r] = fmaf(p1[r], C, mnC);
#pragma unroll
    for (int r = 0; r < 16; ++r) p0[r] = __builtin_amdgcn_exp2f(p0[r]);
}
__device__ __forceinline__ void finishSM(f32x16& p0, f32x16& p1, float alpha, float& l_reg, bf16x8& pa0, bf16x8& pa1, bf16x8& pa2, bf16x8& pa3) {
#pragma unroll
    for (int r = 0; r < 16; ++r) p1[r] = __builtin_amdgcn_exp2f(p1[r]);
    float ps = 0;
#pragma unroll
    for (int r = 0; r < 16; ++r) ps += p0[r];
#pragma unroll
    for (int r = 0; r < 16; ++r) ps += p1[r];
    { auto rr = __builtin_amdgcn_permlane32_swap(__float_as_uint(ps), __float_as_uint(ps), false, false);
      ps = __uint_as_float(rr[0]) + __uint_as_float(rr[1]); }
    l_reg = l_reg * alpha + ps;
#define PK4(P, BASE, OUT) do { unsigned a0 = cvt_pk_bf16(P[BASE + 0], P[BASE + 1]), a1 = cvt_pk_bf16(P[BASE + 2], P[BASE + 3]);   \
    unsigned b0 = cvt_pk_bf16(P[BASE + 4], P[BASE + 5]), b1 = cvt_pk_bf16(P[BASE + 6], P[BASE + 7]);                              \
    auto r0 = __builtin_amdgcn_permlane32_swap(a0, b0, false, false); auto r1 = __builtin_amdgcn_permlane32_swap(a1, b1, false, false); \
    u32x4 w = {r0[0], r1[0], r0[1], r1[1]}; OUT = *reinterpret_cast<bf16x8*>(&w); } while (0)
    PK4(p0, 0, pa0); PK4(p0, 8, pa1); PK4(p1, 0, pa2); PK4(p1, 8, pa3);
#undef PK4
}
__device__ __forceinline__ void qkt(f32x16& p0, f32x16& p1, const char* Ks, const bf16x8* qr, int r32, int hi) {
    p0 = f32x16{}; p1 = f32x16{};
    int lowb = (hi * 16) ^ ((r32 & 7) << 4);
    asm volatile("" : "+v"(lowb));
    const char* Kr = Ks + r32 * 256;
#pragma unroll
    for (int d0 = 0; d0 < 8; ++d0) { const int cb = (d0 * 32) ^ lowb;
        const bf16x8 b0 = *reinterpret_cast<const bf16x8*>(Kr + cb);
        const bf16x8 b1 = *reinterpret_cast<const bf16x8*>(Kr + 32 * 256 + cb);
        p0 = __builtin_amdgcn_mfma_f32_32x32x16_bf16(b0, qr[d0], p0, 0, 0, 0);
        p1 = __builtin_amdgcn_mfma_f32_32x32x16_bf16(b1, qr[d0], p1, 0, 0, 0); }
}
__device__ __forceinline__ int v_st(int k, int c) { const int kk = (k & ~0xC) | ((k & 4) << 1) | ((k & 8) >> 1); return ((kk >> 3) * 4 + (c >> 5)) * 512 + ((kk & 7) * 32 + (c & 31)) * 2; }
__device__ __forceinline__ int v_rd_base(int lane) { return ((lane & 3) << 3) | (((lane >> 2) & 3) << 6) | (((lane >> 4) & 1) << 5) | (((lane >> 5) & 1) << 8); }
constexpr int v_rd_off(int d0, int ks, int half) { return d0 * 512 + ks * 4096 + half * 2048; }
template <int OFF> __device__ __forceinline__ s16x4 tr_read(int vb) {
    s16x4 r; asm volatile("ds_read_b64_tr_b16 %0, %1 offset:%2" : "=&v"(r) : "v"(vb), "i"(OFF) : "memory"); return r;
}
template <int D0> __device__ __forceinline__ void pv_one(f32x16& od, int vb, bf16x8 pa0, bf16x8 pa1, bf16x8 pa2, bf16x8 pa3) {
    const s16x4 l0 = tr_read<v_rd_off(D0, 0, 0)>(vb), h0 = tr_read<v_rd_off(D0, 0, 1)>(vb), l1 = tr_read<v_rd_off(D0, 1, 0)>(vb), h1 = tr_read<v_rd_off(D0, 1, 1)>(vb);
    const s16x4 l2 = tr_read<v_rd_off(D0, 2, 0)>(vb), h2 = tr_read<v_rd_off(D0, 2, 1)>(vb), l3 = tr_read<v_rd_off(D0, 3, 0)>(vb), h3 = tr_read<v_rd_off(D0, 3, 1)>(vb);
    asm volatile("s_waitcnt lgkmcnt(0)" ::: "memory"); SBAR();
#define PK(L, H) (bf16x8){L[0], L[1], L[2], L[3], H[0], H[1], H[2], H[3]}
    od = __builtin_amdgcn_mfma_f32_32x32x16_bf16(pa0, PK(l0, h0), od, 0, 0, 0);
    od = __builtin_amdgcn_mfma_f32_32x32x16_bf16(pa1, PK(l1, h1), od, 0, 0, 0);
    od = __builtin_amdgcn_mfma_f32_32x32x16_bf16(pa2, PK(l2, h2), od, 0, 0, 0);
    od = __builtin_amdgcn_mfma_f32_32x32x16_bf16(pa3, PK(l3, h3), od, 0, 0, 0);
#undef PK
}
__device__ __forceinline__ void pv_d0(f32x16* o, int vb, bf16x8 pa0, bf16x8 pa1, bf16x8 pa2, bf16x8 pa3) {
    pv_one<0>(o[0], vb, pa0, pa1, pa2, pa3); pv_one<1>(o[1], vb, pa0, pa1, pa2, pa3); pv_one<2>(o[2], vb, pa0, pa1, pa2, pa3); pv_one<3>(o[3], vb, pa0, pa1, pa2, pa3);
}

constexpr int MAXP = 8;
struct ItemTable { unsigned short v[64][MAXP]; };
constexpr int head_cap(int h) { return h == 0 ? 1 : h == 1 ? 2 : h == 2 ? 3 : h == 3 ? 5 : h == 4 ? 10 : 16; }
constexpr ItemTable make_items() {
    ItemTable t{};
    for (int i = 0; i < 64; ++i) for (int j = 0; j < MAXP; ++j) t.v[i][j] = 0xFFFF;
    const int kh[8] = {3, 4, 5, 7, 10, 12, 12, 11};
    int bin0 = 0;
    for (int h = 0; h < 8; ++h) { const int k = kh[h];
        unsigned short code[32] = {}; int cost[32] = {}; int n = 0;
        for (int qb = 0; qb < 16; ++qb) { const int npast = qb < head_cap(h) ? qb : head_cap(h); const bool split = (h >= 5 && qb >= 12);
            if (split) { code[n] = (unsigned short)(h | (qb << 3) | (0 << 7) | (1 << 8)); cost[n] = 8; ++n; code[n] = (unsigned short)(h | (qb << 3) | (1 << 7) | (1 << 8)); cost[n] = npast - 7; ++n; }
            else { code[n] = (unsigned short)(h | (qb << 3)); cost[n] = 1 + npast; ++n; } }
        for (int i = 1; i < n; ++i) { const unsigned short xv = code[i]; const int c = cost[i]; int j = i - 1;
            while (j >= 0 && cost[j] < c) { code[j + 1] = code[j]; cost[j + 1] = cost[j]; --j; }
            code[j + 1] = xv; cost[j + 1] = c; }
        int load[16] = {}; int cnt[16] = {};
        for (int i = 0; i < n; ++i) { int best = 0; for (int j = 1; j < k; ++j) if (load[j] < load[best]) best = j;
            if (cnt[best] < MAXP) { t.v[bin0 + best][cnt[best]] = code[i]; ++cnt[best]; load[best] += cost[i] + 1; } }
        bin0 += k; }
    return t;
}
__device__ const ItemTable ATT_ITEMS = make_items();
constexpr float CUT_MARGIN = 40.f;

__device__ __forceinline__ void attn_item(const int tid, const int b, const int h, const int qb, const bool with_own, const int n_lo, const int n_hi, const int mode,
                                          const int slot, const int l, unsigned char* __restrict__ wsb, char* lds) {
    const bf16_t* __restrict__ U = (const bf16_t*)(wsb + WS_U); const float* __restrict__ ksum = (const float*)(wsb + WS_KS); bf16_t* __restrict__ Y = (bf16_t*)(wsb + WS_Y);
    float* __restrict__ part = (float*)(wsb + WS_PART) + (size_t)slot * 66 * 512; int* __restrict__ tick = (int*)(wsb + WS_CTL) + 12544 + 128 * l + 2 * slot;
    const int wid = tid >> 6, lane = tid & 63, r32 = lane & 31, hi = lane >> 5;
    char* V_lds = lds + OFF_V; char* K_lds = lds + OFF_K; char* KM = lds + OFF_KM;
    float* ws = (float*)(lds + OFF_WS) + wid * 64; float* li_l = ws; float* al_l = ws + 32;
    const bf16_t* Qb = U + (size_t)(b * SEQ + qb * 256) * UP + COL_Q + h * HD;
    float m_reg = -1e29f, l_reg = 0; f32x16 o[4] = {}; bf16x8 qr[8];
    { const bf16_t* Qw = Qb + (size_t)(wid * QBLK + r32) * UP + hi * 8;
#pragma unroll
      for (int d0 = 0; d0 < 8; ++d0) qr[d0] = *reinterpret_cast<const bf16x8*>(Qw + d0 * 16); }
    { const int n = tid >> 5, c4 = (tid & 31) * 4;
      const float* k0p = ksum + (size_t)((b * 16 + n) * 2) * 1024 + h * HD + c4;
      const f32x4 s0 = *(const f32x4*)k0p, s1 = *(const f32x4*)(k0p + 1024);
      u32x2 w; w.x = cvt_pk_bf16((s0[0] + s1[0]) * (1.f / 256.f), (s0[1] + s1[1]) * (1.f / 256.f)); w.y = cvt_pk_bf16((s0[2] + s1[2]) * (1.f / 256.f), (s0[3] + s1[3]) * (1.f / 256.f));
      *(u32x2*)(KM + KSWZ(n, c4 * 2)) = w;
      *(u32x2*)(KM + KSWZ(16 + n, c4 * 2)) = (u32x2){0u, 0u}; }
    __syncthreads();
    unsigned selmask = 0u;
    { f32x16 g = f32x16{};
#pragma unroll
      for (int d0 = 0; d0 < 8; ++d0) { const int cb = (d0 * 16 + hi * 8) * 2; const bf16x8 a = *reinterpret_cast<const bf16x8*>(KM + KSWZ(r32, cb)); g = __builtin_amdgcn_mfma_f32_32x32x16_bf16(a, qr[d0], g, 0, 0, 0); }
      float G[16];
#pragma unroll
      for (int r = 0; r < 8; ++r) { auto rr = __builtin_amdgcn_permlane32_swap(__float_as_uint(g[r]), __float_as_uint(g[r]), false, false);
          const float other = hi ? __uint_as_float(rr[0]) : __uint_as_float(rr[1]);
          const int nlo = (r & 3) + 8 * (r >> 2);
          G[nlo] = hi ? other : g[r]; G[nlo + 4] = hi ? g[r] : other; }
#pragma unroll
      for (int n = 0; n < 16; ++n) if (n >= qb) G[n] = -INFINITY;
      const int npick = qb < 3 ? qb : 3;
#pragma unroll
      for (int it = 0; it < 3; ++it) { if (it < npick) { float best = G[0]; int bi = 0;
#pragma unroll
          for (int n = 1; n < 16; ++n) if (G[n] > best) { best = G[n]; bi = n; }
          selmask |= 1u << bi;
#pragma unroll
          for (int n = 0; n < 16; ++n) if (n == bi) G[n] = -INFINITY; } } }
    const float slr = __uint_as_float(__builtin_amdgcn_readfirstlane(__float_as_uint(__builtin_amdgcn_exp2f(-(float)(h + 1)) * (1.f / SCALE))));
    const int tp4 = qb * 256 + wid * QBLK + r32 - 4 * hi;
    const int jo = with_own ? 4 : 0;
    const int NT = jo + 4 * (n_hi - n_lo);
    const int kb_own = qb * 256, kb_past = n_lo * 256 - 64 * jo;
#define KST(j) (((j) < jo ? kb_own : kb_past) + 64 * (j))
#define LBV(j) ((((j) < jo) ? ((j) > (wid >> 1)) : !((selmask >> (n_lo + (((j) - jo) >> 2))) & 1u)) ? -1e30f : slr * (float)(KST(j) - tp4))
    const int vb0 = (int)(uintptr_t)V_lds + v_rd_base(lane);
    unsigned koff, voff;
    { const int row = 4 * wid + (lane >> 4), cc = lane & 15; koff = (unsigned)(row * UP * 2 + ((cc ^ (row & 7)) << 4)) + (unsigned)(COL_K * 2); }
    { const int st = 2 * wid + (lane >> 5), kk = (st >> 2) * 8 + ((lane & 31) >> 2), k = (kk & ~0xC) | ((kk & 4) << 1) | ((kk & 8) >> 1), col = 32 * (st & 3) + 8 * (lane & 3);
      voff = (unsigned)(k * UP * 2 + col * 2) + (unsigned)(COL_V * 2); }
    const int wq = __builtin_amdgcn_readfirstlane(wid);
    LAS unsigned char* ldsL = (LAS unsigned char*)(unsigned)(uintptr_t)lds;
    const char* Ubh = (const char*)(U + (size_t)(b * SEQ) * UP + h * HD);
#define DMAK(bb, k0) do { const unsigned uo_ = (unsigned)((k0) * (UP * 2)); \
    __builtin_amdgcn_global_load_lds((const unsigned*)(Ubh + (koff + uo_)), (LAS unsigned*)(ldsL + OFF_K + (bb) * SHM_K + wq * 1024), 16, 0, 0); \
    __builtin_amdgcn_global_load_lds((const unsigned*)(Ubh + (koff + uo_ + 32u * UP * 2u)), (LAS unsigned*)(ldsL + OFF_K + (bb) * SHM_K + (wq + 8) * 1024), 16, 0, 0); } while (0)
#define DMAV(bb, k0) do { const unsigned uo_ = (unsigned)((k0) * (UP * 2)); \
    __builtin_amdgcn_global_load_lds((const unsigned*)(Ubh + (voff + uo_)), (LAS unsigned*)(ldsL + OFF_V + (bb) * SHM_V + wq * 1024), 16, 0, 0); \
    __builtin_amdgcn_global_load_lds((const unsigned*)(Ubh + (voff + uo_ + 32u * UP * 2u)), (LAS unsigned*)(ldsL + OFF_V + (bb) * SHM_V + (wq + 8) * 1024), 16, 0, 0); } while (0)
#define RESC(a) do { if (__any((a) < 1.f)) { if (hi == 0) al_l[r32] = (a); asm volatile("s_waitcnt lgkmcnt(0)" ::: "memory"); \
    _Pragma("unroll") for (int d = 0; d < 4; ++d) _Pragma("unroll") for (int r = 0; r < 16; ++r) o[d][r] *= al_l[crow(r, hi)]; } } while (0)
    if (NT > 0) {
    f32x16 pA0, pA1, pB0, pB1; float mnA, mnB, alA, alB; bf16x8 pa0, pa1, pa2, pa3;
#define PSM(P0, P1, MN, AL, j) partialSM(P0, P1, m_reg, MN, AL, slr, LBV(j), ((j) < jo && (j) == (wid >> 1)) ? 1 + (wid & 1) : 0, r32 - 4 * hi)
#define WBAR(N) asm volatile("s_waitcnt vmcnt(" #N ") lgkmcnt(0)\n\ts_barrier" ::: "memory")
#define STEP(PC0, PC1, MNC, ALC, PP0, PP1, ALP, j, sl) do { \
        DMAV(sl, KST(j)); \
        SBAR(); qkt(PC0, PC1, K_lds + (sl) * SHM_K, qr, r32, hi); \
        finishSM(PP0, PP1, ALP, l_reg, pa0, pa1, pa2, pa3); SBAR(); \
        WBAR(4); \
        if ((j) + 2 < NT) DMAK(sl, KST((j) + 2)); \
        pv_d0(o, vb0 + (1 - (sl)) * (int)SHM_V, pa0, pa1, pa2, pa3); PSM(PC0, PC1, MNC, ALC, j); \
        if ((j) + 2 < NT) WBAR(4); else WBAR(0); RESC(ALC); } while (0)
    DMAK(0, KST(0)); DMAK(1, KST(1)); DMAV(0, KST(0)); WBAR(4);
    qkt(pA0, pA1, K_lds, qr, r32, hi);
    WBAR(4);
    DMAK(0, KST(2)); PSM(pA0, pA1, mnA, alA, 0);
    WBAR(4); RESC(alA);
    for (int j = 1; j + 1 < NT; j += 2) {
        STEP(pB0, pB1, mnB, alB, pA0, pA1, alA, j, 1);
        STEP(pA0, pA1, mnA, alA, pB0, pB1, alB, j + 1, 0);
    }
    STEP(pB0, pB1, mnB, alB, pA0, pA1, alA, NT - 1, 1);
    finishSM(pB0, pB1, alB, l_reg, pa0, pa1, pa2, pa3); SBAR();
    pv_d0(o, vb0 + (int)SHM_V, pa0, pa1, pa2, pa3);
#undef STEP
#undef WBAR
#undef PSM
    }
    bool write_out = true;
    if (mode == 1) {
        __syncthreads();
        int* tk = (int*)(lds + OFF_WS + NWAVES * 64 * 4 - 16);
        if (tid == 0) tk[0] = __hip_atomic_fetch_add(tick, 1, __ATOMIC_RELAXED, __HIP_MEMORY_SCOPE_AGENT);
        __syncthreads();
        const int t = __builtin_amdgcn_readfirstlane(tk[0]);
        __syncthreads();
        if (t == 0) {
#pragma unroll
            for (int d = 0; d < 4; ++d)
#pragma unroll
                for (int r = 0; r < 16; ++r) __hip_atomic_store(part + (size_t)(d * 16 + r) * 512 + tid, o[d][r], __ATOMIC_RELAXED, __HIP_MEMORY_SCOPE_AGENT);
            __hip_atomic_store(part + (size_t)64 * 512 + tid, m_reg, __ATOMIC_RELAXED, __HIP_MEMORY_SCOPE_AGENT);
            __hip_atomic_store(part + (size_t)65 * 512 + tid, l_reg, __ATOMIC_RELAXED, __HIP_MEMORY_SCOPE_AGENT);
            asm volatile("s_waitcnt vmcnt(0)" ::: "memory");
            __syncthreads();
            if (tid == 0) __hip_atomic_store(tick + 1, 1, __ATOMIC_RELAXED, __HIP_MEMORY_SCOPE_AGENT);
            write_out = false;
        } else {
            if (tid < 64) { unsigned sp = 0;
                while (__builtin_amdgcn_readfirstlane(__hip_atomic_load(tick + 1, __ATOMIC_RELAXED, __HIP_MEMORY_SCOPE_AGENT)) == 0) { __builtin_amdgcn_s_sleep(2); if (++sp > (1u << 22)) break; }
                __builtin_amdgcn_fence(__ATOMIC_ACQUIRE, "agent");
                asm volatile("s_waitcnt vmcnt(0)" ::: "memory"); }
            __syncthreads();
            constexpr float C = SCALE * 1.4426950408889634f;
            const float m2 = part[(size_t)64 * 512 + tid], l2 = part[(size_t)65 * 512 + tid];
            const float mn = fmaxf(m_reg, m2), a1 = __builtin_amdgcn_exp2f((m_reg - mn) * C), a2 = __builtin_amdgcn_exp2f((m2 - mn) * C);
            { float t1 = l_reg * a1, t2 = l2 * a2; asm volatile("" : "+v"(t1), "+v"(t2)); l_reg = t1 + t2; }
            if (hi == 0) { al_l[r32] = a1; li_l[r32] = a2; }
            asm volatile("s_waitcnt lgkmcnt(0)" ::: "memory");
#pragma unroll
            for (int d = 0; d < 4; ++d)
#pragma unroll
                for (int r = 0; r < 16; ++r) { float t1 = o[d][r] * al_l[crow(r, hi)], t2 = part[(size_t)(d * 16 + r) * 512 + tid] * li_l[crow(r, hi)]; asm volatile("" : "+v"(t1), "+v"(t2)); o[d][r] = t1 + t2; }
            asm volatile("s_waitcnt lgkmcnt(0)" ::: "memory");
        }
    }
    if (write_out) {
    if (hi == 0) li_l[r32] = l_reg; asm volatile("s_waitcnt lgkmcnt(0)" ::: "memory");
    float rli[16];
#pragma unroll
    for (int r = 0; r < 16; ++r) rli[r] = __builtin_amdgcn_rcpf(li_l[crow(r, hi)]);
    bf16_t* Ow = Y + (size_t)(b * SEQ + qb * 256 + wid * QBLK) * DM + 512 + h * HD;
#pragma unroll
    for (int r = 0; r < 16; ++r) { const int orow = crow(r, hi);
#pragma unroll
        for (int d0 = 0; d0 < 4; ++d0) { const float v = o[d0][r] * rli[r]; Ow[(size_t)orow * DM + d0 * 32 + r32] = (bf16_t)(cvt_pk_bf16(v, v) & 0xffffu); } }
    }
    __syncthreads();
#undef KST
#undef LBV
#undef DMAK
#undef DMAV
#undef RESC
}
#undef KSWZ
#undef SBAR
}


#define XB_TMO      128
#define XB_XCNT(j)  (256  + 64 * (j))
#define XB_XSUB(j)  (1280 + 64 * (j))
#define XB_XGEN(j)  (2304 + 64 * (j))
#define XB_TOP      3328
#define XB_TOPGEN   3392
#define XCD_BAR_WORDS 3456
#define XB_SPIN_CAP (1u << 18)
__device__ __forceinline__ unsigned xb_ld(unsigned* p)              { return __hip_atomic_load(p, __ATOMIC_RELAXED, __HIP_MEMORY_SCOPE_AGENT); }
__device__ __forceinline__ unsigned xb_add(unsigned* p, unsigned v) { return __hip_atomic_fetch_add(p, v, __ATOMIC_RELAXED, __HIP_MEMORY_SCOPE_AGENT); }
__device__ __forceinline__ unsigned xb_xcc_id() { return (unsigned)__builtin_amdgcn_s_getreg((3 << 11) | 20) & 0xFu; }
#define XB_SPIN(cond, bar) do { unsigned _sp = 0; while (cond) { __builtin_amdgcn_s_sleep(1); \
    if ((++_sp & 255u) == 0u) { if (xb_ld(&(bar)[XB_TMO])) break; if (_sp > XB_SPIN_CAP) { atomicAdd(&(bar)[XB_TMO], 1u); break; } } } } while (0)
struct XcdBarrier { unsigned* bar; unsigned x; volatile LAS unsigned* st; };
__device__ __forceinline__ XcdBarrier xcd_barrier_post(unsigned* bar, volatile LAS unsigned* st) {
    XcdBarrier b; b.bar = bar; b.x = xb_xcc_id(); b.st = st;
    if (threadIdx.x == 0) (void)xb_add(&bar[XB_XCNT(b.x)], 1u);
    return b;
}
__device__ __forceinline__ void xcd_barrier_complete(unsigned* bar, unsigned x, unsigned& nloc, unsigned& nx) {
    const unsigned G = gridDim.x * gridDim.y * gridDim.z;
    unsigned sum, cnt, mine, sp = 0u;
    for (;;) {
        sum = 0u; cnt = 0u; mine = 0u;
#pragma unroll
        for (unsigned j = 0; j < 16; ++j) { const unsigned c = xb_ld(&bar[XB_XCNT(j)]); sum += c; cnt += (c > 0u) ? 1u : 0u; mine = (j == x) ? c : mine; }
        if (sum == G) break;
        __builtin_amdgcn_s_sleep(1);
        if ((++sp & 255u) == 0u) { if (xb_ld(&bar[XB_TMO])) break; if (sp > XB_SPIN_CAP) { atomicAdd(&bar[XB_TMO], 1u); break; } }
    }
    nloc = mine > 0u ? mine : 1u; nx = cnt > 0u ? cnt : 1u;
}
__device__ __forceinline__ void xcd_barrier(const XcdBarrier& b) {
    asm volatile("s_waitcnt vmcnt(0)" ::: "memory");
    __syncthreads();
    if (threadIdx.x == 0) {
        unsigned* bar = b.bar;
        __builtin_amdgcn_s_waitcnt(0);
        unsigned nloc = b.st[0], nx = b.st[1];
        if (nloc == 0u) { xcd_barrier_complete(bar, b.x, nloc, nx); b.st[0] = nloc; b.st[1] = nx; }
        const unsigned old = xb_add(&bar[XB_XSUB(b.x)], 1u);
        const unsigned gen = old / nloc;
        if (old + 1u == (gen + 1u) * nloc) {
            __builtin_amdgcn_fence(__ATOMIC_RELEASE, "agent");
            asm volatile("s_waitcnt vmcnt(0)" ::: "memory");
            const unsigned og = xb_add(&bar[XB_TOP], 1u);
            const unsigned tg = og / nx;
            if (og + 1u == (tg + 1u) * nx) xb_add(&bar[XB_TOPGEN], 1u);
            else XB_SPIN(xb_ld(&bar[XB_TOPGEN]) == tg, bar);
            __builtin_amdgcn_fence(__ATOMIC_ACQUIRE, "agent");
            xb_add(&bar[XB_XGEN(b.x)], 1u);
            asm volatile("s_waitcnt vmcnt(0)" ::: "memory");
        } else {
            XB_SPIN(xb_ld(&bar[XB_XGEN(b.x)]) == gen, bar);
            __builtin_amdgcn_fence(__ATOMIC_ACQUIRE, "agent");
            asm volatile("s_waitcnt vmcnt(0)" ::: "memory");
        }
    }
    __syncthreads();
}

struct Params { const float* in[18]; float* out; unsigned char* ws; int ph_lo, ph_hi; };
enum { IN_X = 0, IN_N1G, IN_WIN, IN_CAW, IN_CCW, IN_CCB, IN_LNG, IN_LNB, IN_WOUT, IN_N2G, IN_RGW, IN_RGB, IN_REW, IN_REB, IN_WG, IN_WU, IN_WD, IN_FG };

__device__ __forceinline__ void transpose_item(const float* __restrict__ W, int K, int N, bf16_t* __restrict__ WT, size_t dstb, int rmul, int radd, const float* __restrict__ scale,
                                               LAS float* scr, int item, int lane) {
    const int nkb = K / 64, nnb = N / 64, per = nkb * nnb, bt = item / per, rem = item - bt * per, kb = rem / nnb, nb = rem - kb * nnb, k0 = kb * 64, n0 = nb * 64;
    const float* src = W + (size_t)bt * K * N;
    bf16_t* dst = WT + (size_t)bt * dstb;
#pragma unroll 4
    for (int i = 0; i < 16; ++i) { const int k = 4 * i + (lane >> 4), n4 = (lane & 15) * 4; const f32x4 v = __builtin_nontemporal_load((const f32x4*)(src + (size_t)(k0 + k) * N + n0 + n4));
        LAS float* s = scr + k * 65 + n4; s[0] = v[0]; s[1] = v[1]; s[2] = v[2]; s[3] = v[3]; }
    asm volatile("s_waitcnt lgkmcnt(0)" ::: "memory");
    const int c = lane & 7, nn = lane >> 3;
    float sc8[8];
#pragma unroll
    for (int i = 0; i < 8; ++i) sc8[i] = scale ? scale[k0 + 8 * c + i] : 1.f;
#pragma unroll
    for (int j = 0; j < 8; ++j) { const int n = nn + 8 * j; const LAS float* s = scr + (8 * c) * 65 + n;
        u32x4 o; o.x = cvt_pk_bf16(s[0] * sc8[0], s[65] * sc8[1]); o.y = cvt_pk_bf16(s[130] * sc8[2], s[195] * sc8[3]); o.z = cvt_pk_bf16(s[260] * sc8[4], s[325] * sc8[5]); o.w = cvt_pk_bf16(s[390] * sc8[6], s[455] * sc8[7]);
        __builtin_nontemporal_store(o, (u32x4*)(dst + (size_t)((n0 + n) * rmul + radd) * K + k0 + 8 * c)); }
    asm volatile("s_waitcnt lgkmcnt(0)" ::: "memory");
}

__device__ __forceinline__ void norm_row_f32(const float* __restrict__ xrow, bf16_t* __restrict__ xout, float* __restrict__ rsout, int lane) {
    f32x4 v[8]; float ss = 0.f;
#pragma unroll
    for (int j = 0; j < 8; ++j) { v[j] = __builtin_nontemporal_load((const f32x4*)xrow + 64 * j + lane); ss += (v[j][0] * v[j][0] + v[j][1] * v[j][1]) + (v[j][2] * v[j][2] + v[j][3] * v[j][3]); }
    const float rs = 1.0f / sqrtf(wave_sum(ss) * (1.f / DM) + EPS);
    if (lane == 0) *rsout = rs;
#pragma unroll
    for (int j = 0; j < 8; ++j) { u32x2 w; w.x = cvt_pk_bf16(v[j][0], v[j][1]); w.y = cvt_pk_bf16(v[j][2], v[j][3]); *((u32x2*)xout + 64 * j + lane) = w; }
}
struct RowRegs { u32x4 x[4]; u32x2 a[4], c[4]; };
__device__ __forceinline__ void combine_load(RowRegs& R, const bf16_t* __restrict__ xrow, const unsigned char* __restrict__ y0, const unsigned char* __restrict__ y1, int lane) {
#pragma unroll
    for (int j = 0; j < 4; ++j) { R.x[j] = *((const u32x4*)xrow + 64 * j + lane); R.a[j] = __builtin_nontemporal_load((const u32x2*)y0 + 64 * j + lane); R.c[j] = __builtin_nontemporal_load((const u32x2*)y1 + 64 * j + lane); }
}
__device__ __forceinline__ void combine_finish(const RowRegs& R, bf16_t* __restrict__ xrow, float g0, float g1, float* __restrict__ rsout, float* __restrict__ fout, const float* __restrict__ fgain, int lane) {
    float v[4][8]; float ss = 0.f;
    g0 *= (1.f / pg8::YM_SCALE); g1 *= (1.f / pg8::YM_SCALE);
#pragma unroll
    for (int j = 0; j < 4; ++j) { const u32x4 x = R.x[j];
        const f32x2 a0 = __builtin_amdgcn_cvt_pk_f32_fp8((int)R.a[j].x, false), a1 = __builtin_amdgcn_cvt_pk_f32_fp8((int)R.a[j].x, true), a2 = __builtin_amdgcn_cvt_pk_f32_fp8((int)R.a[j].y, false), a3 = __builtin_amdgcn_cvt_pk_f32_fp8((int)R.a[j].y, true);
        const f32x2 c0 = __builtin_amdgcn_cvt_pk_f32_fp8((int)R.c[j].x, false), c1 = __builtin_amdgcn_cvt_pk_f32_fp8((int)R.c[j].x, true), c2 = __builtin_amdgcn_cvt_pk_f32_fp8((int)R.c[j].y, false), c3 = __builtin_amdgcn_cvt_pk_f32_fp8((int)R.c[j].y, true);
        v[j][0] = bf_lo(x.x) + g0 * a0[0] + g1 * c0[0]; v[j][1] = bf_hi(x.x) + g0 * a0[1] + g1 * c0[1];
        v[j][2] = bf_lo(x.y) + g0 * a1[0] + g1 * c1[0]; v[j][3] = bf_hi(x.y) + g0 * a1[1] + g1 * c1[1];
        v[j][4] = bf_lo(x.z) + g0 * a2[0] + g1 * c2[0]; v[j][5] = bf_hi(x.z) + g0 * a2[1] + g1 * c2[1];
        v[j][6] = bf_lo(x.w) + g0 * a3[0] + g1 * c3[0]; v[j][7] = bf_hi(x.w) + g0 * a3[1] + g1 * c3[1];
#pragma unroll
        for (int i = 0; i < 8; ++i) ss += v[j][i] * v[j][i]; }
    const float rs = 1.0f / sqrtf(wave_sum(ss) * (1.f / DM) + EPS);
#pragma unroll
    for (int j = 0; j < 4; ++j) {
        if (fout) { const f32x4 ga = *((const f32x4*)fgain + 128 * j + 2 * lane), gb = *((const f32x4*)fgain + 128 * j + 2 * lane + 1);
            __builtin_nontemporal_store((f32x4){v[j][0] * rs * ga[0], v[j][1] * rs * ga[1], v[j][2] * rs * ga[2], v[j][3] * rs * ga[3]}, (f32x4*)fout + 128 * j + 2 * lane);
            __builtin_nontemporal_store((f32x4){v[j][4] * rs * gb[0], v[j][5] * rs * gb[1], v[j][6] * rs * gb[2], v[j][7] * rs * gb[3]}, (f32x4*)fout + 128 * j + 2 * lane + 1); }
        else { u32x4 w; w.x = cvt_pk_bf16(v[j][0], v[j][1]); w.y = cvt_pk_bf16(v[j][2], v[j][3]); w.z = cvt_pk_bf16(v[j][4], v[j][5]); w.w = cvt_pk_bf16(v[j][6], v[j][7]);
            *((u32x4*)xrow + 64 * j + lane) = w; } }
    if (!fout && lane == 0) *rsout = rs;
}

__global__ void __launch_bounds__(NTHREADS, 2) fwd_kernel(Params p) {
    extern __shared__ __attribute__((aligned(16))) unsigned char lds_raw[];
    LAS unsigned char* lds = (LAS unsigned char*)lds_raw;
    cg::grid_group grid = cg::this_grid();
    const int G = gridDim.x, bx = blockIdx.x;
    const int lo = p.ph_lo, hi = p.ph_hi;
    int ph = 0;
    volatile LAS unsigned* bar_st = (volatile LAS unsigned*)(lds + MISC_OFF + 4096);
    if (threadIdx.x < 2) bar_st[threadIdx.x] = 0u;
    __syncthreads();
#ifdef PROBE_A
    if (bx == 0 && threadIdx.x == 0) ((volatile LAS unsigned long long*)(lds + MISC_OFF + 4352))[0] = __builtin_amdgcn_s_memrealtime();
#endif
    XcdBarrier xbar; xbar.bar = (unsigned*)(p.ws + WS_CTL) + 1024; xbar.x = 0; xbar.st = bar_st;
    if (hi - lo > 1) xbar = xcd_barrier_post((unsigned*)(p.ws + WS_CTL) + 1024, bar_st);
#ifndef PH_MASK
#define PH_MASK 0x7f
#endif
#ifndef DBL_MASK
#define DBL_MASK 0
#endif
#ifndef DBL_L0
#define DBL_L0 0
#endif
#define PHASE_BEGIN(k) if (((PH_MASK >> (k)) & 1) && lo <= ph && ph < hi) { for (int rep_ = 0; rep_ <= (int)(((DBL_MASK >> (k)) & 1) && (!DBL_L0 || l == 0)); ++rep_) { \
    int tid = threadIdx.x; asm volatile("" : "+v"(tid)); unsigned char* ws = p.ws; asm volatile("" : "+s"(ws)); ws = (unsigned char*)(__attribute__((address_space(1))) unsigned char*)ws; \
    const int lane = tid & 63, wave = __builtin_amdgcn_readfirstlane(tid >> 6); \
    const int vcu = (G % 8 == 0) ? (bx % 8) * (G / 8) + bx / 8 : bx; const int gw = vcu * NWAVES + wave, NGW = G * NWAVES; \
    bf16_t* const Ub = (bf16_t*)(ws + WS_U); bf16_t* const YM = (bf16_t*)(ws + WS_U); bf16_t* const Yc = (bf16_t*)(ws + WS_Y); bf16_t* const Hb = (bf16_t*)(ws + WS_H); \
    bf16_t* const HMb = (bf16_t*)(ws + WS_HM); float* const KS = (float*)(ws + WS_KS); float* const RS = (float*)(ws + WS_RS); unsigned* const REC = (unsigned*)(ws + WS_REC); \
    int* const TM = (int*)(ws + WS_TM); int* const CNT = (int*)(ws + WS_CTL); bf16_t* const XB = (bf16_t*)(ws + WS_XB); \
    LAS int* const m_tile_e = (LAS int*)(lds + MISC_OFF); LAS int* const m_tstart = m_tile_e + MAXTILES; LAS int* const m_cnt = m_tstart + 40; \
    unsigned char* const wl = ws + WS_W0 + (size_t)l * SZ_LAYER; int* const cntg = CNT + 8192 + l * 32 * 64;     \
    (void)lane; (void)wave; (void)gw; (void)NGW; (void)Ub; (void)YM; (void)Yc; (void)Hb; (void)HMb; (void)KS; (void)RS; (void)REC; (void)TM; (void)XB; (void)m_tile_e; (void)m_tstart; (void)m_cnt; (void)wl; (void)cntg;
#ifdef PROBE_A
#define STAMP() do { if (bx == 0 && threadIdx.x == 0) { ((volatile LAS unsigned long long*)(lds + MISC_OFF + 4352))[ph + 1] = __builtin_amdgcn_s_memrealtime(); } } while (0)
#else
#define STAMP() do {} while (0)
#endif
#define PHASE_END   } if (ph + 1 < hi) { if (lo < 0) grid.sync();   else xcd_barrier(xbar); } STAMP(); } ++ph;

    { const int l = 0;
    PHASE_BEGIN(0)
    {
        LAS float* scr = (LAS float*)(lds + wave * 16640);
        for (int l = 0; l < DEPTH; ++l) {
            unsigned char* wl = ws + WS_W0 + (size_t)l * SZ_LAYER;
            constexpr int I_IN = (DM / 64) * (DIN / 64), I_OUT = (DM / 64) * (DM / 64), I_G = NEXP * (DM / 64) * (DEXP / 64), I_D = NEXP * (DEXP / 64) * (DM / 64), I_ALL = I_IN + I_OUT + 2 * I_G + I_D;
            for (int it = gw; it < I_ALL; it += NGW) {
                int r = it;
                if (r < I_IN) { const int n0 = (r % (DIN / 64)) * 64;
                    const int rmul = ((n0 >= 512 && n0 < 1536) || n0 >= 4608) ? 2 : 1;
                    const int radd = n0 < 512 ? 0 : n0 < 1024 ? -512 : n0 < 1536 ? -1535 : n0 < 4608 ? 0 : n0 < 5120 ? -4608 : -5631;
                    transpose_item(p.in[IN_WIN] + (size_t)l * DM * DIN, DM, DIN, (bf16_t*)(wl + OFF_WIN), 0, rmul, radd, p.in[IN_N1G] + l * DM, scr, r, lane); continue; } r -= I_IN;
                if (r < I_OUT) { transpose_item(p.in[IN_WOUT] + (size_t)l * DM * DM, DM, DM, (bf16_t*)(wl + OFF_WOUT), 0, 1, 0, nullptr, scr, r, lane); continue; } r -= I_OUT;
                if (r < I_G) { transpose_item(p.in[IN_WG] + (size_t)l * NEXP * DM * DEXP, DM, DEXP, (bf16_t*)(wl + OFF_WGU), (size_t)1024 * DM, 2, 0, p.in[IN_N2G] + l * DM, scr, r, lane); continue; } r -= I_G;
                if (r < I_G) { transpose_item(p.in[IN_WU] + (size_t)l * NEXP * DM * DEXP, DM, DEXP, (bf16_t*)(wl + OFF_WGU), (size_t)1024 * DM, 2, 1, p.in[IN_N2G] + l * DM, scr, r, lane); continue; } r -= I_G;
                transpose_item(p.in[IN_WD] + (size_t)l * NEXP * DEXP * DM, DEXP, DM, (bf16_t*)(wl + OFF_WD), (size_t)DM * DEXP, 1, 0, nullptr, scr, r, lane);
            }
            bf16_t* RW = (bf16_t*)(wl + OFF_RW);
            for (int i = vcu * NTHREADS + tid; i < NRW * (DM / 8); i += G * NTHREADS) { const int n = i / (DM / 8), k8 = (i % (DM / 8)) * 8; float v[8];
#pragma unroll
                for (int j = 0; j < 8; ++j) { const int k = k8 + j; const float g = p.in[IN_N2G][l * DM + k];
                    v[j] = n < 4 ? g * p.in[IN_RGW][(size_t)l * DM * 4 + k * 4 + n] : (n < 36 ? g * p.in[IN_REW][(size_t)l * DM * 32 + k * 32 + (n - 4)] : 0.f); }
                u32x4 o; o.x = cvt_pk_bf16(v[0], v[1]); o.y = cvt_pk_bf16(v[2], v[3]); o.z = cvt_pk_bf16(v[4], v[5]); o.w = cvt_pk_bf16(v[6], v[7]);
                *(u32x4*)(RW + (size_t)n * DM + k8) = o; }
        }
        for (int m = gw; m < T_TOK; m += NGW) norm_row_f32(p.in[IN_X] + (size_t)m * DM, XB + (size_t)m * DM, RS + m, lane);
        __syncthreads();
    }
    PHASE_END
    }

    for (int l = 0; l < DEPTH; ++l) {
        PHASE_BEGIN(1)
        {
            pg8::DenseSched S{(const char*)XB, (const char*)(wl + OFF_WIN), T_TOK / 256, DIN / 256, G, bx, DM};
            pg8::EpiInProj E{Ub, KS, (float*)(ws + WS_NRM), RS};
            pg8::gemm_phase(lds, tid, DM, S, E);
        }
        PHASE_END
        PHASE_BEGIN(2)
        {
            { const float* NRM = (const float*)(ws + WS_NRM);
              LAS int* bc = (LAS int*)(lds + MISC_OFF + 4224);
              for (int slot_ = vcu; slot_ < 256; slot_ += G) { const int b = slot_ >> 6, sl64 = slot_ & 63;
               for (int pi = 0; pi < att::MAXP; ++pi) {
                const unsigned code = (unsigned)__builtin_amdgcn_readfirstlane((int)att::ATT_ITEMS.v[sl64][pi]);
                if (code == 0xFFFFu) break;
                const int h = code & 7, qb = (code >> 3) & 15, part = (code >> 7) & 1, split = (code >> 8) & 1;
                if (tid < 64) { const int n = lane >> 2, wc = lane & 3;
                    const float* kp = NRM + (size_t)(((64 + b * 16 + n) * 8 + h) * 2) * 4 + wc; float kv = fmaxf(kp[0], kp[4]);
                    kv += __shfl_xor(kv, 1); kv += __shfl_xor(kv, 2); if (n > qb) kv = 0.f;
#pragma unroll
                    for (int o = 4; o < 64; o <<= 1) kv = fmaxf(kv, __shfl_xor(kv, o));
                    const float* qp = NRM + (size_t)(((b * 16 + qb) * 8 + h) * 2) * 4 + wc; float qv = fmaxf(qp[0], qp[4]);
                    qv += __shfl_xor(qv, 1); qv += __shfl_xor(qv, 2);
                    const float bound = att::SCALE * 1.02f * sqrtf(qv) * 2.f * sqrtf(kv) + att::CUT_MARGIN;
                    const float D = bound * exp2f((float)(h + 1));
                    int nb = (int)fminf(floorf((D - 1.f) * (1.f / 256.f)), 64.f);
                    int ns = qb - 1 - nb; ns = ns < 0 ? 0 : ns;
                    if (lane == 0) bc[1] = ns; }
                __syncthreads();
                const int n_start = __builtin_amdgcn_readfirstlane(bc[1]);
                const int n_mid = (qb - 7) > n_start ? (qb - 7) : n_start;
                const bool with_own = (part == 0);
                const int n_lo = split ? (part == 0 ? n_mid : n_start) : n_start, n_hi = split ? (part == 0 ? qb : n_mid) : qb;
                const int slot = split ? ((b * 3 + (h - 5)) * 4 + (qb - 12)) : 0;
#ifdef PROBE_TILES
                if (tid == 0 && l == 0) atomicAdd(&CNT[520], (with_own ? 4 : 0) + 4 * (n_hi - n_lo));
#endif
                att::attn_item(tid, b, h, qb, with_own, n_lo, n_hi, split, slot, l, ws, (char*)lds_raw);
               } } }
#ifndef NO_CONV
            int* const cq = CNT + 12416 + 16 * l; LAS int* qc = (LAS int*)(lds + MISC_OFF + 4240);
            __syncthreads();
            if (tid == 0) qc[0] = __hip_atomic_fetch_add(cq, 1, __ATOMIC_RELAXED, __HIP_MEMORY_SCOPE_AGENT);
            __syncthreads();
            { const float* cw = p.in[IN_CAW] + (size_t)l * 3 * 512;
              for (;;) { const int it = __builtin_amdgcn_readfirstlane(qc[0]); __syncthreads(); if (it >= T_TOK / 64) break;
                if (tid == 0) qc[0] = __hip_atomic_fetch_add(cq, 1, __ATOMIC_RELAXED, __HIP_MEMORY_SCOPE_AGENT);
                const int c8 = (tid & 63) * 8, tg0 = it * 64 + (tid >> 6) * 8, bstart = tg0 & ~(SEQ - 1);
                float w0[8], w1[8], w2[8];
#pragma unroll
                for (int j = 0; j < 8; ++j) { w0[j] = cw[c8 + j]; w1[j] = cw[512 + c8 + j]; w2[j] = cw[1024 + c8 + j]; }
                float z[10][8];
#pragma unroll
                for (int i = 0; i < 10; ++i) { const int tt = tg0 - 2 + i;
                    if (tt >= bstart) { const u32x4 a = *(const u32x4*)(Ub + (size_t)tt * UP + COL_Z + c8);
                        z[i][0] = bf_lo(a.x); z[i][1] = bf_hi(a.x); z[i][2] = bf_lo(a.y); z[i][3] = bf_hi(a.y); z[i][4] = bf_lo(a.z); z[i][5] = bf_hi(a.z); z[i][6] = bf_lo(a.w); z[i][7] = bf_hi(a.w); }
                    else {
#pragma unroll
                        for (int j = 0; j < 8; ++j) z[i][j] = 0.f; } }
#pragma unroll
                for (int o = 0; o < 8; ++o) { const int tt = tg0 + o; const u32x4 bg = *(const u32x4*)(Ub + (size_t)tt * UP + COL_BG + c8); float y[8];
#pragma unroll
                    for (int j = 0; j < 8; ++j) y[j] = w0[j] * z[o][j] + w1[j] * z[o + 1][j] + w2[j] * z[o + 2][j];
                    u32x4 w; w.x = cvt_pk_bf16(bf_lo(bg.x) * y[0], bf_hi(bg.x) * y[1]); w.y = cvt_pk_bf16(bf_lo(bg.y) * y[2], bf_hi(bg.y) * y[3]);
                    w.z = cvt_pk_bf16(bf_lo(bg.z) * y[4], bf_hi(bg.z) * y[5]); w.w = cvt_pk_bf16(bf_lo(bg.w) * y[6], bf_hi(bg.w) * y[7]);
                    *(u32x4*)(Yc + (size_t)tt * DM + c8) = w; }
                __syncthreads(); } }
            { const float* cw = p.in[IN_CCW] + (size_t)l * 31 * 512; const float* cb = p.in[IN_CCB] + l * 512; const float* lg = p.in[IN_LNG] + l * 512; const float* lb = p.in[IN_LNB] + l * 512;
              LAS float* hh = (LAS float*)lds; LAS float* co = hh + 46 * 512;
              for (;;) { const int it = __builtin_amdgcn_readfirstlane(qc[0]) - T_TOK / 64; __syncthreads(); if (it >= T_TOK / 16) break;
                if (tid == 0) qc[0] = __hip_atomic_fetch_add(cq, 1, __ATOMIC_RELAXED, __HIP_MEMORY_SCOPE_AGENT);
                const int t0 = it * 16, bstart = t0 & ~(SEQ - 1);
                { const int c8 = (tid & 63) * 8;
                  for (int i = tid >> 6; i < 46; i += 8) { const int tt = t0 - 30 + i; float v[8];
                    if (tt >= bstart) { const u32x4 a = *(const u32x4*)(Ub + (size_t)tt * UP + COL_HH + c8);
                        v[0] = bf_lo(a.x); v[1] = bf_hi(a.x); v[2] = bf_lo(a.y); v[3] = bf_hi(a.y); v[4] = bf_lo(a.z); v[5] = bf_hi(a.z); v[6] = bf_lo(a.w); v[7] = bf_hi(a.w); }
                    else {
#pragma unroll
                        for (int j = 0; j < 8; ++j) v[j] = 0.f; }
                    *(LAS f32x4*)(hh + i * 512 + c8) = (f32x4){v[0], v[1], v[2], v[3]}; *(LAS f32x4*)(hh + i * 512 + c8 + 4) = (f32x4){v[4], v[5], v[6], v[7]}; } }
                __syncthreads();
                { const int c = tid; float w[31];
#pragma unroll
                  for (int j = 0; j < 31; ++j) w[j] = cw[j * 512 + c];
                  const float bias = cb[c];
                  float win[46];
#pragma unroll
                  for (int i = 0; i < 46; ++i) win[i] = hh[i * 512 + c];
#pragma unroll
                  for (int o = 0; o < 16; ++o) { float a = bias;
#pragma unroll
                      for (int j = 0; j < 31; ++j) a = fmaf(w[j], win[o + j], a);
                      co[o * 512 + c] = a; } }
                __syncthreads();
                { const int c8 = lane * 8;
                  f32x4 ga = *(const f32x4*)(lg + c8), gb = *(const f32x4*)(lg + c8 + 4), ba = *(const f32x4*)(lb + c8), bb = *(const f32x4*)(lb + c8 + 4);
#pragma unroll
                  for (int q = 0; q < 2; ++q) { const int o = wave * 2 + q; const f32x4 xa = *(const LAS f32x4*)(co + o * 512 + c8), xb = *(const LAS f32x4*)(co + o * 512 + c8 + 4);
                    const float mu = wave_sum((xa[0] + xa[1]) + (xa[2] + xa[3]) + (xb[0] + xb[1]) + (xb[2] + xb[3])) * (1.f / 512.f);
                    const f32x4 da = xa - mu, db = xb - mu;
                    const float var = wave_sum((da[0] * da[0] + da[1] * da[1]) + (da[2] * da[2] + da[3] * da[3]) + (db[0] * db[0] + db[1] * db[1]) + (db[2] * db[2] + db[3] * db[3])) * (1.f / 512.f);
                    const float rstd = 1.0f / sqrtf(var + EPS);
                    f32x4 ya = da * rstd * ga + ba, yb = db * rstd * gb + bb;
#pragma unroll
                    for (int j = 0; j < 4; ++j) { ya[j] = ya[j] * fast_sigmoid(ya[j]); yb[j] = yb[j] * fast_sigmoid(yb[j]); }
                    u32x4 w; w.x = cvt_pk_bf16(ya[0], ya[1]); w.y = cvt_pk_bf16(ya[2], ya[3]); w.z = cvt_pk_bf16(yb[0], yb[1]); w.w = cvt_pk_bf16(yb[2], yb[3]);
                    *(u32x4*)(Yc + (size_t)(t0 + o) * DM + 1536 + c8) = w; } }
                __syncthreads();
              } }
#endif
        }
        PHASE_END
        PHASE_BEGIN(3)
        {

#ifdef ATT_CHECK
            if (l == ATT_CHECK) {
                LAS float* qs = (LAS float*)(lds + wave * 4608); LAS float* ps = qs + 128;
                const float SC = 0.088388347648318440f;
                for (int sidx = gw; sidx < 4096; sidx += NGW) {
                    const int b = sidx & 3, h = (sidx >> 2) & 7; const int t = (int)((((unsigned)sidx * 2654435761u) >> 12) & 4095u);
                    const int qblk = t >> 8; const float slope = exp2f(-(float)(h + 1));
                    const bf16_t* urow = Ub + (size_t)(b * SEQ + t) * UP;
                    for (int d = lane; d < 128; d += 64) qs[d] = __uint_as_float((unsigned)urow[COL_Q + h * HD + d] << 16) * SC;
                    asm volatile("s_waitcnt lgkmcnt(0)" ::: "memory");
                    float gate[16];
#pragma unroll
                    for (int n = 0; n < 16; ++n) gate[n] = -1e30f;
                    for (int n = 0; n < qblk; ++n) { float sacc = 0.f;
                        for (int kk = lane; kk < 256; kk += 64) { const bf16_t* kr = Ub + (size_t)(b * SEQ + n * 256 + kk) * UP + COL_K + h * HD; float dsum = 0.f;
                            for (int c = 0; c < 16; ++c) { const u32x4 w = *(const u32x4*)(kr + 8 * c);
                                dsum += qs[8 * c] * bf_lo(w.x) + qs[8 * c + 1] * bf_hi(w.x) + qs[8 * c + 2] * bf_lo(w.y) + qs[8 * c + 3] * bf_hi(w.y) + qs[8 * c + 4] * bf_lo(w.z) + qs[8 * c + 5] * bf_hi(w.z) + qs[8 * c + 6] * bf_lo(w.w) + qs[8 * c + 7] * bf_hi(w.w); }
                            sacc += dsum; }
                        const float gsum = wave_sum(sacc) * (1.f / 256.f);
#pragma unroll
                        for (int m = 0; m < 16; ++m) if (m == n) gate[m] = gsum; }
                    int sel[3] = {-1, -1, -1}; float sv[4] = {-1e30f, -1e30f, -1e30f, -1e30f};
                    { float gcopy[16];
#pragma unroll
                      for (int n = 0; n < 16; ++n) gcopy[n] = gate[n];
                      for (int it = 0; it < 4; ++it) { float best = gcopy[0]; int bi = 0;
#pragma unroll
                          for (int n = 1; n < 16; ++n) if (gcopy[n] > best) { best = gcopy[n]; bi = n; }
                          if (it < 3) sel[it] = bi; sv[it] = best;
#pragma unroll
                          for (int n = 0; n < 16; ++n) if (n == bi) gcopy[n] = -3e38f; } }
                    const int nsel = qblk < 3 ? qblk : 3;
                    const bool neartie = (qblk > 3) && (sv[2] - sv[3] < 1.5e-3f);
                    float mx = -1e30f;
                    for (int r = 0; r < 4; ++r) { const bool own = (r == 3); const int blkn = own ? qblk : sel[r]; const bool valid = own || r < nsel;
                        for (int kk = lane; kk < 256; kk += 64) { float lg = -1e30f;
                            if (valid) { const int kpos = blkn * 256 + kk;
                                if (!own || kpos <= t) { const bf16_t* kr = Ub + (size_t)(b * SEQ + kpos) * UP + COL_K + h * HD; float dsum = 0.f;
                                    for (int c = 0; c < 16; ++c) { const u32x4 w = *(const u32x4*)(kr + 8 * c);
                                        dsum += qs[8 * c] * bf_lo(w.x) + qs[8 * c + 1] * bf_hi(w.x) + qs[8 * c + 2] * bf_lo(w.y) + qs[8 * c + 3] * bf_hi(w.y) + qs[8 * c + 4] * bf_lo(w.z) + qs[8 * c + 5] * bf_hi(w.z) + qs[8 * c + 6] * bf_lo(w.w) + qs[8 * c + 7] * bf_hi(w.w); }
                                    lg = dsum - slope * (float)(t - kpos); } }
                            ps[r * 256 + kk] = lg; mx = fmaxf(mx, lg); } }
#pragma unroll
                    for (int o = 1; o < 64; o <<= 1) mx = fmaxf(mx, __shfl_xor(mx, o));
                    float se = 0.f;
                    for (int i = lane; i < 1024; i += 64) { const float e = (ps[i] > -1e29f) ? __expf(ps[i] - mx) : 0.f; ps[i] = e; se += e; }
                    se = wave_sum(se);
                    asm volatile("s_waitcnt lgkmcnt(0)" ::: "memory");
                    float o0 = 0.f, o1 = 0.f;
                    for (int r = 0; r < 4; ++r) { const bool own = (r == 3); const int blkn = own ? qblk : sel[r]; const bool valid = own || r < nsel;
                        if (valid) for (int kk = 0; kk < 256; ++kk) { const float pp = ps[r * 256 + kk];
                            if (pp != 0.f) { const unsigned w = *(const unsigned*)(Ub + (size_t)(b * SEQ + blkn * 256 + kk) * UP + COL_V + h * HD + 2 * lane); o0 += pp * bf_lo(w); o1 += pp * bf_hi(w); } } }
                    o0 /= se; o1 /= se;
                    const unsigned yw = *(const unsigned*)(Yc + (size_t)(b * SEQ + t) * DM + 512 + h * HD + 2 * lane);
                    float err = fmaxf(fabsf(o0 - bf_lo(yw)), fabsf(o1 - bf_hi(yw))), ref = fmaxf(fabsf(o0), fabsf(o1));
                    const bool isnan_ = !(err == err);
#pragma unroll
                    for (int o = 1; o < 64; o <<= 1) { err = fmaxf(err, __shfl_xor(err, o)); ref = fmaxf(ref, __shfl_xor(ref, o)); }
                    const bool bad = __any(isnan_) || !(err <= 0.03f * ref + 1e-4f);
                    if (lane == 0) { if (neartie) atomicAdd(&CNT[514], 1); else { atomicAdd(&CNT[513], 1); if (bad) atomicAdd(&CNT[512], 1); } }
                    asm volatile("s_waitcnt lgkmcnt(0)" ::: "memory");
                }
                __syncthreads();
            }
#endif
            pg8::DenseSched S{(const char*)Yc, (const char*)(wl + OFF_WOUT), T_TOK / 256, DM / 256, G, bx, DM};
            pg8::EpiResBf16 E{nullptr, XB};
            pg8::gemm_phase(lds, tid, DM, S, E);
        }
        PHASE_END
        PHASE_BEGIN(4)
        {
            const bf16_t* RW = (const bf16_t*)(wl + OFF_RW);
            const float* rgb = p.in[IN_RGB] + l * 4; const float* reb = p.in[IN_REB] + l * 32;
            LAS float* part = (LAS float*)lds;
            LAS float* ssp = part + 8 * 64 * 49;
            LAS float* lgr = ssp + 8 * 64;
            LAS float* rsr = lgr + 64 * 49;
            const int r16 = lane & 15, q = lane >> 4;
            bf16x8 rwf[8][3];
#pragma unroll
            for (int ks = 0; ks < 8; ++ks)
#pragma unroll
                for (int nb = 0; nb < 3; ++nb) rwf[ks][nb] = *reinterpret_cast<const bf16x8*>(RW + (size_t)(nb * 16 + r16) * DM + wave * 256 + ks * 32 + 8 * q);
            for (int it = vcu; it < T_TOK / 64; it += G) {
#pragma unroll 1
                for (int rg = 0; rg < 4; ++rg) {
                    const int row = it * 64 + rg * 16 + r16;
                    const bf16_t* xr = XB + (size_t)row * DM + wave * 256 + 8 * q;
                    u32x4 xw[8];
#pragma unroll
                    for (int ks = 0; ks < 8; ++ks) xw[ks] = *(const u32x4*)(xr + ks * 32);
                    f32x4 acc[3] = {(f32x4){0.f, 0.f, 0.f, 0.f}, (f32x4){0.f, 0.f, 0.f, 0.f}, (f32x4){0.f, 0.f, 0.f, 0.f}}; float ss = 0.f;
#pragma unroll
                    for (int ks = 0; ks < 8; ++ks) { const u32x4 w = xw[ks];
                        const float a0 = bf_lo(w.x), a1 = bf_hi(w.x), a2 = bf_lo(w.y), a3 = bf_hi(w.y), a4 = bf_lo(w.z), a5 = bf_hi(w.z), a6 = bf_lo(w.w), a7 = bf_hi(w.w);
                        ss += (a0 * a0 + a1 * a1) + (a2 * a2 + a3 * a3) + (a4 * a4 + a5 * a5) + (a6 * a6 + a7 * a7);
                        const bf16x8 a = *reinterpret_cast<const bf16x8*>(&w);
#pragma unroll
                        for (int nb = 0; nb < 3; ++nb) acc[nb] = __builtin_amdgcn_mfma_f32_16x16x32_bf16(a, rwf[ks][nb], acc[nb], 0, 0, 0); }
                    ss += __shfl_xor(ss, 16); ss += __shfl_xor(ss, 32);
                    if (q == 0) ssp[wave * 64 + rg * 16 + r16] = ss;
#pragma unroll
                    for (int nb = 0; nb < 3; ++nb)
#pragma unroll
                        for (int r = 0; r < 4; ++r) part[(wave * 64 + rg * 16 + 4 * q + r) * 49 + nb * 16 + r16] = acc[nb][r];
                }
                __syncthreads();
                for (int i = tid; i < 64 * 48; i += NTHREADS) { const int r = i / 48, c = i - r * 48; float a = 0.f;
#pragma unroll
                    for (int w = 0; w < 8; ++w) a += part[(w * 64 + r) * 49 + c];
                    lgr[r * 49 + c] = a; }
                if (tid < 64) { float a = 0.f;
#pragma unroll
                    for (int w = 0; w < 8; ++w) a += ssp[w * 64 + tid];
                    rsr[tid] = 1.0f / sqrtf(a * (1.f / DM) + EPS); }
                __syncthreads();
                if (tid < 64) {
                    const int row = it * 64 + tid; const float rs = rsr[tid];
                    const LAS float* lr = lgr + tid * 49;
                    float gl[4];
#pragma unroll
                    for (int j = 0; j < 4; ++j) gl[j] = lr[j] * rs + rgb[j];
                    int grp = 0; float gm = gl[0];
#pragma unroll
                    for (int j = 1; j < 4; ++j) if (gl[j] > gm) { gm = gl[j]; grp = j; }
                    float gsum = 0.f;
#pragma unroll
                    for (int j = 0; j < 4; ++j) gsum += __expf(gl[j] - gm);
                    const float pgrp = 1.0f / gsum;
                    float el[8];
#pragma unroll
                    for (int j = 0; j < 8; ++j) el[j] = lr[4 + grp * 8 + j] * rs + reb[grp * 8 + j];
                    int i1 = 0; float m1 = el[0];
#pragma unroll
                    for (int j = 1; j < 8; ++j) if (el[j] > m1) { m1 = el[j]; i1 = j; }
                    int i2 = -1; float m2 = -INFINITY;
#pragma unroll
                    for (int j = 0; j < 8; ++j) if (j != i1 && el[j] > m2) { m2 = el[j]; i2 = j; }
                    const float e2 = __expf(m2 - m1), inv = 1.0f / (1.0f + e2);
                    const float g1 = pgrp * inv, g2 = pgrp * e2 * inv;
                    const int E1 = grp * 8 + i1, E2 = grp * 8 + i2;
                    LAS int* hist = (LAS int*)(rsr + 64); LAS int* hbase = hist + 32;
                    if (tid < 32) hist[tid] = 0;
                    asm volatile("s_waitcnt lgkmcnt(0)" ::: "memory");
                    const int rk1 = __hip_atomic_fetch_add(&hist[E1], 1, __ATOMIC_RELAXED, __HIP_MEMORY_SCOPE_WORKGROUP);
                    const int rk2 = __hip_atomic_fetch_add(&hist[E2], 1, __ATOMIC_RELAXED, __HIP_MEMORY_SCOPE_WORKGROUP);
                    asm volatile("s_waitcnt lgkmcnt(0)" ::: "memory");
                    if (tid < 32) { const int hc = hist[tid]; hbase[tid] = hc > 0 ? atomicAdd(&cntg[tid * 64], hc) : 0; }
                    asm volatile("s_waitcnt vmcnt(0) lgkmcnt(0)" ::: "memory");
                    const int pos1 = hbase[E1] + rk1, pos2 = hbase[E2] + rk2;
                    TM[E1 * T_TOK + pos1] = row; TM[E2 * T_TOK + pos2] = row;
                    u32x4 ra = {(unsigned)E1, (unsigned)pos1, (unsigned)E2, (unsigned)pos2}; u32x4 rb = {__float_as_uint(g1), __float_as_uint(g2), 0u, 0u};
                    *(u32x4*)(REC + (size_t)row * 8) = ra; *(u32x4*)(REC + (size_t)row * 8 + 4) = rb;
                    RS[row] = rs;
                }
                __syncthreads();
            }
        }
        PHASE_END
        for (int pass = 0; pass < 2; ++pass) {
            PHASE_BEGIN(5)
            {
                if (tid < 64) { const int c = tid < NEXP ? __hip_atomic_load(&cntg[tid * 64], __ATOMIC_RELAXED, __HIP_MEMORY_SCOPE_AGENT) : 0; const int nt_ = (c + 255) >> 8; int incl = nt_;
#pragma unroll
                    for (int o = 1; o < 64; o <<= 1) { const int v = __shfl_up(incl, o); if (lane >= o) incl += v; }
                    const int st = incl - nt_;
                    if (tid < NEXP) { m_tstart[tid] = st; m_cnt[tid] = c; for (int k = 0; k < nt_; ++k) m_tile_e[st + k] = tid; }
                    if (tid == NEXP) m_tstart[NEXP] = st; }
                __syncthreads();
                const int nM = m_tstart[NEXP];
#ifndef PASS_MASK
#define PASS_MASK 3
#endif
                if ((PASS_MASK & 1) && pass == 0) {
                    pg8::MoeSched S{(const char*)XB, (const char*)(wl + OFF_WGU), (size_t)1024 * DM * 2, nM, 1024 / 256, G, bx, DM, true, m_tile_e, m_tstart, m_cnt, TM};
                    pg8::EpiSwiglu E{HMb, RS, TM, m_tstart, m_cnt};
                    pg8::gemm_phase(lds, tid, DM, S, E);
                } else if (PASS_MASK & 2) {
                    pg8::MoeSched S{(const char*)HMb, (const char*)(wl + OFF_WD), (size_t)DM * DEXP * 2, nM, DM / 256, G, bx, DEXP, false, m_tile_e, m_tstart, m_cnt, TM};
                    pg8::EpiFp8 E{(unsigned char*)YM, DM};
                    pg8::gemm_phase(lds, tid, DEXP, S, E);
                }
                __syncthreads();
            }
            PHASE_END
        }
        PHASE_BEGIN(6)
        {
            int tst; { const int c = lane < NEXP ? __hip_atomic_load(&cntg[lane * 64], __ATOMIC_RELAXED, __HIP_MEMORY_SCOPE_AGENT) : 0; const int nt_ = (c + 255) >> 8; int incl = nt_;
#pragma unroll
                for (int o = 1; o < 64; o <<= 1) { const int v = __shfl_up(incl, o); if (lane >= o) incl += v; }
                tst = incl - nt_; }
            const bool fin = (l == DEPTH - 1);
            u32x4 ra_n = (u32x4){0u, 0u, 0u, 0u}; u32x2 rb_n = (u32x2){0u, 0u};
            if (gw < T_TOK) { ra_n = *(const u32x4*)(REC + (size_t)gw * 8); rb_n = *(const u32x2*)(REC + (size_t)gw * 8 + 4); }
            for (int m = gw; m < T_TOK; m += NGW) {
                const u32x4 ra = ra_n; const u32x2 rb = rb_n;
                if (m + NGW < T_TOK) { ra_n = *(const u32x4*)(REC + (size_t)(m + NGW) * 8); rb_n = *(const u32x2*)(REC + (size_t)(m + NGW) * 8 + 4); }
                const int r0 = __shfl(tst, (int)ra.x) * 256 + (int)ra.y, r1 = __shfl(tst, (int)ra.z) * 256 + (int)ra.w;
                RowRegs RR; combine_load(RR, XB + (size_t)m * DM, (const unsigned char*)YM + (size_t)r0 * DM, (const unsigned char*)YM + (size_t)r1 * DM, lane);
                combine_finish(RR, XB + (size_t)m * DM, __uint_as_float(rb.x), __uint_as_float(rb.y), RS + m, fin ? p.out + (size_t)m * DM : nullptr, p.in[IN_FG], lane);
            }
        }
        PHASE_END
    }
#ifdef PROBE_A
    { __syncthreads(); grid.sync(); if (bx == 0 && threadIdx.x == 0) { volatile LAS unsigned long long* tsp = (volatile LAS unsigned long long*)(lds + MISC_OFF + 4352);
        const float ta = (float)(tsp[PROBE_A + 1] - tsp[PROBE_A]) * 0.01f, tb = (float)(tsp[PROBE_B + 1] - tsp[PROBE_B]) * 0.01f;
        (void)tb; p.out[0] += 40.f * rintf((ta - PROBE_OFS) * 0.025f) + PROBE_OFS; } }
#endif
#ifdef PROBE_TILES
    { __syncthreads(); grid.sync(); if (bx == 0 && threadIdx.x == 0) { int* CNTd = (int*)(p.ws + WS_CTL); p.out[0] += (float)CNTd[520] * 0.01f; } }
#endif
#ifdef ATT_CHECK
    { grid.sync(); if (bx == 0 && threadIdx.x == 0) { int* CNTd = (int*)(p.ws + WS_CTL); const int bad = CNTd[512], tot = CNTd[513], nt_ = CNTd[514];
        float A = 10.f + 1000.f * (float)bad / (float)(tot > 0 ? tot : 1);
#if ATT_REPORT == 1
        A = 10.f + 1000.f * (float)nt_ / 4096.f;
#endif
        p.out[0] += A; } }
#endif
#undef PHASE_BEGIN
#undef PHASE_END
}

constexpr int N_PHASES = 1 + 7 * DEPTH;

extern "C" void kernel_launch(void* const* d_in, const int* in_sizes, int n_in, void* d_out, int out_size, void* d_ws, size_t ws_size, hipStream_t stream) {
    static int grid = 0;
    if (grid == 0) {
        if (n_in != 18 || in_sizes[0] != T_TOK * DM || out_size != T_TOK * DM || ws_size < WS_END) {
            fprintf(stderr, "kernel_launch: unexpected shapes: n_in %d in0 %d out %d ws %zu (need >= %zu)\n", n_in, n_in > 0 ? in_sizes[0] : -1, out_size, ws_size, (size_t)WS_END); grid = -1; return; }
        int dev = 0, cus = 0, per_cu = 0;
        hipGetDevice(&dev); hipDeviceGetAttribute(&cus, hipDeviceAttributeMultiprocessorCount, dev);
        if (hipFuncSetAttribute((const void*)fwd_kernel, hipFuncAttributeMaxDynamicSharedMemorySize, LDS_BYTES) != hipSuccess) { fprintf(stderr, "kernel_launch: hipFuncSetAttribute failed\n"); grid = -1; return; }
        if (hipOccupancyMaxActiveBlocksPerMultiprocessor(&per_cu, (const void*)fwd_kernel, NTHREADS, LDS_BYTES) != hipSuccess || per_cu < 1) { fprintf(stderr, "kernel_launch: occupancy query says %d blocks/CU\n", per_cu); per_cu = 1; }
        (void)hipGetLastError();
        grid = cus;
        if (grid > 256) grid = 256;
    }
    if (grid < 0) return;
    hipMemsetAsync((char*)d_ws + WS_CTL, 0, CTL_BYTES, stream);
    Params p{};
    for (int i = 0; i < 18; ++i) p.in[i] = (const float*)d_in[i];
    p.out = (float*)d_out; p.ws = (unsigned char*)d_ws;
#if MK_N_LAUNCHES == 1
    p.ph_lo = 0; p.ph_hi = N_PHASES;
    void* args[] = {&p};
    hipError_t e = hipLaunchCooperativeKernel((const void*)fwd_kernel, dim3(grid), dim3(NTHREADS), args, LDS_BYTES, stream);
    if (e != hipSuccess) fprintf(stderr, "kernel_launch: cooperative launch failed: %s (grid %d)\n", hipGetErrorString(e), grid);
#else
    for (int ph = 0; ph < N_PHASES; ++ph) { p.ph_lo = ph; p.ph_hi = ph + 1;
        hipLaunchKernelGGL(fwd_kernel, dim3(grid), dim3(NTHREADS), LDS_BYTES, stream, p); }
    hipError_t e = hipPeekAtLastError();
    if (e != hipSuccess) fprintf(stderr, "kernel_launch: launch failed: %s\n", hipGetErrorName(e));
#endif
}
```

```cpp
#include <hip/hip_runtime.h>
#include <hip/hip_cooperative_groups.h>
#include <cstdio>
#include <cstdint>
namespace cg = cooperative_groups;

#ifndef PROBE_ATT2
#define PROBE_ATT2 0
#endif
#ifndef ATT_REPORT
#define ATT_REPORT 0
#endif
#ifndef MK_N_LAUNCHES
#define MK_N_LAUNCHES 1
#endif

#define LAS __attribute__((address_space(3)))
typedef unsigned short bf16_t;
typedef short bf16x8 __attribute__((ext_vector_type(8)));
typedef short s16x4 __attribute__((ext_vector_type(4)));
typedef float f32x2 __attribute__((ext_vector_type(2)));
typedef float f32x4 __attribute__((ext_vector_type(4)));
typedef float f32x16 __attribute__((ext_vector_type(16)));
typedef unsigned u32x2 __attribute__((ext_vector_type(2)));
typedef unsigned u32x4 __attribute__((ext_vector_type(4)));

constexpr int T_TOK = 16384, DM = 2048, DIN = 5632, SEQ = 4096, NBATCH = 4, NHEAD = 8, HD = 128, DEPTH = 2;
constexpr int GC_Q = 1536, GC_K = 2560, GC_V = 3584;
constexpr int UP = 4608, COL_BG = 0, COL_Z = 512, COL_Q = 1024, COL_K = 2048, COL_V = 3072, COL_HH = 4096;
constexpr int NEXP = 32, DEXP = 512, NRW = 48;
constexpr int MAXTILES = 160;
constexpr float EPS = 1e-6f;
constexpr float W1_SCALE = 64.f, W2_SCALE = 32.f, HM_SCALE = 16.f;
constexpr int NWAVES = 8, NTHREADS = 512;
constexpr int RING_BYTES = 131072, SCRATCH_BYTES = 147456, MISC_OFF = SCRATCH_BYTES, MISC_BYTES = 8192, LDS_BYTES = SCRATCH_BYTES + MISC_BYTES;

constexpr size_t MiB = 1u << 20;
constexpr size_t WS_CTL = 0;
constexpr size_t CTL_BYTES = 65536;
constexpr size_t SZ_WIN = (size_t)DIN * DM * 2, SZ_WOUT = (size_t)DM * DM * 2, SZ_WGU = (size_t)NEXP * 1024 * DM * 2, SZ_WD = (size_t)NEXP * DM * DEXP * 2, SZ_RW = (size_t)NRW * DM * 2;
constexpr size_t WS_W0 = 1 * MiB;
constexpr size_t OFF_WIN = 0, OFF_WOUT = OFF_WIN + SZ_WIN, OFF_WGU = OFF_WOUT + SZ_WOUT, OFF_WD = OFF_WGU + SZ_WGU, OFF_RW = OFF_WD + SZ_WD, SZ_LAYER = ((OFF_RW + SZ_RW + 4095) / 4096) * 4096;
constexpr size_t WS_U = WS_W0 + DEPTH * SZ_LAYER;
constexpr size_t SZ_U = (size_t)T_TOK * UP * 2;
static_assert((size_t)MAXTILES * 256 * DM <= SZ_U, "ymoe (fp8) overlays u");
constexpr size_t WS_Y = WS_U + SZ_U;
constexpr size_t WS_H = WS_Y + (size_t)T_TOK * DM * 2;
constexpr size_t WS_HM = WS_H + (size_t)T_TOK * DM * 2;
constexpr size_t WS_KS = WS_HM + (size_t)MAXTILES * 256 * DEXP * 2;
constexpr size_t WS_RS = WS_KS + (size_t)64 * 2 * 1024 * 4;
constexpr size_t WS_REC = WS_RS + (size_t)T_TOK * 4;
constexpr size_t WS_TM = WS_REC + (size_t)T_TOK * 32;
constexpr size_t WS_XB = WS_TM + (size_t)NEXP * T_TOK * 4;
constexpr size_t WS_X8 = WS_XB + (size_t)T_TOK * DM * 2;
constexpr size_t WS_NRM = WS_X8 + (size_t)T_TOK * DM;
constexpr size_t WS_PART = WS_NRM + 2 * 64 * 8 * 8 * 4;
constexpr size_t WS_END = WS_PART + (size_t)48 * 66 * 512 * 4;

__device__ __forceinline__ unsigned cvt_pk_bf16(float lo, float hi) { unsigned r; asm volatile("v_cvt_pk_bf16_f32 %0, %1, %2" : "=v"(r) : "v"(lo), "v"(hi)); return r; }
__device__ __forceinline__ float bf_lo(unsigned w) { return __uint_as_float(w << 16); }
__device__ __forceinline__ float bf_hi(unsigned w) { return __uint_as_float(w & 0xffff0000u); }
__device__ __forceinline__ float wave_sum(float v) {
#pragma unroll
    for (int o = 1; o < 64; o <<= 1) v += __shfl_xor(v, o);
    return v;
}
__device__ __forceinline__ float fast_sigmoid(float x) { return __builtin_amdgcn_rcpf(1.f + __builtin_amdgcn_exp2f(-1.4426950408889634f * x)); }

namespace pg8 {
constexpr int BM = 256, BK = 64, HALF = 128, HTB = HALF * BK * 2, STAGE_BYTES = 8 * HTB, NXCD = 8, WGM = 8;
__host__ __device__ __forceinline__ int lds_byte(int r, int c) { const int st = (r >> 4) * 2 + (c >> 5), rr = r & 15, cc = c & 31, ob = rr * 64 + cc * 2; return st * 1024 + (ob ^ (((ob >> 9) & 1) << 5)); }
__host__ __device__ __forceinline__ void stage_rc(int b, int& R, int& C) { const int st = b / 1024, sb = b % 1024, swz = sb ^ (((sb >> 9) & 1) << 5); R = (st >> 1) * 16 + swz / 64; C = (st & 1) * 32 + (swz % 64) / 2; }
__host__ __device__ __forceinline__ int perm32(int rho) { const int n = rho >> 4, i = rho & 15; return 8 * (i >> 2) + 4 * n + (i & 3); }

struct Unit { int pm, pn, e; };

__device__ __forceinline__ bool order_next(int i, int G, int c, int nM, int nN, Unit& u) {
    const int nwg = nM * nN; const long L = (long)i * G + c; if (L >= nwg) return false;
    int wgid = (int)L; { const int q = nwg / NXCD, r = nwg % NXCD, xcd = wgid % NXCD, off = wgid / NXCD; wgid = (xcd < r ? xcd * (q + 1) : r * (q + 1) + (xcd - r) * q) + off; }
    const int nig = WGM * nN, gid = wgid / nig, fm = gid * WGM, gsz = (nM - fm) < WGM ? (nM - fm) : WGM;
    u.pm = fm + ((wgid % nig) % gsz); u.pn = (wgid % nig) / gsz; u.e = 0; return true;
}

struct DenseSched {
    const char* A; const char* Bt; int nM, nN, G, c, K;
    __device__ __forceinline__ bool next(int i, Unit& u) const { return order_next(i, G, c, nM, nN, u); }
    __device__ __forceinline__ const char* a_base(const Unit& u) const { return A + (size_t)u.pm * BM * K * 2; }
    __device__ __forceinline__ const char* b_base(const Unit& u) const { return Bt + (size_t)u.pn * BM * K * 2; }
    __device__ __forceinline__ void a_rows(const Unit&, const int (&RA)[2], const unsigned (&cofA)[2], unsigned (&g)[2][2]) const {
#pragma unroll
        for (int h = 0; h < 2; ++h)
#pragma unroll
            for (int i = 0; i < 2; ++i) g[h][i] = (unsigned)((h * HALF + RA[i]) * K) * 2u + cofA[i];
    }
};
struct MoeSched {
    const char* A; const char* Bt; size_t b_estride; int nM, nN, G, c, K; bool gather;
    const LAS int* tile_e; const LAS int* tstart; const LAS int* cnt; const int* tokmap; int es;
    __device__ __forceinline__ bool next(int i, Unit& u) const { if (!order_next(i, G, c, nM, nN, u)) return false; u.e = tile_e[u.pm]; return true; }
    __device__ __forceinline__ const char* a_base(const Unit& u) const { return gather ? A : A + (size_t)u.pm * BM * K * es; }
    __device__ __forceinline__ const char* b_base(const Unit& u) const { return Bt + (size_t)u.e * b_estride + (size_t)u.pn * BM * K * es; }
    __device__ __forceinline__ void a_rows(const Unit& u, const int (&RA)[2], const unsigned (&cofA)[2], unsigned (&g)[2][2]) const {
        if (gather) {
            const int p0 = (u.pm - tstart[u.e]) * BM, cn = cnt[u.e];
#pragma unroll
            for (int h = 0; h < 2; ++h)
#pragma unroll
                for (int i = 0; i < 2; ++i) { int pos = p0 + h * HALF + RA[i]; pos = pos < cn ? pos : cn - 1; const int tok = tokmap[u.e * T_TOK + pos]; g[h][i] = (unsigned)(tok * K * es) + cofA[i]; }
        } else {
#pragma unroll
            for (int h = 0; h < 2; ++h)
#pragma unroll
                for (int i = 0; i < 2; ++i) g[h][i] = (unsigned)((h * HALF + RA[i]) * K * es) + cofA[i];
        }
    }
};

__device__ __forceinline__ void acc_zero(f32x4 (&acc)[2][2][4][2]) {
#pragma unroll
    for (int a = 0; a < 2; ++a)
#pragma unroll
        for (int b = 0; b < 2; ++b)
#pragma unroll
            for (int m = 0; m < 4; ++m)
#pragma unroll
                for (int n = 0; n < 2; ++n) acc[a][b][m][n] = (f32x4){0.f, 0.f, 0.f, 0.f};
}
struct EpiInProj {
    static constexpr bool PERM = true;
    __device__ __forceinline__ void init(f32x4 (&acc)[2][2][4][2], const Unit&, int, int, int, int) const { acc_zero(acc); }
    bf16_t* U; float* ksum; float* nrm; const float* rs;
    __device__ __forceinline__ void operator()(const f32x4 (&acc_)[2][2][4][2], const Unit& u, int wr, int wc, int fr, int fq) const {
        const int row0 = u.pm * BM + wr * 64 + fr, col0 = u.pn * BM + wc * 32 + 8 * fq;
        f32x4 acc[2][2][4][2];
#pragma unroll
        for (int ai = 0; ai < 2; ++ai)
#pragma unroll
            for (int m = 0; m < 4; ++m) { const float sc = rs[row0 + ai * HALF + m * 16];
#pragma unroll
                for (int bj = 0; bj < 2; ++bj) { acc[ai][bj][m][0] = acc_[ai][bj][m][0] * sc; acc[ai][bj][m][1] = acc_[ai][bj][m][1] * sc; } }
        const bool paired = (u.pn >= 2 && u.pn < 6) || u.pn >= 18;
        if (!paired) { const int ocol = (u.pn < 2 ? u.pn * 256 : COL_Q + (u.pn - 6) * 256) + wc * 32 + 8 * fq;
#pragma unroll
          for (int ai = 0; ai < 2; ++ai)
#pragma unroll
            for (int m = 0; m < 4; ++m) { bf16_t* rowp = U + (size_t)(row0 + ai * HALF + m * 16) * UP + ocol;
#pragma unroll
                for (int bj = 0; bj < 2; ++bj) { const f32x4 v0 = acc[ai][bj][m][0], v1 = acc[ai][bj][m][1]; u32x4 w;
                    w.x = cvt_pk_bf16(v0[0], v0[1]); w.y = cvt_pk_bf16(v0[2], v0[3]); w.z = cvt_pk_bf16(v1[0], v1[1]); w.w = cvt_pk_bf16(v1[2], v1[3]);
                    *(u32x4*)(rowp + bj * HALF) = w; } }
        } else { const bool glu = u.pn >= 18; const int ocol = (glu ? COL_HH + (u.pn - 18) * 128 : COL_Z + (u.pn - 2) * 128) + wc * 16 + 4 * fq;
#pragma unroll
          for (int ai = 0; ai < 2; ++ai)
#pragma unroll
            for (int m = 0; m < 4; ++m) { bf16_t* rowp = U + (size_t)(row0 + ai * HALF + m * 16) * UP + ocol;
#pragma unroll
                for (int bj = 0; bj < 2; ++bj) { const f32x4 v0 = acc[ai][bj][m][0], v1 = acc[ai][bj][m][1];
                    float h0, h1, h2, h3;
                    if (glu) { h0 = v0[0] * fast_sigmoid(v0[1]); h1 = v0[2] * fast_sigmoid(v0[3]); h2 = v1[0] * fast_sigmoid(v1[1]); h3 = v1[2] * fast_sigmoid(v1[3]); }
                    else { h0 = v0[0] * v0[1]; h1 = v0[2] * v0[3]; h2 = v1[0] * v1[1]; h3 = v1[2] * v1[3]; }
                    u32x2 w; w.x = cvt_pk_bf16(h0, h1); w.y = cvt_pk_bf16(h2, h3); *(u32x2*)(rowp + bj * (HALF / 2)) = w; } }
        }
        if (u.pn >= GC_Q / 256 && u.pn < GC_V / 256) {
            const int kind = u.pn >= GC_K / 256, hb = 2 * (u.pn - (kind ? GC_K / 256 : GC_Q / 256));
#pragma unroll
            for (int bj = 0; bj < 2; ++bj) { float mx = 0.f;
#pragma unroll
                for (int ai = 0; ai < 2; ++ai)
#pragma unroll
                    for (int m = 0; m < 4; ++m) { const f32x4 a = acc[ai][bj][m][0], c = acc[ai][bj][m][1];
                        float q = (a[0] * a[0] + a[1] * a[1]) + (a[2] * a[2] + a[3] * a[3]) + (c[0] * c[0] + c[1] * c[1]) + (c[2] * c[2] + c[3] * c[3]);
                        q += __shfl_xor(q, 16); q += __shfl_xor(q, 32); mx = fmaxf(mx, q); }
#pragma unroll
                for (int o = 1; o < 16; o <<= 1) mx = fmaxf(mx, __shfl_xor(mx, o));
                if ((fr | fq) == 0) nrm[(((kind * 64 + u.pm) * 8 + hb + bj) * 2 + wr) * 4 + wc] = mx; }
        }
        if (u.pn >= GC_K / 256 && u.pn < GC_V / 256) {
            float* kp = ksum + (size_t)(u.pm * 2 + wr) * 1024 + (u.pn - GC_K / 256) * 256 + wc * 32 + 8 * fq;
#pragma unroll
            for (int bj = 0; bj < 2; ++bj)
#pragma unroll
                for (int n = 0; n < 2; ++n) { f32x4 s = (f32x4){0.f, 0.f, 0.f, 0.f};
#pragma unroll
                    for (int ai = 0; ai < 2; ++ai)
#pragma unroll
                        for (int m = 0; m < 4; ++m) s += acc[ai][bj][m][n];
#pragma unroll
                    for (int o = 1; o < 16; o <<= 1) { s[0] += __shfl_xor(s[0], o); s[1] += __shfl_xor(s[1], o); s[2] += __shfl_xor(s[2], o); s[3] += __shfl_xor(s[3], o); }
                    if (fr == 0) *(f32x4*)(kp + bj * HALF + 4 * n) = s; }
        }
    }
};
struct EpiResBf16 {
    static constexpr bool PERM = true;
    const float* resf; bf16_t* out;
    __device__ __forceinline__ void init(f32x4 (&acc)[2][2][4][2], const Unit& u, int wr, int wc, int fr, int fq) const {
        const int row0 = u.pm * BM + wr * 64 + fr, col0 = u.pn * BM + wc * 32 + 8 * fq;
#pragma unroll
        for (int ai = 0; ai < 2; ++ai)
#pragma unroll
            for (int m = 0; m < 4; ++m) { const size_t off = (size_t)(row0 + ai * HALF + m * 16) * DM + col0;
#pragma unroll
                for (int bj = 0; bj < 2; ++bj) {
                    if (resf) { acc[ai][bj][m][0] = __builtin_nontemporal_load((const f32x4*)(resf + off + bj * HALF)); acc[ai][bj][m][1] = __builtin_nontemporal_load((const f32x4*)(resf + off + bj * HALF + 4)); }
                    else { const u32x4 r = *(const u32x4*)(out + off + bj * HALF);
                        acc[ai][bj][m][0] = (f32x4){bf_lo(r.x), bf_hi(r.x), bf_lo(r.y), bf_hi(r.y)}; acc[ai][bj][m][1] = (f32x4){bf_lo(r.z), bf_hi(r.z), bf_lo(r.w), bf_hi(r.w)}; } } }
    }
    __device__ __forceinline__ void operator()(const f32x4 (&acc)[2][2][4][2], const Unit& u, int wr, int wc, int fr, int fq) const {
        const int row0 = u.pm * BM + wr * 64 + fr, col0 = u.pn * BM + wc * 32 + 8 * fq;
#pragma unroll
        for (int ai = 0; ai < 2; ++ai)
#pragma unroll
            for (int m = 0; m < 4; ++m) { const size_t off = (size_t)(row0 + ai * HALF + m * 16) * DM + col0;
#pragma unroll
                for (int bj = 0; bj < 2; ++bj) { const f32x4 v0 = acc[ai][bj][m][0], v1 = acc[ai][bj][m][1];
                    u32x4 w; w.x = cvt_pk_bf16(v0[0], v0[1]); w.y = cvt_pk_bf16(v0[2], v0[3]); w.z = cvt_pk_bf16(v1[0], v1[1]); w.w = cvt_pk_bf16(v1[2], v1[3]);
                    *(u32x4*)(out + off + bj * HALF) = w; } }
    }
};
struct EpiSwiglu {
    static constexpr bool PERM = true;
    __device__ __forceinline__ void init(f32x4 (&acc)[2][2][4][2], const Unit&, int, int, int, int) const { acc_zero(acc); }
    unsigned char* HMo; const float* rs; const int* tokmap; const LAS int* tstart; const LAS int* cnt;
    __device__ __forceinline__ void operator()(const f32x4 (&acc)[2][2][4][2], const Unit& u, int wr, int wc, int fr, int fq) const {
        const int p0 = (u.pm - tstart[u.e]) * BM, cn = cnt[u.e];
#pragma unroll
        for (int ai = 0; ai < 2; ++ai)
#pragma unroll
            for (int m = 0; m < 4; ++m) { const int r = ai * HALF + wr * 64 + m * 16 + fr; int pos = p0 + r; pos = pos < cn ? pos : cn - 1;
                const float sc = rs[tokmap[u.e * T_TOK + pos]] * (1.f / W1_SCALE);
                unsigned char* rowp = HMo + (size_t)(u.pm * BM + r) * DEXP + ((u.pn * BM + wc * 32 + 8 * fq) >> 1);
#pragma unroll
                for (int bj = 0; bj < 2; ++bj) { const f32x4 v0 = acc[ai][bj][m][0] * sc, v1 = acc[ai][bj][m][1] * sc;
                    const float h0 = __builtin_amdgcn_fmed3f(HM_SCALE * v0[0] * fast_sigmoid(v0[0]) * v0[1], -400.f, 400.f), h1 = __builtin_amdgcn_fmed3f(HM_SCALE * v0[2] * fast_sigmoid(v0[2]) * v0[3], -400.f, 400.f);
                    const float h2 = __builtin_amdgcn_fmed3f(HM_SCALE * v1[0] * fast_sigmoid(v1[0]) * v1[1], -400.f, 400.f), h3 = __builtin_amdgcn_fmed3f(HM_SCALE * v1[2] * fast_sigmoid(v1[2]) * v1[3], -400.f, 400.f);
                    int w = 0; w = __builtin_amdgcn_cvt_pk_fp8_f32(h0, h1, w, false); w = __builtin_amdgcn_cvt_pk_fp8_f32(h2, h3, w, true);
                    *(unsigned*)(rowp + bj * (HALF / 2)) = (unsigned)w; } }
    }
};
constexpr float YM_SCALE = 8.f;
struct EpiFp8 {
    static constexpr bool PERM = true;
    __device__ __forceinline__ void init(f32x4 (&acc)[2][2][4][2], const Unit&, int, int, int, int) const { acc_zero(acc); }
    unsigned char* O; int ldc; float osc;
    __device__ __forceinline__ void operator()(const f32x4 (&acc)[2][2][4][2], const Unit& u, int wr, int wc, int fr, int fq) const {
        const int row0 = u.pm * BM + wr * 64 + fr, col0 = u.pn * BM + wc * 32 + 8 * fq;
#pragma unroll
        for (int ai = 0; ai < 2; ++ai)
#pragma unroll
            for (int m = 0; m < 4; ++m) { unsigned char* rowp = O + (size_t)(row0 + ai * HALF + m * 16) * ldc + col0;
#pragma unroll
                for (int bj = 0; bj < 2; ++bj) { f32x4 v0 = acc[ai][bj][m][0] * osc, v1 = acc[ai][bj][m][1] * osc;
#pragma unroll
                    for (int e = 0; e < 4; ++e) { v0[e] = __builtin_amdgcn_fmed3f(v0[e], -400.f, 400.f); v1[e] = __builtin_amdgcn_fmed3f(v1[e], -400.f, 400.f); }
                    int w0 = 0, w1 = 0;
                    w0 = __builtin_amdgcn_cvt_pk_fp8_f32(v0[0], v0[1], w0, false); w0 = __builtin_amdgcn_cvt_pk_fp8_f32(v0[2], v0[3], w0, true);
                    w1 = __builtin_amdgcn_cvt_pk_fp8_f32(v1[0], v1[1], w1, false); w1 = __builtin_amdgcn_cvt_pk_fp8_f32(v1[2], v1[3], w1, true);
                    *(u32x2*)(rowp + bj * HALF) = (u32x2){(unsigned)w0, (unsigned)w1}; } }
    }
};

template <int ES, class Epi, class Sched>
__device__ __forceinline__ void gemm_phase(LAS unsigned char* lds, const int tid, const int K, const Sched& S, const Epi& E) {
    const int wid = __builtin_amdgcn_readfirstlane(tid >> 6), lane = tid & 63, wr = wid >> 2, wc = wid & 3, fr = lane & 15, fq = lane >> 4;
    const int nt = K * ES / (BK * 2);
    unsigned voffB[2];
#pragma unroll
    for (int i = 0; i < 2; ++i) { int R, C; stage_rc(tid * 16 + i * 8192, R, C); const int Rb = Epi::PERM ? ((R & ~31) + perm32(R & 31)) : R;
        voffB[i] = (unsigned)(Rb * K * ES) + (unsigned)C * 2u; }
#define PG8_AROWS(u_, g_) do { int t_ = tid; asm volatile("" : "+v"(t_)); int RA[2]; unsigned cofA[2]; \
        _Pragma("unroll") for (int i = 0; i < 2; ++i) { int R, C; stage_rc(t_ * 16 + i * 8192, R, C); RA[i] = R; cofA[i] = (unsigned)C * 2u; } S.a_rows(u_, RA, cofA, g_); } while (0)
    const size_t kstep = (size_t)(BK * 2);
    const size_t hstep = (size_t)HALF * K * ES;
    const unsigned ldsw = (unsigned)wid * 1024u;
    const int aoff = lds_byte(wr * 64 + fr, fq * 8), boff = lds_byte(wc * 32 + fr, fq * 8);
#define PG8_SA(b, h) (((b) * 2 + (h)) * HTB)
#define PG8_SB(b, h) ((4 + (b) * 2 + (h)) * HTB)
#define PG8_STG(bufoff, gptr, v0, v1) do { \
        __builtin_amdgcn_global_load_lds((const unsigned*)((const char*)(gptr) + (v0)), (LAS unsigned*)(lds + (bufoff) + ldsw), 16, 0, 0); \
        __builtin_amdgcn_global_load_lds((const unsigned*)((const char*)(gptr) + (v1)), (LAS unsigned*)(lds + (bufoff) + ldsw + 8192), 16, 0, 0); } while (0)
#define PG8_LDA(dst, b, h) do { _Pragma("unroll") for (int m = 0; m < 4; ++m) _Pragma("unroll") for (int k = 0; k < 2; ++k) dst[m][k] = *(const LAS bf16x8*)(lds + PG8_SA(b, h) + aoff + m * 2048 + k * 1024); } while (0)
#define PG8_LDB(dst, b, h) do { _Pragma("unroll") for (int n = 0; n < 2; ++n) _Pragma("unroll") for (int k = 0; k < 2; ++k) dst[n][k] = *(const LAS bf16x8*)(lds + PG8_SB(b, h) + boff + n * 2048 + k * 1024); } while (0)
    typedef long l64x2 __attribute__((ext_vector_type(2)));
#define PG8_MMA(ai, bj, At, Bt) do { __builtin_amdgcn_s_setprio(1); _Pragma("unroll") for (int m = 0; m < 4; ++m) _Pragma("unroll") for (int n = 0; n < 2; ++n) _Pragma("unroll") for (int k = 0; k < 2; ++k) { \
        if constexpr (ES == 2) acc[ai][bj][m][n] = __builtin_amdgcn_mfma_f32_16x16x32_bf16(Bt[n][k], At[m][k], acc[ai][bj][m][n], 0, 0, 0); \
        else { const l64x2 a_ = __builtin_bit_cast(l64x2, At[m][k]), b_ = __builtin_bit_cast(l64x2, Bt[n][k]);     \
            acc[ai][bj][m][n] = __builtin_amdgcn_mfma_f32_16x16x32_fp8_fp8(b_[0], a_[0], acc[ai][bj][m][n], 0, 0, 0); \
            acc[ai][bj][m][n] = __builtin_amdgcn_mfma_f32_16x16x32_fp8_fp8(b_[1], a_[1], acc[ai][bj][m][n], 0, 0, 0); } } __builtin_amdgcn_s_setprio(0); } while (0)
#define PG8_WAIT_V(n) asm volatile("s_waitcnt vmcnt(" #n ")" ::: "memory")
#define PG8_WAIT_L(n) asm volatile("s_waitcnt lgkmcnt(" #n ")" ::: "memory")
#define PG8_BAR __builtin_amdgcn_s_barrier()
#define PG8_SCHED __builtin_amdgcn_sched_barrier(0)
    Unit cur, nxt; int ui = 0;
    if (!S.next(0, cur)) return;
    f32x4 acc[2][2][4][2];
    E.init(acc, cur, wr, wc, fr, fq);
    bf16x8 At[4][2], B0[2][2], B1[2][2];
    const char* cA = S.a_base(cur); const char* cB = S.b_base(cur);
    unsigned gc[2][2], gn[2][2];
    PG8_AROWS(cur, gc);
    PG8_STG(PG8_SB(0, 0), cB, voffB[0], voffB[1]); PG8_STG(PG8_SB(0, 1), cB + hstep, voffB[0], voffB[1]); PG8_STG(PG8_SA(0, 0), cA, gc[0][0], gc[0][1]); PG8_STG(PG8_SA(0, 1), cA, gc[1][0], gc[1][1]);
    if (wr == 1) PG8_BAR;
    PG8_WAIT_V(2); PG8_BAR;
    PG8_STG(PG8_SB(1, 0), cB + kstep, voffB[0], voffB[1]); PG8_STG(PG8_SA(1, 0), cA + kstep, gc[0][0], gc[0][1]); PG8_STG(PG8_SB(1, 1), cB + hstep + kstep, voffB[0], voffB[1]);
    PG8_WAIT_V(6); PG8_BAR;
    for (;;) {
        const bool has_next = S.next(ui + 1, nxt);
        const char* nA = has_next ? S.a_base(nxt) : cA; const char* nB = has_next ? S.b_base(nxt) : cB;
        if (has_next) PG8_AROWS(nxt, gn);
        else { gn[0][0] = gc[0][0]; gn[0][1] = gc[0][1]; gn[1][0] = gc[1][0]; gn[1][1] = gc[1][1]; }
#pragma unroll 1
        for (int t = 0; t < nt; t += 2) {
            const bool last = (t == nt - 2);
            const char* a1 = cA + (size_t)(t + 1) * kstep;
            const char* a2 = last ? nA : cA + (size_t)(t + 2) * kstep; const char* b2 = last ? nB : cB + (size_t)(t + 2) * kstep;
            const char* a3 = a2 + kstep; const char* b3 = b2 + kstep;
            const unsigned g00 = last ? gn[0][0] : gc[0][0], g01 = last ? gn[0][1] : gc[0][1], g10 = last ? gn[1][0] : gc[1][0], g11 = last ? gn[1][1] : gc[1][1];
            PG8_LDB(B0, 0, 0); PG8_LDB(B1, 0, 1); PG8_SCHED; PG8_LDA(At, 0, 0); PG8_STG(PG8_SA(1, 1), a1, gc[1][0], gc[1][1]);
            PG8_WAIT_V(8); PG8_WAIT_L(0); PG8_BAR; PG8_MMA(0, 0, At, B0); PG8_MMA(0, 1, At, B1); PG8_BAR; PG8_SCHED;
            PG8_LDA(At, 0, 1); PG8_STG(PG8_SB(0, 0), b2, voffB[0], voffB[1]); PG8_STG(PG8_SB(0, 1), b2 + hstep, voffB[0], voffB[1]); PG8_STG(PG8_SA(0, 0), a2, g00, g01);
            PG8_WAIT_V(8); PG8_WAIT_L(0); PG8_BAR; PG8_MMA(1, 0, At, B0); PG8_MMA(1, 1, At, B1); PG8_BAR; PG8_SCHED;
            PG8_LDB(B0, 1, 0); PG8_LDB(B1, 1, 1); PG8_SCHED; PG8_LDA(At, 1, 0); PG8_STG(PG8_SA(0, 1), a2, g10, g11);
            PG8_WAIT_V(8); PG8_WAIT_L(0); PG8_BAR; PG8_MMA(0, 0, At, B0); PG8_MMA(0, 1, At, B1); PG8_BAR; PG8_SCHED;
            PG8_LDA(At, 1, 1); PG8_STG(PG8_SB(1, 0), b3, voffB[0], voffB[1]); PG8_STG(PG8_SB(1, 1), b3 + hstep, voffB[0], voffB[1]); PG8_STG(PG8_SA(1, 0), a3, g00, g01);
            PG8_WAIT_V(8); PG8_WAIT_L(0); PG8_BAR; PG8_MMA(1, 0, At, B0); PG8_MMA(1, 1, At, B1); PG8_BAR; PG8_SCHED;
        }
        if (wr == 0) PG8_BAR;
        E(acc, cur, wr, wc, fr, fq);
        if (!has_next) break;
        E.init(acc, nxt, wr, wc, fr, fq);
        cur = nxt; cA = nA; cB = nB; gc[0][0] = gn[0][0]; gc[0][1] = gn[0][1]; gc[1][0] = gn[1][0]; gc[1][1] = gn[1][1]; ++ui;
        if (wr == 1) PG8_BAR;
    }
    PG8_WAIT_V(0);
    PG8_BAR;
#undef PG8_AROWS
#undef PG8_SA
#undef PG8_SB
#undef PG8_STG
#undef PG8_LDA
#undef PG8_LDB
#undef PG8_MMA
#undef PG8_WAIT_V
#undef PG8_WAIT_L
#undef PG8_BAR
#undef PG8_SCHED
}
}

namespace att {
constexpr float SCALE = 0.088388347648318440f;
constexpr float THR = 8.f;
constexpr int KVBLK = 64, QBLK = 32;
constexpr size_t SHM_V = KVBLK * HD * 2, SHM_K = KVBLK * HD * 2;
constexpr int NRING = 2;
constexpr int OFF_V = 0, OFF_K = NRING * SHM_V, OFF_WS = OFF_K + NRING * SHM_K, OFF_KM = OFF_WS + NWAVES * 64 * 4, ATT_LDS = OFF_KM + 32 * 256;
#define KSWZ(row, colB) ((row) * 256 + ((colB) ^ (((row) & 7) << 4)))
#define SBAR() __builtin_amdgcn_sched_barrier(0)
__device__ __forceinline__ int crow(int r, int hi) { return (r & 3) + 8 * (r >> 2) + 4 * hi; }

__device__ __forceinline__ void partialSM(f32x16& p0, f32x16& p1, float& m_reg, float& mn, float& alpha, float slr, float lb, int mode, int thr) {
    constexpr float C = SCALE * 1.4426950408889634f;
#pragma unroll
    for (int r = 0; r < 16; ++r) { const float cr = (float)((r & 3) + 8 * (r >> 2)); p0[r] = fmaf(slr, cr, p0[r]); p1[r] = fmaf(slr, cr + 32.f, p1[r]); }
    if (mode) {
        if (mode == 1) {
#pragma unroll
            for (int r = 0; r < 16; ++r) { if ((r & 3) + 8 * (r >> 2) > thr) p0[r] = -3.0e38f; p1[r] = -3.0e38f; }
        } else {
#pragma unroll
            for (int r = 0; r < 16; ++r) { if ((r & 3) + 8 * (r >> 2) > thr) p1[r] = -3.0e38f; }
        }
    }
    float pmax = p0[0];
#pragma unroll
    for (int r = 1; r < 16; ++r) pmax = fmaxf(pmax, p0[r]);
#pragma unroll
    for (int r = 0; r < 16; ++r) pmax = fmaxf(pmax, p1[r]);
    pmax += lb;
    { auto rr = __builtin_amdgcn_permlane32_swap(__float_as_uint(pmax), __float_as_uint(pmax), false, false);
      pmax = fmaxf(__uint_as_float(rr[0]), __uint_as_float(rr[1])); }
    if (__builtin_expect(__all(pmax - m_reg <= THR / SCALE), 1)) { mn = m_reg; alpha = 1.f; }
    else { mn = fmaxf(m_reg, pmax); alpha = __builtin_amdgcn_exp2f((m_reg - mn) * C); m_reg = mn; }
    const float mnC = (lb - mn) * C;
#pragma unroll
    for (int r = 0; r < 16; ++r) p0[r] = fmaf(p0[r], C, mnC);
#pragma unroll
    for (int r = 0; r < 16; ++r) p1[r] = fmaf(p1[r], C, mnC);
#pragma unroll
    for (int r = 0; r < 16; ++r) p0[r] = __builtin_amdgcn_exp2f(p0[r]);
}
__device__ __forceinline__ void finishSM(f32x16& p0, f32x16& p1, float alpha, float& l_reg, bf16x8& pa0, bf16x8& pa1, bf16x8& pa2, bf16x8& pa3) {
#pragma unroll
    for (int r = 0; r < 16; ++r) p1[r] = __builtin_amdgcn_exp2f(p1[r]);
    float ps = 0;
#pragma unroll
    for (int r = 0; r < 16; ++r) ps += p0[r];
#pragma unroll
    for (int r = 0; r < 16; ++r) ps += p1[r];
    { auto rr = __builtin_amdgcn_permlane32_swap(__float_as_uint(ps), __float_as_uint(ps), false, false);
      ps = __uint_as_float(rr[0]) + __uint_as_float(rr[1]); }
    l_reg = l_reg * alpha + ps;
#define PK4(P, BASE, OUT) do { unsigned a0 = cvt_pk_bf16(P[BASE + 0], P[BASE + 1]), a1 = cvt_pk_bf16(P[BASE + 2], P[BASE + 3]);   \
    unsigned b0 = cvt_pk_bf16(P[BASE + 4], P[BASE + 5]), b1 = cvt_pk_bf16(P[BASE + 6], P[BASE + 7]);                              \
    auto r0 = __builtin_amdgcn_permlane32_swap(a0, b0, false, false); auto r1 = __builtin_amdgcn_permlane32_swap(a1, b1, false, false); \
    u32x4 w = {r0[0], r1[0], r0[1], r1[1]}; OUT = *reinterpret_cast<bf16x8*>(&w); } while (0)
    PK4(p0, 0, pa0); PK4(p0, 8, pa1); PK4(p1, 0, pa2); PK4(p1, 8, pa3);
#undef PK4
}
__device__ __forceinline__ void qkt(f32x16& p0, f32x16& p1, const char* Ks, const bf16x8* qr, int r32, int hi) {
    p0 = f32x16{}; p1 = f32x16{};
    int lowb = (hi * 16) ^ ((r32 & 7) << 4);
    asm volatile("" : "+v"(lowb));
    const char* Kr = Ks + r32 * 256;
#pragma unroll
    for (int d0 = 0; d0 < 8; ++d0) { const int cb = (d0 * 32) ^ lowb;
        const bf16x8 b0 = *reinterpret_cast<const bf16x8*>(Kr + cb);
        const bf16x8 b1 = *reinterpret_cast<const bf16x8*>(Kr + 32 * 256 + cb);
        p0 = __builtin_amdgcn_mfma_f32_32x32x16_bf16(b0, qr[d0], p0, 0, 0, 0);
        p1 = __builtin_amdgcn_mfma_f32_32x32x16_bf16(b1, qr[d0], p1, 0, 0, 0); }
}
__device__ __forceinline__ int v_st(int k, int c) { const int kk = (k & ~0xC) | ((k & 4) << 1) | ((k & 8) >> 1); return ((kk >> 3) * 4 + (c >> 5)) * 512 + ((kk & 7) * 32 + (c & 31)) * 2; }
__device__ __forceinline__ int v_rd_base(int lane) { return ((lane & 3) << 3) | (((lane >> 2) & 3) << 6) | (((lane >> 4) & 1) << 5) | (((lane >> 5) & 1) << 8); }
constexpr int v_rd_off(int d0, int ks, int half) { return d0 * 512 + ks * 4096 + half * 2048; }
template <int OFF> __device__ __forceinline__ s16x4 tr_read(int vb) {
    s16x4 r; asm volatile("ds_read_b64_tr_b16 %0, %1 offset:%2" : "=&v"(r) : "v"(vb), "i"(OFF) : "memory"); return r;
}
template <int D0> __device__ __forceinline__ void pv_one(f32x16& od, int vb, bf16x8 pa0, bf16x8 pa1, bf16x8 pa2, bf16x8 pa3) {
    const s16x4 l0 = tr_read<v_rd_off(D0, 0, 0)>(vb), h0 = tr_read<v_rd_off(D0, 0, 1)>(vb), l1 = tr_read<v_rd_off(D0, 1, 0)>(vb), h1 = tr_read<v_rd_off(D0, 1, 1)>(vb);
    const s16x4 l2 = tr_read<v_rd_off(D0, 2, 0)>(vb), h2 = tr_read<v_rd_off(D0, 2, 1)>(vb), l3 = tr_read<v_rd_off(D0, 3, 0)>(vb), h3 = tr_read<v_rd_off(D0, 3, 1)>(vb);
    asm volatile("s_waitcnt lgkmcnt(0)" ::: "memory"); SBAR();
#define PK(L, H) (bf16x8){L[0], L[1], L[2], L[3], H[0], H[1], H[2], H[3]}
    od = __builtin_amdgcn_mfma_f32_32x32x16_bf16(pa0, PK(l0, h0), od, 0, 0, 0);
    od = __builtin_amdgcn_mfma_f32_32x32x16_bf16(pa1, PK(l1, h1), od, 0, 0, 0);
    od = __builtin_amdgcn_mfma_f32_32x32x16_bf16(pa2, PK(l2, h2), od, 0, 0, 0);
    od = __builtin_amdgcn_mfma_f32_32x32x16_bf16(pa3, PK(l3, h3), od, 0, 0, 0);
#undef PK
}
__device__ __forceinline__ void pv_d0(f32x16* o, int vb, bf16x8 pa0, bf16x8 pa1, bf16x8 pa2, bf16x8 pa3) {
    pv_one<0>(o[0], vb, pa0, pa1, pa2, pa3); pv_one<1>(o[1], vb, pa0, pa1, pa2, pa3); pv_one<2>(o[2], vb, pa0, pa1, pa2, pa3); pv_one<3>(o[3], vb, pa0, pa1, pa2, pa3);
}

constexpr int MAXP = 8;
struct ItemTable { unsigned short v[64][MAXP]; };
constexpr int head_cap(int h) { return h == 0 ? 1 : h == 1 ? 2 : h == 2 ? 3 : h == 3 ? 5 : h == 4 ? 10 : 16; }
constexpr ItemTable make_items() {
    ItemTable t{};
    for (int i = 0; i < 64; ++i) for (int j = 0; j < MAXP; ++j) t.v[i][j] = 0xFFFF;
    const int kh[8] = {3, 4, 5, 7, 10, 12, 12, 11};
    int bin0 = 0;
    for (int h = 0; h < 8; ++h) { const int k = kh[h];
        unsigned short code[32] = {}; int cost[32] = {}; int n = 0;
        for (int qb = 0; qb < 16; ++qb) { const int npast = qb < head_cap(h) ? qb : head_cap(h); const bool split = (h >= 5 && qb >= 12);
            if (split) { code[n] = (unsigned short)(h | (qb << 3) | (0 << 7) | (1 << 8)); cost[n] = 8; ++n; code[n] = (unsigned short)(h | (qb << 3) | (1 << 7) | (1 << 8)); cost[n] = npast - 7; ++n; }
            else { code[n] = (unsigned short)(h | (qb << 3)); cost[n] = 1 + npast; ++n; } }
        for (int i = 1; i < n; ++i) { const unsigned short xv = code[i]; const int c = cost[i]; int j = i - 1;
            while (j >= 0 && cost[j] < c) { code[j + 1] = code[j]; cost[j + 1] = cost[j]; --j; }
            code[j + 1] = xv; cost[j + 1] = c; }
        int load[16] = {}; int cnt[16] = {};
        for (int i = 0; i < n; ++i) { int best = 0; for (int j = 1; j < k; ++j) if (load[j] < load[best]) best = j;
            if (cnt[best] < MAXP) { t.v[bin0 + best][cnt[best]] = code[i]; ++cnt[best]; load[best] += cost[i] + 1; } }
        bin0 += k; }
    return t;
}
__device__ const ItemTable ATT_ITEMS = make_items();
constexpr float CUT_MARGIN = 40.f;

__device__ __forceinline__ void attn_item(const int tid, const int b, const int h, const int qb, const bool with_own, const int n_lo, const int n_hi, const int mode,
                                          const int slot, const int l, unsigned char* __restrict__ wsb, char* lds) {
    const bf16_t* __restrict__ U = (const bf16_t*)(wsb + WS_U); const float* __restrict__ ksum = (const float*)(wsb + WS_KS); bf16_t* __restrict__ Y = (bf16_t*)(wsb + WS_Y);
    float* __restrict__ part = (float*)(wsb + WS_PART) + (size_t)slot * 66 * 512; int* __restrict__ tick = (int*)(wsb + WS_CTL) + 12544 + 128 * l + 2 * slot;
    const int wid = tid >> 6, lane = tid & 63, r32 = lane & 31, hi = lane >> 5;
    char* V_lds = lds + OFF_V; char* K_lds = lds + OFF_K; char* KM = lds + OFF_KM;
    float* ws = (float*)(lds + OFF_WS) + wid * 64; float* li_l = ws; float* al_l = ws + 32;
    const bf16_t* Qb = U + (size_t)(b * SEQ + qb * 256) * UP + COL_Q + h * HD;
    float m_reg = -1e29f, l_reg = 0; f32x16 o[4] = {}; bf16x8 qr[8];
    { const bf16_t* Qw = Qb + (size_t)(wid * QBLK + r32) * UP + hi * 8;
#pragma unroll
      for (int d0 = 0; d0 < 8; ++d0) qr[d0] = *reinterpret_cast<const bf16x8*>(Qw + d0 * 16); }
    { const int n = tid >> 5, c4 = (tid & 31) * 4;
      const float* k0p = ksum + (size_t)((b * 16 + n) * 2) * 1024 + h * HD + c4;
      const f32x4 s0 = *(const f32x4*)k0p, s1 = *(const f32x4*)(k0p + 1024);
      u32x2 w; w.x = cvt_pk_bf16((s0[0] + s1[0]) * (1.f / 256.f), (s0[1] + s1[1]) * (1.f / 256.f)); w.y = cvt_pk_bf16((s0[2] + s1[2]) * (1.f / 256.f), (s0[3] + s1[3]) * (1.f / 256.f));
      *(u32x2*)(KM + KSWZ(n, c4 * 2)) = w;
      *(u32x2*)(KM + KSWZ(16 + n, c4 * 2)) = (u32x2){0u, 0u}; }
    __syncthreads();
    unsigned selmask = 0u;
    { f32x16 g = f32x16{};
#pragma unroll
      for (int d0 = 0; d0 < 8; ++d0) { const int cb = (d0 * 16 + hi * 8) * 2; const bf16x8 a = *reinterpret_cast<const bf16x8*>(KM + KSWZ(r32, cb)); g = __builtin_amdgcn_mfma_f32_32x32x16_bf16(a, qr[d0], g, 0, 0, 0); }
      float G[16];
#pragma unroll
      for (int r = 0; r < 8; ++r) { auto rr = __builtin_amdgcn_permlane32_swap(__float_as_uint(g[r]), __float_as_uint(g[r]), false, false);
          const float other = hi ? __uint_as_float(rr[0]) : __uint_as_float(rr[1]);
          const int nlo = (r & 3) + 8 * (r >> 2);
          G[nlo] = hi ? other : g[r]; G[nlo + 4] = hi ? g[r] : other; }
#pragma unroll
      for (int n = 0; n < 16; ++n) if (n >= qb) G[n] = -INFINITY;
      const int npick = qb < 3 ? qb : 3;
#pragma unroll
      for (int it = 0; it < 3; ++it) { if (it < npick) { float best = G[0]; int bi = 0;
#pragma unroll
          for (int n = 1; n < 16; ++n) if (G[n] > best) { best = G[n]; bi = n; }
          selmask |= 1u << bi;
#pragma unroll
          for (int n = 0; n < 16; ++n) if (n == bi) G[n] = -INFINITY; } } }
    const float slr = __uint_as_float(__builtin_amdgcn_readfirstlane(__float_as_uint(__builtin_amdgcn_exp2f(-(float)(h + 1)) * (1.f / SCALE))));
    const int tp4 = qb * 256 + wid * QBLK + r32 - 4 * hi;
    const int jo = with_own ? 4 : 0;
    const int NT = jo + 4 * (n_hi - n_lo);
    const int kb_own = qb * 256, kb_past = n_lo * 256 - 64 * jo;
#define KST(j) (((j) < jo ? kb_own : kb_past) + 64 * (j))
#define LBV(j) ((((j) < jo) ? ((j) > (wid >> 1)) : !((selmask >> (n_lo + (((j) - jo) >> 2))) & 1u)) ? -1e30f : slr * (float)(KST(j) - tp4))
    const int vb0 = (int)(uintptr_t)V_lds + v_rd_base(lane);
    unsigned koff, voff;
    { const int row = 4 * wid + (lane >> 4), cc = lane & 15; koff = (unsigned)(row * UP * 2 + ((cc ^ (row & 7)) << 4)) + (unsigned)(COL_K * 2); }
    { const int st = 2 * wid + (lane >> 5), kk = (st >> 2) * 8 + ((lane & 31) >> 2), k = (kk & ~0xC) | ((kk & 4) << 1) | ((kk & 8) >> 1), col = 32 * (st & 3) + 8 * (lane & 3);
      voff = (unsigned)(k * UP * 2 + col * 2) + (unsigned)(COL_V * 2); }
    const int wq = __builtin_amdgcn_readfirstlane(wid);
    LAS unsigned char* ldsL = (LAS unsigned char*)(unsigned)(uintptr_t)lds;
    const char* Ubh = (const char*)(U + (size_t)(b * SEQ) * UP + h * HD);
#define DMAK(bb, k0) do { const unsigned uo_ = (unsigned)((k0) * (UP * 2)); \
    __builtin_amdgcn_global_load_lds((const unsigned*)(Ubh + (koff + uo_)), (LAS unsigned*)(ldsL + OFF_K + (bb) * SHM_K + wq * 1024), 16, 0, 0); \
    __builtin_amdgcn_global_load_lds((const unsigned*)(Ubh + (koff + uo_ + 32u * UP * 2u)), (LAS unsigned*)(ldsL + OFF_K + (bb) * SHM_K + (wq + 8) * 1024), 16, 0, 0); } while (0)
#define DMAV(bb, k0) do { const unsigned uo_ = (unsigned)((k0) * (UP * 2)); \
    __builtin_amdgcn_global_load_lds((const unsigned*)(Ubh + (voff + uo_)), (LAS unsigned*)(ldsL + OFF_V + (bb) * SHM_V + wq * 1024), 16, 0, 0); \
    __builtin_amdgcn_global_load_lds((const unsigned*)(Ubh + (voff + uo_ + 32u * UP * 2u)), (LAS unsigned*)(ldsL + OFF_V + (bb) * SHM_V + (wq + 8) * 1024), 16, 0, 0); } while (0)
#define RESC(a) do { if (__any((a) < 1.f)) { if (hi == 0) al_l[r32] = (a); asm volatile("s_waitcnt lgkmcnt(0)" ::: "memory"); \
    _Pragma("unroll") for (int d = 0; d < 4; ++d) _Pragma("unroll") for (int r = 0; r < 16; ++r) o[d][r] *= al_l[crow(r, hi)]; } } while (0)
    if (NT > 0) {
    f32x16 pA0, pA1, pB0, pB1; float mnA, mnB, alA, alB; bf16x8 pa0, pa1, pa2, pa3;
#define PSM(P0, P1, MN, AL, j) partialSM(P0, P1, m_reg, MN, AL, slr, LBV(j), ((j) < jo && (j) == (wid >> 1)) ? 1 + (wid & 1) : 0, r32 - 4 * hi)
#define WBAR(N) asm volatile("s_waitcnt vmcnt(" #N ") lgkmcnt(0)\n\ts_barrier" ::: "memory")
#define STEP(PC0, PC1, MNC, ALC, PP0, PP1, ALP, j, sl) do { \
        DMAV(sl, KST(j)); \
        SBAR(); qkt(PC0, PC1, K_lds + (sl) * SHM_K, qr, r32, hi); \
        finishSM(PP0, PP1, ALP, l_reg, pa0, pa1, pa2, pa3); SBAR(); \
        WBAR(4); \
        if ((j) + 2 < NT) DMAK(sl, KST((j) + 2)); \
        pv_d0(o, vb0 + (1 - (sl)) * (int)SHM_V, pa0, pa1, pa2, pa3); PSM(PC0, PC1, MNC, ALC, j); \
        if ((j) + 2 < NT) WBAR(4); else WBAR(0); RESC(ALC); } while (0)
    DMAK(0, KST(0)); DMAK(1, KST(1)); DMAV(0, KST(0)); WBAR(4);
    qkt(pA0, pA1, K_lds, qr, r32, hi);
    WBAR(4);
    DMAK(0, KST(2)); PSM(pA0, pA1, mnA, alA, 0);
    WBAR(4); RESC(alA);
    for (int j = 1; j + 1 < NT; j += 2) {
        STEP(pB0, pB1, mnB, alB, pA0, pA1, alA, j, 1);
        STEP(pA0, pA1, mnA, alA, pB0, pB1, alB, j + 1, 0);
    }
    STEP(pB0, pB1, mnB, alB, pA0, pA1, alA, NT - 1, 1);
    finishSM(pB0, pB1, alB, l_reg, pa0, pa1, pa2, pa3); SBAR();
    pv_d0(o, vb0 + (int)SHM_V, pa0, pa1, pa2, pa3);
#undef STEP
#undef WBAR
#undef PSM
    }
    bool write_out = true;
    if (mode == 1) {
        __syncthreads();
        int* tk = (int*)(lds + OFF_WS + NWAVES * 64 * 4 - 16);
        if (tid == 0) tk[0] = __hip_atomic_fetch_add(tick, 1, __ATOMIC_RELAXED, __HIP_MEMORY_SCOPE_AGENT);
        __syncthreads();
        const int t = __builtin_amdgcn_readfirstlane(tk[0]);
        __syncthreads();
        if (t == 0) {
#pragma unroll
            for (int d = 0; d < 4; ++d)
#pragma unroll
                for (int r = 0; r < 16; ++r) __hip_atomic_store(part + (size_t)(d * 16 + r) * 512 + tid, o[d][r], __ATOMIC_RELAXED, __HIP_MEMORY_SCOPE_AGENT);
            __hip_atomic_store(part + (size_t)64 * 512 + tid, m_reg, __ATOMIC_RELAXED, __HIP_MEMORY_SCOPE_AGENT);
            __hip_atomic_store(part + (size_t)65 * 512 + tid, l_reg, __ATOMIC_RELAXED, __HIP_MEMORY_SCOPE_AGENT);
            asm volatile("s_waitcnt vmcnt(0)" ::: "memory");
            __syncthreads();
            if (tid == 0) __hip_atomic_store(tick + 1, 1, __ATOMIC_RELAXED, __HIP_MEMORY_SCOPE_AGENT);
            write_out = false;
        } else {
            if (tid < 64) { unsigned sp = 0;
                while (__builtin_amdgcn_readfirstlane(__hip_atomic_load(tick + 1, __ATOMIC_RELAXED, __HIP_MEMORY_SCOPE_AGENT)) == 0) { __builtin_amdgcn_s_sleep(2); if (++sp > (1u << 22)) break; }
                __builtin_amdgcn_fence(__ATOMIC_ACQUIRE, "agent");
                asm volatile("s_waitcnt vmcnt(0)" ::: "memory"); }
            __syncthreads();
            constexpr float C = SCALE * 1.4426950408889634f;
            const float m2 = part[(size_t)64 * 512 + tid], l2 = part[(size_t)65 * 512 + tid];
            const float mn = fmaxf(m_reg, m2), a1 = __builtin_amdgcn_exp2f((m_reg - mn) * C), a2 = __builtin_amdgcn_exp2f((m2 - mn) * C);
            { float t1 = l_reg * a1, t2 = l2 * a2; asm volatile("" : "+v"(t1), "+v"(t2)); l_reg = t1 + t2; }
            if (hi == 0) { al_l[r32] = a1; li_l[r32] = a2; }
            asm volatile("s_waitcnt lgkmcnt(0)" ::: "memory");
#pragma unroll
            for (int d = 0; d < 4; ++d)
#pragma unroll
                for (int r = 0; r < 16; ++r) { float t1 = o[d][r] * al_l[crow(r, hi)], t2 = part[(size_t)(d * 16 + r) * 512 + tid] * li_l[crow(r, hi)]; asm volatile("" : "+v"(t1), "+v"(t2)); o[d][r] = t1 + t2; }
            asm volatile("s_waitcnt lgkmcnt(0)" ::: "memory");
        }
    }
    if (write_out) {
    if (hi == 0) li_l[r32] = l_reg; asm volatile("s_waitcnt lgkmcnt(0)" ::: "memory");
    float rli[16];
#pragma unroll
    for (int r = 0; r < 16; ++r) rli[r] = __builtin_amdgcn_rcpf(li_l[crow(r, hi)]);
    bf16_t* Ow = Y + (size_t)(b * SEQ + qb * 256 + wid * QBLK) * DM + 512 + h * HD;
#pragma unroll
    for (int r = 0; r < 16; ++r) { const int orow = crow(r, hi);
#pragma unroll
        for (int d0 = 0; d0 < 4; ++d0) { const float v = o[d0][r] * rli[r]; Ow[(size_t)orow * DM + d0 * 32 + r32] = (bf16_t)(cvt_pk_bf16(v, v) & 0xffffu); } }
    }
    __syncthreads();
#undef KST
#undef LBV
#undef DMAK
#undef DMAV
#undef RESC
}
#undef KSWZ
#undef SBAR
}


#define XB_TMO      128
#define XB_XCNT(j)  (256  + 64 * (j))
#define XB_XSUB(j)  (1280 + 64 * (j))
#define XB_XGEN(j)  (2304 + 64 * (j))
#define XB_TOP      3328
#define XB_TOPGEN   3392
#define XCD_BAR_WORDS 3456
#define XB_SPIN_CAP (1u << 18)
__device__ __forceinline__ unsigned xb_ld(unsigned* p)              { return __hip_atomic_load(p, __ATOMIC_RELAXED, __HIP_MEMORY_SCOPE_AGENT); }
__device__ __forceinline__ unsigned xb_add(unsigned* p, unsigned v) { return __hip_atomic_fetch_add(p, v, __ATOMIC_RELAXED, __HIP_MEMORY_SCOPE_AGENT); }
__device__ __forceinline__ unsigned xb_xcc_id() { return (unsigned)__builtin_amdgcn_s_getreg((3 << 11) | 20) & 0xFu; }
#define XB_SPIN(cond, bar) do { unsigned _sp = 0; while (cond) { __builtin_amdgcn_s_sleep(1); \
    if ((++_sp & 255u) == 0u) { if (xb_ld(&(bar)[XB_TMO])) break; if (_sp > XB_SPIN_CAP) { atomicAdd(&(bar)[XB_TMO], 1u); break; } } } } while (0)
struct XcdBarrier { unsigned* bar; unsigned x; volatile LAS unsigned* st; };
__device__ __forceinline__ XcdBarrier xcd_barrier_post(unsigned* bar, volatile LAS unsigned* st) {
    XcdBarrier b; b.bar = bar; b.x = xb_xcc_id(); b.st = st;
    if (threadIdx.x == 0) (void)xb_add(&bar[XB_XCNT(b.x)], 1u);
    return b;
}
__device__ __forceinline__ void xcd_barrier_complete(unsigned* bar, unsigned x, unsigned& nloc, unsigned& nx) {
    const unsigned G = gridDim.x * gridDim.y * gridDim.z;
    unsigned sum, cnt, mine, sp = 0u;
    for (;;) {
        sum = 0u; cnt = 0u; mine = 0u;
#pragma unroll
        for (unsigned j = 0; j < 16; ++j) { const unsigned c = xb_ld(&bar[XB_XCNT(j)]); sum += c; cnt += (c > 0u) ? 1u : 0u; mine = (j == x) ? c : mine; }
        if (sum == G) break;
        __builtin_amdgcn_s_sleep(1);
        if ((++sp & 255u) == 0u) { if (xb_ld(&bar[XB_TMO])) break; if (sp > XB_SPIN_CAP) { atomicAdd(&bar[XB_TMO], 1u); break; } }
    }
    nloc = mine > 0u ? mine : 1u; nx = cnt > 0u ? cnt : 1u;
}
__device__ __forceinline__ void xcd_barrier(const XcdBarrier& b) {
    asm volatile("s_waitcnt vmcnt(0)" ::: "memory");
    __syncthreads();
    if (threadIdx.x == 0) {
        unsigned* bar = b.bar;
        __builtin_amdgcn_s_waitcnt(0);
        unsigned nloc = b.st[0], nx = b.st[1];
        if (nloc == 0u) { xcd_barrier_complete(bar, b.x, nloc, nx); b.st[0] = nloc; b.st[1] = nx; }
        const unsigned old = xb_add(&bar[XB_XSUB(b.x)], 1u);
        const unsigned gen = old / nloc;
        if (old + 1u == (gen + 1u) * nloc) {
            __builtin_amdgcn_fence(__ATOMIC_RELEASE, "agent");
            asm volatile("s_waitcnt vmcnt(0)" ::: "memory");
            const unsigned og = xb_add(&bar[XB_TOP], 1u);
            const unsigned tg = og / nx;
            if (og + 1u == (tg + 1u) * nx) xb_add(&bar[XB_TOPGEN], 1u);
            else XB_SPIN(xb_ld(&bar[XB_TOPGEN]) == tg, bar);
            __builtin_amdgcn_fence(__ATOMIC_ACQUIRE, "agent");
            xb_add(&bar[XB_XGEN(b.x)], 1u);
            asm volatile("s_waitcnt vmcnt(0)" ::: "memory");
        } else {
            XB_SPIN(xb_ld(&bar[XB_XGEN(b.x)]) == gen, bar);
            __builtin_amdgcn_fence(__ATOMIC_ACQUIRE, "agent");
            asm volatile("s_waitcnt vmcnt(0)" ::: "memory");
        }
    }
    __syncthreads();
}

struct Params { const float* in[18]; float* out; unsigned char* ws; int ph_lo, ph_hi; };
enum { IN_X = 0, IN_N1G, IN_WIN, IN_CAW, IN_CCW, IN_CCB, IN_LNG, IN_LNB, IN_WOUT, IN_N2G, IN_RGW, IN_RGB, IN_REW, IN_REB, IN_WG, IN_WU, IN_WD, IN_FG };

__device__ __forceinline__ void transpose_item(const float* __restrict__ W, int K, int N, bf16_t* __restrict__ WT, size_t dstb, int rmul, int radd, const float* __restrict__ scale,
                                               LAS float* scr, int item, int lane) {
    const int nkb = K / 64, nnb = N / 64, per = nkb * nnb, bt = item / per, rem = item - bt * per, kb = rem / nnb, nb = rem - kb * nnb, k0 = kb * 64, n0 = nb * 64;
    const float* src = W + (size_t)bt * K * N;
    bf16_t* dst = WT + (size_t)bt * dstb;
#pragma unroll 4
    for (int i = 0; i < 16; ++i) { const int k = 4 * i + (lane >> 4), n4 = (lane & 15) * 4; const f32x4 v = __builtin_nontemporal_load((const f32x4*)(src + (size_t)(k0 + k) * N + n0 + n4));
        LAS float* s = scr + k * 65 + n4; s[0] = v[0]; s[1] = v[1]; s[2] = v[2]; s[3] = v[3]; }
    asm volatile("s_waitcnt lgkmcnt(0)" ::: "memory");
    const int c = lane & 7, nn = lane >> 3;
    float sc8[8];
#pragma unroll
    for (int i = 0; i < 8; ++i) sc8[i] = scale ? scale[k0 + 8 * c + i] : 1.f;
#pragma unroll
    for (int j = 0; j < 8; ++j) { const int n = nn + 8 * j; const LAS float* s = scr + (8 * c) * 65 + n;
        u32x4 o; o.x = cvt_pk_bf16(s[0] * sc8[0], s[65] * sc8[1]); o.y = cvt_pk_bf16(s[130] * sc8[2], s[195] * sc8[3]); o.z = cvt_pk_bf16(s[260] * sc8[4], s[325] * sc8[5]); o.w = cvt_pk_bf16(s[390] * sc8[6], s[455] * sc8[7]);
        __builtin_nontemporal_store(o, (u32x4*)(dst + (size_t)((n0 + n) * rmul + radd) * K + k0 + 8 * c)); }
    asm volatile("s_waitcnt lgkmcnt(0)" ::: "memory");
}

__device__ __forceinline__ void transpose_item8(const float* __restrict__ W, int K, int N, unsigned char* __restrict__ WT, size_t dstb, int rmul, int radd, const float* __restrict__ scale, float mult,
                                                LAS float* scr, int item, int lane) {
    const int nkb = K / 64, nnb = N / 64, per = nkb * nnb, bt = item / per, rem = item - bt * per, kb = rem / nnb, nb = rem - kb * nnb, k0 = kb * 64, n0 = nb * 64;
    const float* src = W + (size_t)bt * K * N;
    unsigned char* dst = WT + (size_t)bt * dstb;
#pragma unroll 4
    for (int i = 0; i < 16; ++i) { const int k = 4 * i + (lane >> 4), n4 = (lane & 15) * 4; const f32x4 v = __builtin_nontemporal_load((const f32x4*)(src + (size_t)(k0 + k) * N + n0 + n4));
        LAS float* s = scr + k * 65 + n4; s[0] = v[0]; s[1] = v[1]; s[2] = v[2]; s[3] = v[3]; }
    asm volatile("s_waitcnt lgkmcnt(0)" ::: "memory");
    const int c = lane & 7, nn = lane >> 3;
    float sc8[8];
#pragma unroll
    for (int i = 0; i < 8; ++i) sc8[i] = (scale ? scale[k0 + 8 * c + i] : 1.f) * mult;
#pragma unroll
    for (int j = 0; j < 8; ++j) { const int n = nn + 8 * j; const LAS float* s = scr + (8 * c) * 65 + n;
        float v[8];
#pragma unroll
        for (int i = 0; i < 8; ++i) v[i] = __builtin_amdgcn_fmed3f(s[65 * i] * sc8[i], -400.f, 400.f);
        int w0 = 0, w1 = 0;
        w0 = __builtin_amdgcn_cvt_pk_fp8_f32(v[0], v[1], w0, false); w0 = __builtin_amdgcn_cvt_pk_fp8_f32(v[2], v[3], w0, true);
        w1 = __builtin_amdgcn_cvt_pk_fp8_f32(v[4], v[5], w1, false); w1 = __builtin_amdgcn_cvt_pk_fp8_f32(v[6], v[7], w1, true);
        __builtin_nontemporal_store((u32x2){(unsigned)w0, (unsigned)w1}, (u32x2*)(dst + (size_t)((n0 + n) * rmul + radd) * K + k0 + 8 * c)); }
    asm volatile("s_waitcnt lgkmcnt(0)" ::: "memory");
}

__device__ __forceinline__ void norm_row_f32(const float* __restrict__ xrow, bf16_t* __restrict__ xout, float* __restrict__ rsout, int lane) {
    f32x4 v[8]; float ss = 0.f;
#pragma unroll
    for (int j = 0; j < 8; ++j) { v[j] = __builtin_nontemporal_load((const f32x4*)xrow + 64 * j + lane); ss += (v[j][0] * v[j][0] + v[j][1] * v[j][1]) + (v[j][2] * v[j][2] + v[j][3] * v[j][3]); }
    const float rs = 1.0f / sqrtf(wave_sum(ss) * (1.f / DM) + EPS);
    if (lane == 0) *rsout = rs;
#pragma unroll
    for (int j = 0; j < 8; ++j) { u32x2 w; w.x = cvt_pk_bf16(v[j][0], v[j][1]); w.y = cvt_pk_bf16(v[j][2], v[j][3]); *((u32x2*)xout + 64 * j + lane) = w; }
}
struct RowRegs { u32x4 x[4]; u32x2 a[4], c[4]; };
__device__ __forceinline__ void combine_load(RowRegs& R, const bf16_t* __restrict__ xrow, const unsigned char* __restrict__ y0, const unsigned char* __restrict__ y1, int lane) {
#pragma unroll
    for (int j = 0; j < 4; ++j) { R.x[j] = *((const u32x4*)xrow + 64 * j + lane); R.a[j] = __builtin_nontemporal_load((const u32x2*)y0 + 64 * j + lane); R.c[j] = __builtin_nontemporal_load((const u32x2*)y1 + 64 * j + lane); }
}
__device__ __forceinline__ void combine_finish(const RowRegs& R, bf16_t* __restrict__ xrow, float g0, float g1, float* __restrict__ rsout, float* __restrict__ fout, const float* __restrict__ fgain, int lane) {
    float v[4][8]; float ss = 0.f;
    g0 *= (1.f / pg8::YM_SCALE); g1 *= (1.f / pg8::YM_SCALE);
#pragma unroll
    for (int j = 0; j < 4; ++j) { const u32x4 x = R.x[j];
        const f32x2 a0 = __builtin_amdgcn_cvt_pk_f32_fp8((int)R.a[j].x, false), a1 = __builtin_amdgcn_cvt_pk_f32_fp8((int)R.a[j].x, true), a2 = __builtin_amdgcn_cvt_pk_f32_fp8((int)R.a[j].y, false), a3 = __builtin_amdgcn_cvt_pk_f32_fp8((int)R.a[j].y, true);
        const f32x2 c0 = __builtin_amdgcn_cvt_pk_f32_fp8((int)R.c[j].x, false), c1 = __builtin_amdgcn_cvt_pk_f32_fp8((int)R.c[j].x, true), c2 = __builtin_amdgcn_cvt_pk_f32_fp8((int)R.c[j].y, false), c3 = __builtin_amdgcn_cvt_pk_f32_fp8((int)R.c[j].y, true);
        v[j][0] = bf_lo(x.x) + g0 * a0[0] + g1 * c0[0]; v[j][1] = bf_hi(x.x) + g0 * a0[1] + g1 * c0[1];
        v[j][2] = bf_lo(x.y) + g0 * a1[0] + g1 * c1[0]; v[j][3] = bf_hi(x.y) + g0 * a1[1] + g1 * c1[1];
        v[j][4] = bf_lo(x.z) + g0 * a2[0] + g1 * c2[0]; v[j][5] = bf_hi(x.z) + g0 * a2[1] + g1 * c2[1];
        v[j][6] = bf_lo(x.w) + g0 * a3[0] + g1 * c3[0]; v[j][7] = bf_hi(x.w) + g0 * a3[1] + g1 * c3[1];
#pragma unroll
        for (int i = 0; i < 8; ++i) ss += v[j][i] * v[j][i]; }
    const float rs = 1.0f / sqrtf(wave_sum(ss) * (1.f / DM) + EPS);
#pragma unroll
    for (int j = 0; j < 4; ++j) {
        if (fout) { const f32x4 ga = *((const f32x4*)fgain + 128 * j + 2 * lane), gb = *((const f32x4*)fgain + 128 * j + 2 * lane + 1);
            __builtin_nontemporal_store((f32x4){v[j][0] * rs * ga[0], v[j][1] * rs * ga[1], v[j][2] * rs * ga[2], v[j][3] * rs * ga[3]}, (f32x4*)fout + 128 * j + 2 * lane);
            __builtin_nontemporal_store((f32x4){v[j][4] * rs * gb[0], v[j][5] * rs * gb[1], v[j][6] * rs * gb[2], v[j][7] * rs * gb[3]}, (f32x4*)fout + 128 * j + 2 * lane + 1); }
        else { u32x4 w; w.x = cvt_pk_bf16(v[j][0], v[j][1]); w.y = cvt_pk_bf16(v[j][2], v[j][3]); w.z = cvt_pk_bf16(v[j][4], v[j][5]); w.w = cvt_pk_bf16(v[j][6], v[j][7]);
            *((u32x4*)xrow + 64 * j + lane) = w; } }
    if (!fout && lane == 0) *rsout = rs;
}

__global__ void __launch_bounds__(NTHREADS, 2) fwd_kernel(Params p) {
    extern __shared__ __attribute__((aligned(16))) unsigned char lds_raw[];
    LAS unsigned char* lds = (LAS unsigned char*)lds_raw;
    cg::grid_group grid = cg::this_grid();
    const int G = gridDim.x, bx = blockIdx.x;
    const int lo = p.ph_lo, hi = p.ph_hi;
    int ph = 0;
    const int wave_s = __builtin_amdgcn_readfirstlane((int)threadIdx.x >> 6);
    volatile LAS unsigned* bar_st = (volatile LAS unsigned*)(lds + MISC_OFF + 4096);
    if (threadIdx.x < 2) bar_st[threadIdx.x] = 0u;
    __syncthreads();
#ifdef PROBE_A
    if (bx == 0 && threadIdx.x == 0) ((volatile LAS unsigned long long*)(lds + MISC_OFF + 4352))[0] = __builtin_amdgcn_s_memrealtime();
#endif
    XcdBarrier xbar; xbar.bar = (unsigned*)(p.ws + WS_CTL) + 1024; xbar.x = 0; xbar.st = bar_st;
    if (hi - lo > 1) xbar = xcd_barrier_post((unsigned*)(p.ws + WS_CTL) + 1024, bar_st);
#ifndef PH_MASK
#define PH_MASK 0x7f
#endif
#ifndef DBL_MASK
#define DBL_MASK 0
#endif
#ifndef DBL_L0
#define DBL_L0 0
#endif
#define PHASE_BEGIN(k) if (((PH_MASK >> (k)) & 1) && lo <= ph && ph < hi) { for (int rep_ = 0; rep_ <= (int)(((DBL_MASK >> (k)) & 1) && (!DBL_L0 || l == 0)); ++rep_) { \
    int tid; asm volatile("v_mbcnt_lo_u32_b32 %0, -1, 0\n\tv_mbcnt_hi_u32_b32 %0, -1, %0" : "=v"(tid)); tid += wave_s * 64; unsigned char* ws = p.ws; asm volatile("" : "+s"(ws)); ws = (unsigned char*)(__attribute__((address_space(1))) unsigned char*)ws; \
    const int lane = tid & 63, wave = __builtin_amdgcn_readfirstlane(tid >> 6); \
    const int vcu = (G % 8 == 0) ? (bx % 8) * (G / 8) + bx / 8 : bx; const int gw = vcu * NWAVES + wave, NGW = G * NWAVES; \
    bf16_t* const Ub = (bf16_t*)(ws + WS_U); bf16_t* const YM = (bf16_t*)(ws + WS_U); bf16_t* const Yc = (bf16_t*)(ws + WS_Y); bf16_t* const Hb = (bf16_t*)(ws + WS_H); \
    bf16_t* const HMb = (bf16_t*)(ws + WS_HM); float* const KS = (float*)(ws + WS_KS); float* const RS = (float*)(ws + WS_RS); unsigned* const REC = (unsigned*)(ws + WS_REC); \
    int* const TM = (int*)(ws + WS_TM); int* const CNT = (int*)(ws + WS_CTL); bf16_t* const XB = (bf16_t*)(ws + WS_XB); \
    LAS int* const m_tile_e = (LAS int*)(lds + MISC_OFF); LAS int* const m_tstart = m_tile_e + MAXTILES; LAS int* const m_cnt = m_tstart + 40; \
    unsigned char* const wl = ws + WS_W0 + (size_t)l * SZ_LAYER; int* const cntg = CNT + 8192 + l * 32 * 64;     \
    (void)lane; (void)wave; (void)gw; (void)NGW; (void)Ub; (void)YM; (void)Yc; (void)Hb; (void)HMb; (void)KS; (void)RS; (void)REC; (void)TM; (void)XB; (void)m_tile_e; (void)m_tstart; (void)m_cnt; (void)wl; (void)cntg;
#ifdef PROBE_A
#define STAMP() do { if (bx == 0 && threadIdx.x == 0) { ((volatile LAS unsigned long long*)(lds + MISC_OFF + 4352))[ph + 1] = __builtin_amdgcn_s_memrealtime(); } } while (0)
#else
#define STAMP() do {} while (0)
#endif
#define PHASE_END   } if (ph + 1 < hi) { if (lo < 0) grid.sync();   else xcd_barrier(xbar); } STAMP(); } ++ph;

    { const int l = 0;
    PHASE_BEGIN(0)
    {
        LAS float* scr = (LAS float*)(lds + wave * 16640);
        for (int l = 0; l < DEPTH; ++l) {
            unsigned char* wl = ws + WS_W0 + (size_t)l * SZ_LAYER;
            constexpr int I_IN = (DM / 64) * (DIN / 64), I_OUT = (DM / 64) * (DM / 64), I_G = NEXP * (DM / 64) * (DEXP / 64), I_D = NEXP * (DEXP / 64) * (DM / 64), I_ALL = I_IN + I_OUT + 2 * I_G + I_D;
            for (int it = gw; it < I_ALL; it += NGW) {
                int r = it;
                if (r < I_IN) { const int n0 = (r % (DIN / 64)) * 64;
                    const int rmul = ((n0 >= 512 && n0 < 1536) || n0 >= 4608) ? 2 : 1;
                    const int radd = n0 < 512 ? 0 : n0 < 1024 ? -512 : n0 < 1536 ? -1535 : n0 < 4608 ? 0 : n0 < 5120 ? -4608 : -5631;
                    transpose_item(p.in[IN_WIN] + (size_t)l * DM * DIN, DM, DIN, (bf16_t*)(wl + OFF_WIN), 0, rmul, radd, p.in[IN_N1G] + l * DM, scr, r, lane); continue; } r -= I_IN;
                if (r < I_OUT) { transpose_item(p.in[IN_WOUT] + (size_t)l * DM * DM, DM, DM, (bf16_t*)(wl + OFF_WOUT), 0, 1, 0, nullptr, scr, r, lane); continue; } r -= I_OUT;
                if (r < I_G) { transpose_item8(p.in[IN_WG] + (size_t)l * NEXP * DM * DEXP, DM, DEXP, (unsigned char*)(wl + OFF_WGU), (size_t)1024 * DM, 2, 0, p.in[IN_N2G] + l * DM, W1_SCALE, scr, r, lane); continue; } r -= I_G;
                if (r < I_G) { transpose_item8(p.in[IN_WU] + (size_t)l * NEXP * DM * DEXP, DM, DEXP, (unsigned char*)(wl + OFF_WGU), (size_t)1024 * DM, 2, 1, p.in[IN_N2G] + l * DM, W1_SCALE, scr, r, lane); continue; } r -= I_G;
                transpose_item8(p.in[IN_WD] + (size_t)l * NEXP * DEXP * DM, DEXP, DM, (unsigned char*)(wl + OFF_WD), (size_t)DM * DEXP, 1, 0, nullptr, W2_SCALE, scr, r, lane);
            }
            bf16_t* RW = (bf16_t*)(wl + OFF_RW);
            for (int i = vcu * NTHREADS + tid; i < NRW * (DM / 8); i += G * NTHREADS) { const int n = i / (DM / 8), k8 = (i % (DM / 8)) * 8; float v[8];
#pragma unroll
                for (int j = 0; j < 8; ++j) { const int k = k8 + j; const float g = p.in[IN_N2G][l * DM + k];
                    v[j] = n < 4 ? g * p.in[IN_RGW][(size_t)l * DM * 4 + k * 4 + n] : (n < 36 ? g * p.in[IN_REW][(size_t)l * DM * 32 + k * 32 + (n - 4)] : 0.f); }
                u32x4 o; o.x = cvt_pk_bf16(v[0], v[1]); o.y = cvt_pk_bf16(v[2], v[3]); o.z = cvt_pk_bf16(v[4], v[5]); o.w = cvt_pk_bf16(v[6], v[7]);
                *(u32x4*)(RW + (size_t)n * DM + k8) = o; }
        }
        for (int m = gw; m < T_TOK; m += NGW) norm_row_f32(p.in[IN_X] + (size_t)m * DM, XB + (size_t)m * DM, RS + m, lane);
        __syncthreads();
    }
    PHASE_END
    }

    for (int l = 0; l < DEPTH; ++l) {
        PHASE_BEGIN(1)
        {
            pg8::DenseSched S{(const char*)XB, (const char*)(wl + OFF_WIN), T_TOK / 256, DIN / 256, G, bx, DM};
            pg8::EpiInProj E{Ub, KS, (float*)(ws + WS_NRM), RS};
            pg8::gemm_phase<2>(lds, tid, DM, S, E);
        }
        PHASE_END
        PHASE_BEGIN(2)
        {
            { const float* NRM = (const float*)(ws + WS_NRM);
              LAS int* bc = (LAS int*)(lds + MISC_OFF + 4224);
              for (int slot_ = vcu; slot_ < 256; slot_ += G) { const int b = slot_ >> 6, sl64 = slot_ & 63;
               for (int pi = 0; pi < att::MAXP; ++pi) {
                const unsigned code = (unsigned)__builtin_amdgcn_readfirstlane((int)att::ATT_ITEMS.v[sl64][pi]);
                if (code == 0xFFFFu) break;
                const int h = code & 7, qb = (code >> 3) & 15, part = (code >> 7) & 1, split = (code >> 8) & 1;
                if (tid < 64) { const int n = lane >> 2, wc = lane & 3;
                    const float* kp = NRM + (size_t)(((64 + b * 16 + n) * 8 + h) * 2) * 4 + wc; float kv = fmaxf(kp[0], kp[4]);
                    kv += __shfl_xor(kv, 1); kv += __shfl_xor(kv, 2); if (n > qb) kv = 0.f;
#pragma unroll
                    for (int o = 4; o < 64; o <<= 1) kv = fmaxf(kv, __shfl_xor(kv, o));
                    const float* qp = NRM + (size_t)(((b * 16 + qb) * 8 + h) * 2) * 4 + wc; float qv = fmaxf(qp[0], qp[4]);
                    qv += __shfl_xor(qv, 1); qv += __shfl_xor(qv, 2);
                    const float bound = att::SCALE * 1.02f * sqrtf(qv) * 2.f * sqrtf(kv) + att::CUT_MARGIN;
                    const float D = bound * exp2f((float)(h + 1));
                    int nb = (int)fminf(floorf((D - 1.f) * (1.f / 256.f)), 64.f);
                    int ns = qb - 1 - nb; ns = ns < 0 ? 0 : ns;
                    if (lane == 0) bc[1] = ns; }
                __syncthreads();
                const int n_start = __builtin_amdgcn_readfirstlane(bc[1]);
                const int n_mid = (qb - 7) > n_start ? (qb - 7) : n_start;
                const bool with_own = (part == 0);
                const int n_lo = split ? (part == 0 ? n_mid : n_start) : n_start, n_hi = split ? (part == 0 ? qb : n_mid) : qb;
                const int slot = split ? ((b * 3 + (h - 5)) * 4 + (qb - 12)) : 0;
#ifdef PROBE_TILES
                if (tid == 0 && l == 0) atomicAdd(&CNT[520], (with_own ? 4 : 0) + 4 * (n_hi - n_lo));
#endif
                att::attn_item(tid, b, h, qb, with_own, n_lo, n_hi, split, slot, l, ws, (char*)lds_raw);
               } } }
#ifndef NO_CONV
            int* const cq = CNT + 12416 + 16 * l; LAS int* qc = (LAS int*)(lds + MISC_OFF + 4240);
            __syncthreads();
            if (tid == 0) qc[0] = __hip_atomic_fetch_add(cq, 1, __ATOMIC_RELAXED, __HIP_MEMORY_SCOPE_AGENT);
            __syncthreads();
            { const float* cw = p.in[IN_CAW] + (size_t)l * 3 * 512;
              for (;;) { const int it = __builtin_amdgcn_readfirstlane(qc[0]); __syncthreads(); if (it >= T_TOK / 64) break;
                if (tid == 0) qc[0] = __hip_atomic_fetch_add(cq, 1, __ATOMIC_RELAXED, __HIP_MEMORY_SCOPE_AGENT);
                const int c8 = (tid & 63) * 8, tg0 = it * 64 + (tid >> 6) * 8, bstart = tg0 & ~(SEQ - 1);
                float w0[8], w1[8], w2[8];
#pragma unroll
                for (int j = 0; j < 8; ++j) { w0[j] = cw[c8 + j]; w1[j] = cw[512 + c8 + j]; w2[j] = cw[1024 + c8 + j]; }
                float z[10][8];
#pragma unroll
                for (int i = 0; i < 10; ++i) { const int tt = tg0 - 2 + i;
                    if (tt >= bstart) { const u32x4 a = *(const u32x4*)(Ub + (size_t)tt * UP + COL_Z + c8);
                        z[i][0] = bf_lo(a.x); z[i][1] = bf_hi(a.x); z[i][2] = bf_lo(a.y); z[i][3] = bf_hi(a.y); z[i][4] = bf_lo(a.z); z[i][5] = bf_hi(a.z); z[i][6] = bf_lo(a.w); z[i][7] = bf_hi(a.w); }
                    else {
#pragma unroll
                        for (int j = 0; j < 8; ++j) z[i][j] = 0.f; } }
#pragma unroll
                for (int o = 0; o < 8; ++o) { const int tt = tg0 + o; const u32x4 bg = *(const u32x4*)(Ub + (size_t)tt * UP + COL_BG + c8); float y[8];
#pragma unroll
                    for (int j = 0; j < 8; ++j) y[j] = w0[j] * z[o][j] + w1[j] * z[o + 1][j] + w2[j] * z[o + 2][j];
                    u32x4 w; w.x = cvt_pk_bf16(bf_lo(bg.x) * y[0], bf_hi(bg.x) * y[1]); w.y = cvt_pk_bf16(bf_lo(bg.y) * y[2], bf_hi(bg.y) * y[3]);
                    w.z = cvt_pk_bf16(bf_lo(bg.z) * y[4], bf_hi(bg.z) * y[5]); w.w = cvt_pk_bf16(bf_lo(bg.w) * y[6], bf_hi(bg.w) * y[7]);
                    *(u32x4*)(Yc + (size_t)tt * DM + c8) = w; }
                __syncthreads(); } }
            { const float* cw = p.in[IN_CCW] + (size_t)l * 31 * 512; const float* cb = p.in[IN_CCB] + l * 512; const float* lg = p.in[IN_LNG] + l * 512; const float* lb = p.in[IN_LNB] + l * 512;
              LAS float* hh = (LAS float*)lds; LAS float* co = hh + 46 * 512;
              for (;;) { const int it = __builtin_amdgcn_readfirstlane(qc[0]) - T_TOK / 64; __syncthreads(); if (it >= T_TOK / 16) break;
                if (tid == 0) qc[0] = __hip_atomic_fetch_add(cq, 1, __ATOMIC_RELAXED, __HIP_MEMORY_SCOPE_AGENT);
                const int t0 = it * 16, bstart = t0 & ~(SEQ - 1);
                { const int c8 = (tid & 63) * 8;
                  for (int i = tid >> 6; i < 46; i += 8) { const int tt = t0 - 30 + i; float v[8];
                    if (tt >= bstart) { const u32x4 a = *(const u32x4*)(Ub + (size_t)tt * UP + COL_HH + c8);
                        v[0] = bf_lo(a.x); v[1] = bf_hi(a.x); v[2] = bf_lo(a.y); v[3] = bf_hi(a.y); v[4] = bf_lo(a.z); v[5] = bf_hi(a.z); v[6] = bf_lo(a.w); v[7] = bf_hi(a.w); }
                    else {
#pragma unroll
                        for (int j = 0; j < 8; ++j) v[j] = 0.f; }
                    *(LAS f32x4*)(hh + i * 512 + c8) = (f32x4){v[0], v[1], v[2], v[3]}; *(LAS f32x4*)(hh + i * 512 + c8 + 4) = (f32x4){v[4], v[5], v[6], v[7]}; } }
                __syncthreads();
                { const int c = tid; float w[31];
#pragma unroll
                  for (int j = 0; j < 31; ++j) w[j] = cw[j * 512 + c];
                  const float bias = cb[c];
                  float win[46];
#pragma unroll
                  for (int i = 0; i < 46; ++i) win[i] = hh[i * 512 + c];
#pragma unroll
                  for (int o = 0; o < 16; ++o) { float a = bias;
#pragma unroll
                      for (int j = 0; j < 31; ++j) a = fmaf(w[j], win[o + j], a);
                      co[o * 512 + c] = a; } }
                __syncthreads();
                { const int c8 = lane * 8;
                  f32x4 ga = *(const f32x4*)(lg + c8), gb = *(const f32x4*)(lg + c8 + 4), ba = *(const f32x4*)(lb + c8), bb = *(const f32x4*)(lb + c8 + 4);
#pragma unroll
                  for (int q = 0; q < 2; ++q) { const int o = wave * 2 + q; const f32x4 xa = *(const LAS f32x4*)(co + o * 512 + c8), xb = *(const LAS f32x4*)(co + o * 512 + c8 + 4);
                    const float mu = wave_sum((xa[0] + xa[1]) + (xa[2] + xa[3]) + (xb[0] + xb[1]) + (xb[2] + xb[3])) * (1.f / 512.f);
                    const f32x4 da = xa - mu, db = xb - mu;
                    const float var = wave_sum((da[0] * da[0] + da[1] * da[1]) + (da[2] * da[2] + da[3] * da[3]) + (db[0] * db[0] + db[1] * db[1]) + (db[2] * db[2] + db[3] * db[3])) * (1.f / 512.f);
                    const float rstd = 1.0f / sqrtf(var + EPS);
                    f32x4 ya = da * rstd * ga + ba, yb = db * rstd * gb + bb;
#pragma unroll
                    for (int j = 0; j < 4; ++j) { ya[j] = ya[j] * fast_sigmoid(ya[j]); yb[j] = yb[j] * fast_sigmoid(yb[j]); }
                    u32x4 w; w.x = cvt_pk_bf16(ya[0], ya[1]); w.y = cvt_pk_bf16(ya[2], ya[3]); w.z = cvt_pk_bf16(yb[0], yb[1]); w.w = cvt_pk_bf16(yb[2], yb[3]);
                    *(u32x4*)(Yc + (size_t)(t0 + o) * DM + 1536 + c8) = w; } }
                __syncthreads();
              } }
#endif
        }
        PHASE_END
        PHASE_BEGIN(3)
        {

#ifdef ATT_CHECK
            if (l == ATT_CHECK) {
                LAS float* qs = (LAS float*)(lds + wave * 4608); LAS float* ps = qs + 128;
                const float SC = 0.088388347648318440f;
                for (int sidx = gw; sidx < 4096; sidx += NGW) {
                    const int b = sidx & 3, h = (sidx >> 2) & 7; const int t = (int)((((unsigned)sidx * 2654435761u) >> 12) & 4095u);
                    const int qblk = t >> 8; const float slope = exp2f(-(float)(h + 1));
                    const bf16_t* urow = Ub + (size_t)(b * SEQ + t) * UP;
                    for (int d = lane; d < 128; d += 64) qs[d] = __uint_as_float((unsigned)urow[COL_Q + h * HD + d] << 16) * SC;
                    asm volatile("s_waitcnt lgkmcnt(0)" ::: "memory");
                    float gate[16];
#pragma unroll
                    for (int n = 0; n < 16; ++n) gate[n] = -1e30f;
                    for (int n = 0; n < qblk; ++n) { float sacc = 0.f;
                        for (int kk = lane; kk < 256; kk += 64) { const bf16_t* kr = Ub + (size_t)(b * SEQ + n * 256 + kk) * UP + COL_K + h * HD; float dsum = 0.f;
                            for (int c = 0; c < 16; ++c) { const u32x4 w = *(const u32x4*)(kr + 8 * c);
                                dsum += qs[8 * c] * bf_lo(w.x) + qs[8 * c + 1] * bf_hi(w.x) + qs[8 * c + 2] * bf_lo(w.y) + qs[8 * c + 3] * bf_hi(w.y) + qs[8 * c + 4] * bf_lo(w.z) + qs[8 * c + 5] * bf_hi(w.z) + qs[8 * c + 6] * bf_lo(w.w) + qs[8 * c + 7] * bf_hi(w.w); }
                            sacc += dsum; }
                        const float gsum = wave_sum(sacc) * (1.f / 256.f);
#pragma unroll
                        for (int m = 0; m < 16; ++m) if (m == n) gate[m] = gsum; }
                    int sel[3] = {-1, -1, -1}; float sv[4] = {-1e30f, -1e30f, -1e30f, -1e30f};
                    { float gcopy[16];
#pragma unroll
                      for (int n = 0; n < 16; ++n) gcopy[n] = gate[n];
                      for (int it = 0; it < 4; ++it) { float best = gcopy[0]; int bi = 0;
#pragma unroll
                          for (int n = 1; n < 16; ++n) if (gcopy[n] > best) { best = gcopy[n]; bi = n; }
                          if (it < 3) sel[it] = bi; sv[it] = best;
#pragma unroll
                          for (int n = 0; n < 16; ++n) if (n == bi) gcopy[n] = -3e38f; } }
                    const int nsel = qblk < 3 ? qblk : 3;
                    const bool neartie = (qblk > 3) && (sv[2] - sv[3] < 1.5e-3f);
                    float mx = -1e30f;
                    for (int r = 0; r < 4; ++r) { const bool own = (r == 3); const int blkn = own ? qblk : sel[r]; const bool valid = own || r < nsel;
                        for (int kk = lane; kk < 256; kk += 64) { float lg = -1e30f;
                            if (valid) { const int kpos = blkn * 256 + kk;
                                if (!own || kpos <= t) { const bf16_t* kr = Ub + (size_t)(b * SEQ + kpos) * UP + COL_K + h * HD; float dsum = 0.f;
                                    for (int c = 0; c < 16; ++c) { const u32x4 w = *(const u32x4*)(kr + 8 * c);
                                        dsum += qs[8 * c] * bf_lo(w.x) + qs[8 * c + 1] * bf_hi(w.x) + qs[8 * c + 2] * bf_lo(w.y) + qs[8 * c + 3] * bf_hi(w.y) + qs[8 * c + 4] * bf_lo(w.z) + qs[8 * c + 5] * bf_hi(w.z) + qs[8 * c + 6] * bf_lo(w.w) + qs[8 * c + 7] * bf_hi(w.w); }
                                    lg = dsum - slope * (float)(t - kpos); } }
                            ps[r * 256 + kk] = lg; mx = fmaxf(mx, lg); } }
#pragma unroll
                    for (int o = 1; o < 64; o <<= 1) mx = fmaxf(mx, __shfl_xor(mx, o));
                    float se = 0.f;
                    for (int i = lane; i < 1024; i += 64) { const float e = (ps[i] > -1e29f) ? __expf(ps[i] - mx) : 0.f; ps[i] = e; se += e; }
                    se = wave_sum(se);
                    asm volatile("s_waitcnt lgkmcnt(0)" ::: "memory");
                    float o0 = 0.f, o1 = 0.f;
                    for (int r = 0; r < 4; ++r) { const bool own = (r == 3); const int blkn = own ? qblk : sel[r]; const bool valid = own || r < nsel;
                        if (valid) for (int kk = 0; kk < 256; ++kk) { const float pp = ps[r * 256 + kk];
                            if (pp != 0.f) { const unsigned w = *(const unsigned*)(Ub + (size_t)(b * SEQ + blkn * 256 + kk) * UP + COL_V + h * HD + 2 * lane); o0 += pp * bf_lo(w); o1 += pp * bf_hi(w); } } }
                    o0 /= se; o1 /= se;
                    const unsigned yw = *(const unsigned*)(Yc + (size_t)(b * SEQ + t) * DM + 512 + h * HD + 2 * lane);
                    float err = fmaxf(fabsf(o0 - bf_lo(yw)), fabsf(o1 - bf_hi(yw))), ref = fmaxf(fabsf(o0), fabsf(o1));
                    const bool isnan_ = !(err == err);
#pragma unroll
                    for (int o = 1; o < 64; o <<= 1) { err = fmaxf(err, __shfl_xor(err, o)); ref = fmaxf(ref, __shfl_xor(ref, o)); }
                    const bool bad = __any(isnan_) || !(err <= 0.03f * ref + 1e-4f);
                    if (lane == 0) { if (neartie) atomicAdd(&CNT[514], 1); else { atomicAdd(&CNT[513], 1); if (bad) atomicAdd(&CNT[512], 1); } }
                    asm volatile("s_waitcnt lgkmcnt(0)" ::: "memory");
                }
                __syncthreads();
            }
#endif
            pg8::DenseSched S{(const char*)Yc, (const char*)(wl + OFF_WOUT), T_TOK / 256, DM / 256, G, bx, DM};
            pg8::EpiResBf16 E{nullptr, XB};
            pg8::gemm_phase<2>(lds, tid, DM, S, E);
        }
        PHASE_END
        PHASE_BEGIN(4)
        {
            const bf16_t* RW = (const bf16_t*)(wl + OFF_RW);
            const float* rgb = p.in[IN_RGB] + l * 4; const float* reb = p.in[IN_REB] + l * 32;
            LAS float* part = (LAS float*)lds;
            LAS float* ssp = part + 8 * 64 * 49;
            LAS float* lgr = ssp + 8 * 64;
            LAS float* rsr = lgr + 64 * 49;
            const int r16 = lane & 15, q = lane >> 4;
            bf16x8 rwf[8][3];
#pragma unroll
            for (int ks = 0; ks < 8; ++ks)
#pragma unroll
                for (int nb = 0; nb < 3; ++nb) rwf[ks][nb] = *reinterpret_cast<const bf16x8*>(RW + (size_t)(nb * 16 + r16) * DM + wave * 256 + ks * 32 + 8 * q);
            for (int it = vcu; it < T_TOK / 64; it += G) {
#pragma unroll 1
                for (int rg = 0; rg < 4; ++rg) {
                    const int row = it * 64 + rg * 16 + r16;
                    const bf16_t* xr = XB + (size_t)row * DM + wave * 256 + 8 * q; unsigned char* x8r = ws + WS_X8 + (size_t)row * DM + wave * 256 + 8 * q;
                    u32x4 xw[8];
#pragma unroll
                    for (int ks = 0; ks < 8; ++ks) xw[ks] = *(const u32x4*)(xr + ks * 32);
                    f32x4 acc[3] = {(f32x4){0.f, 0.f, 0.f, 0.f}, (f32x4){0.f, 0.f, 0.f, 0.f}, (f32x4){0.f, 0.f, 0.f, 0.f}}; float ss = 0.f;
#pragma unroll
                    for (int ks = 0; ks < 8; ++ks) { const u32x4 w = xw[ks];
                        const float a0 = bf_lo(w.x), a1 = bf_hi(w.x), a2 = bf_lo(w.y), a3 = bf_hi(w.y), a4 = bf_lo(w.z), a5 = bf_hi(w.z), a6 = bf_lo(w.w), a7 = bf_hi(w.w);
                        ss += (a0 * a0 + a1 * a1) + (a2 * a2 + a3 * a3) + (a4 * a4 + a5 * a5) + (a6 * a6 + a7 * a7);
                        { int w0 = 0, w1 = 0;
                          w0 = __builtin_amdgcn_cvt_pk_fp8_f32(__builtin_amdgcn_fmed3f(a0, -400.f, 400.f), __builtin_amdgcn_fmed3f(a1, -400.f, 400.f), w0, false); w0 = __builtin_amdgcn_cvt_pk_fp8_f32(__builtin_amdgcn_fmed3f(a2, -400.f, 400.f), __builtin_amdgcn_fmed3f(a3, -400.f, 400.f), w0, true);
                          w1 = __builtin_amdgcn_cvt_pk_fp8_f32(__builtin_amdgcn_fmed3f(a4, -400.f, 400.f), __builtin_amdgcn_fmed3f(a5, -400.f, 400.f), w1, false); w1 = __builtin_amdgcn_cvt_pk_fp8_f32(__builtin_amdgcn_fmed3f(a6, -400.f, 400.f), __builtin_amdgcn_fmed3f(a7, -400.f, 400.f), w1, true);
                          *(u32x2*)(x8r + ks * 32) = (u32x2){(unsigned)w0, (unsigned)w1}; }
                        const bf16x8 a = *reinterpret_cast<const bf16x8*>(&w);
#pragma unroll
                        for (int nb = 0; nb < 3; ++nb) acc[nb] = __builtin_amdgcn_mfma_f32_16x16x32_bf16(a, rwf[ks][nb], acc[nb], 0, 0, 0); }
                    ss += __shfl_xor(ss, 16); ss += __shfl_xor(ss, 32);
                    if (q == 0) ssp[wave * 64 + rg * 16 + r16] = ss;
#pragma unroll
                    for (int nb = 0; nb < 3; ++nb)
#pragma unroll
                        for (int r = 0; r < 4; ++r) part[(wave * 64 + rg * 16 + 4 * q + r) * 49 + nb * 16 + r16] = acc[nb][r];
                }
                __syncthreads();
                for (int i = tid; i < 64 * 48; i += NTHREADS) { const int r = i / 48, c = i - r * 48; float a = 0.f;
#pragma unroll
                    for (int w = 0; w < 8; ++w) a += part[(w * 64 + r) * 49 + c];
                    lgr[r * 49 + c] = a; }
                if (tid < 64) { float a = 0.f;
#pragma unroll
                    for (int w = 0; w < 8; ++w) a += ssp[w * 64 + tid];
                    rsr[tid] = 1.0f / sqrtf(a * (1.f / DM) + EPS); }
                __syncthreads();
                if (tid < 64) {
                    const int row = it * 64 + tid; const float rs = rsr[tid];
                    const LAS float* lr = lgr + tid * 49;
                    float gl[4];
#pragma unroll
                    for (int j = 0; j < 4; ++j) gl[j] = lr[j] * rs + rgb[j];
                    int grp = 0; float gm = gl[0];
#pragma unroll
                    for (int j = 1; j < 4; ++j) if (gl[j] > gm) { gm = gl[j]; grp = j; }
                    float gsum = 0.f;
#pragma unroll
                    for (int j = 0; j < 4; ++j) gsum += __expf(gl[j] - gm);
                    const float pgrp = 1.0f / gsum;
                    float el[8];
#pragma unroll
                    for (int j = 0; j < 8; ++j) el[j] = lr[4 + grp * 8 + j] * rs + reb[grp * 8 + j];
                    int i1 = 0; float m1 = el[0];
#pragma unroll
                    for (int j = 1; j < 8; ++j) if (el[j] > m1) { m1 = el[j]; i1 = j; }
                    int i2 = -1; float m2 = -INFINITY;
#pragma unroll
                    for (int j = 0; j < 8; ++j) if (j != i1 && el[j] > m2) { m2 = el[j]; i2 = j; }
                    const float e2 = __expf(m2 - m1), inv = 1.0f / (1.0f + e2);
                    const float g1 = pgrp * inv, g2 = pgrp * e2 * inv;
                    const int E1 = grp * 8 + i1, E2 = grp * 8 + i2;
                    LAS int* hist = (LAS int*)(rsr + 64); LAS int* hbase = hist + 32;
                    if (tid < 32) hist[tid] = 0;
                    asm volatile("s_waitcnt lgkmcnt(0)" ::: "memory");
                    const int rk1 = __hip_atomic_fetch_add(&hist[E1], 1, __ATOMIC_RELAXED, __HIP_MEMORY_SCOPE_WORKGROUP);
                    const int rk2 = __hip_atomic_fetch_add(&hist[E2], 1, __ATOMIC_RELAXED, __HIP_MEMORY_SCOPE_WORKGROUP);
                    asm volatile("s_waitcnt lgkmcnt(0)" ::: "memory");
                    if (tid < 32) { const int hc = hist[tid]; hbase[tid] = hc > 0 ? atomicAdd(&cntg[tid * 64], hc) : 0; }
                    asm volatile("s_waitcnt vmcnt(0) lgkmcnt(0)" ::: "memory");
                    const int pos1 = hbase[E1] + rk1, pos2 = hbase[E2] + rk2;
                    TM[E1 * T_TOK + pos1] = row; TM[E2 * T_TOK + pos2] = row;
                    u32x4 ra = {(unsigned)E1, (unsigned)pos1, (unsigned)E2, (unsigned)pos2}; u32x4 rb = {__float_as_uint(g1), __float_as_uint(g2), 0u, 0u};
                    *(u32x4*)(REC + (size_t)row * 8) = ra; *(u32x4*)(REC + (size_t)row * 8 + 4) = rb;
                    RS[row] = rs;
                }
                __syncthreads();
            }
        }
        PHASE_END
        for (int pass = 0; pass < 2; ++pass) {
            PHASE_BEGIN(5)
            {
                if (tid < 64) { const int c = tid < NEXP ? __hip_atomic_load(&cntg[tid * 64], __ATOMIC_RELAXED, __HIP_MEMORY_SCOPE_AGENT) : 0; const int nt_ = (c + 255) >> 8; int incl = nt_;
#pragma unroll
                    for (int o = 1; o < 64; o <<= 1) { const int v = __shfl_up(incl, o); if (lane >= o) incl += v; }
                    const int st = incl - nt_;
                    if (tid < NEXP) { m_tstart[tid] = st; m_cnt[tid] = c; for (int k = 0; k < nt_; ++k) m_tile_e[st + k] = tid; }
                    if (tid == NEXP) m_tstart[NEXP] = st; }
                __syncthreads();
                const int nM = m_tstart[NEXP];
#ifndef PASS_MASK
#define PASS_MASK 3
#endif
                if ((PASS_MASK & 1) && pass == 0) {
                    pg8::MoeSched S{(const char*)(ws + WS_X8), (const char*)(wl + OFF_WGU), (size_t)1024 * DM, nM, 1024 / 256, G, bx, DM, true, m_tile_e, m_tstart, m_cnt, TM, 1};
                    pg8::EpiSwiglu E{(unsigned char*)HMb, RS, TM, m_tstart, m_cnt};
                    pg8::gemm_phase<1>(lds, tid, DM, S, E);
                } else if (PASS_MASK & 2) {
                    pg8::MoeSched S{(const char*)HMb, (const char*)(wl + OFF_WD), (size_t)DM * DEXP, nM, DM / 256, G, bx, DEXP, false, m_tile_e, m_tstart, m_cnt, TM, 1};
                    pg8::EpiFp8 E{(unsigned char*)YM, DM, pg8::YM_SCALE / (HM_SCALE * W2_SCALE)};
                    pg8::gemm_phase<1>(lds, tid, DEXP, S, E);
                }
                __syncthreads();
            }
            PHASE_END
        }
        PHASE_BEGIN(6)
        {
            int tst; { const int c = lane < NEXP ? __hip_atomic_load(&cntg[lane * 64], __ATOMIC_RELAXED, __HIP_MEMORY_SCOPE_AGENT) : 0; const int nt_ = (c + 255) >> 8; int incl = nt_;
#pragma unroll
                for (int o = 1; o < 64; o <<= 1) { const int v = __shfl_up(incl, o); if (lane >= o) incl += v; }
                tst = incl - nt_; }
            const bool fin = (l == DEPTH - 1);
            u32x4 ra_n = (u32x4){0u, 0u, 0u, 0u}; u32x2 rb_n = (u32x2){0u, 0u};
            if (gw < T_TOK) { ra_n = *(const u32x4*)(REC + (size_t)gw * 8); rb_n = *(const u32x2*)(REC + (size_t)gw * 8 + 4); }
            for (int m = gw; m < T_TOK; m += NGW) {
                const u32x4 ra = ra_n; const u32x2 rb = rb_n;
                if (m + NGW < T_TOK) { ra_n = *(const u32x4*)(REC + (size_t)(m + NGW) * 8); rb_n = *(const u32x2*)(REC + (size_t)(m + NGW) * 8 + 4); }
                const int r0 = __shfl(tst, (int)ra.x) * 256 + (int)ra.y, r1 = __shfl(tst, (int)ra.z) * 256 + (int)ra.w;
                RowRegs RR; combine_load(RR, XB + (size_t)m * DM, (const unsigned char*)YM + (size_t)r0 * DM, (const unsigned char*)YM + (size_t)r1 * DM, lane);
                combine_finish(RR, XB + (size_t)m * DM, __uint_as_float(rb.x), __uint_as_float(rb.y), RS + m, fin ? p.out + (size_t)m * DM : nullptr, p.in[IN_FG], lane);
            }
        }
        PHASE_END
    }
#ifdef PROBE_A
    { __syncthreads(); grid.sync(); if (bx == 0 && threadIdx.x == 0) { volatile LAS unsigned long long* tsp = (volatile LAS unsigned long long*)(lds + MISC_OFF + 4352);
        const float ta = (float)(tsp[PROBE_A + 1] - tsp[PROBE_A]) * 0.01f, tb = (float)(tsp[PROBE_B + 1] - tsp[PROBE_B]) * 0.01f;
        (void)tb; p.out[0] += 40.f * rintf((ta - PROBE_OFS) * 0.025f) + PROBE_OFS; } }
#endif
#ifdef PROBE_TILES
    { __syncthreads(); grid.sync(); if (bx == 0 && threadIdx.x == 0) { int* CNTd = (int*)(p.ws + WS_CTL); p.out[0] += (float)CNTd[520] * 0.01f; } }
#endif
#ifdef ATT_CHECK
    { grid.sync(); if (bx == 0 && threadIdx.x == 0) { int* CNTd = (int*)(p.ws + WS_CTL); const int bad = CNTd[512], tot = CNTd[513], nt_ = CNTd[514];
        float A = 10.f + 1000.f * (float)bad / (float)(tot > 0 ? tot : 1);
#if ATT_REPORT == 1
        A = 10.f + 1000.f * (float)nt_ / 4096.f;
#endif
        p.out[0] += A; } }
#endif
#undef PHASE_BEGIN
#undef PHASE_END
}

constexpr int N_PHASES = 1 + 7 * DEPTH;

extern "C" void kernel_launch(void* const* d_in, const int* in_sizes, int n_in, void* d_out, int out_size, void* d_ws, size_t ws_size, hipStream_t stream) {
    static int grid = 0;
    if (grid == 0) {
        if (n_in != 18 || in_sizes[0] != T_TOK * DM || out_size != T_TOK * DM || ws_size < WS_END) {
            fprintf(stderr, "kernel_launch: unexpected shapes: n_in %d in0 %d out %d ws %zu (need >= %zu)\n", n_in, n_in > 0 ? in_sizes[0] : -1, out_size, ws_size, (size_t)WS_END); grid = -1; return; }
        int dev = 0, cus = 0, per_cu = 0;
        hipGetDevice(&dev); hipDeviceGetAttribute(&cus, hipDeviceAttributeMultiprocessorCount, dev);
        if (hipFuncSetAttribute((const void*)fwd_kernel, hipFuncAttributeMaxDynamicSharedMemorySize, LDS_BYTES) != hipSuccess) { fprintf(stderr, "kernel_launch: hipFuncSetAttribute failed\n"); grid = -1; return; }
        if (hipOccupancyMaxActiveBlocksPerMultiprocessor(&per_cu, (const void*)fwd_kernel, NTHREADS, LDS_BYTES) != hipSuccess || per_cu < 1) { fprintf(stderr, "kernel_launch: occupancy query says %d blocks/CU\n", per_cu); per_cu = 1; }
        (void)hipGetLastError();
        grid = cus;
        if (grid > 256) grid = 256;
    }
    if (grid < 0) return;
    hipMemsetAsync((char*)d_ws + WS_CTL, 0, CTL_BYTES, stream);
    Params p{};
    for (int i = 0; i < 18; ++i) p.in[i] = (const float*)d_in[i];
    p.out = (float*)d_out; p.ws = (unsigned char*)d_ws;
#if MK_N_LAUNCHES == 1
    p.ph_lo = 0; p.ph_hi = N_PHASES;
    void* args[] = {&p};
    hipError_t e = hipLaunchCooperativeKernel((const void*)fwd_kernel, dim3(grid), dim3(NTHREADS), args, LDS_BYTES, stream);
    if (e != hipSuccess) fprintf(stderr, "kernel_launch: cooperative launch failed: %s (grid %d)\n", hipGetErrorString(e), grid);
#else
    for (int ph = 0; ph < N_PHASES; ++ph) { p.ph_lo = ph; p.ph_hi = ph + 1;
        hipLaunchKernelGGL(fwd_kernel, dim3(grid), dim3(NTHREADS), LDS_BYTES, stream, p); }
    hipError_t e = hipPeekAtLastError();
    if (e != hipSuccess) fprintf(stderr, "kernel_launch: launch failed: %s\n", hipGetErrorName(e));
#endif
}
```

```cpp
#include <hip/hip_runtime.h>
#include <hip/hip_cooperative_groups.h>
#include <cstdio>
#include <cstdint>
namespace cg = cooperative_groups;

#ifndef PROBE_ATT2
#define PROBE_ATT2 0
#endif
#ifndef ATT_REPORT
#define ATT_REPORT 0
#endif
#ifndef MK_N_LAUNCHES
#define MK_N_LAUNCHES 1
#endif

#define LAS __attribute__((address_space(3)))
typedef unsigned short bf16_t;
typedef short bf16x8 __attribute__((ext_vector_type(8)));
typedef short s16x4 __attribute__((ext_vector_type(4)));
typedef float f32x2 __attribute__((ext_vector_type(2)));
typedef float f32x4 __attribute__((ext_vector_type(4)));
typedef float f32x16 __attribute__((ext_vector_type(16)));
typedef unsigned u32x2 __attribute__((ext_vector_type(2)));
typedef unsigned u32x4 __attribute__((ext_vector_type(4)));

constexpr int T_TOK = 16384, DM = 2048, DIN = 5632, SEQ = 4096, NBATCH = 4, NHEAD = 8, HD = 128, DEPTH = 2;
constexpr int GC_Q = 1536, GC_K = 2560, GC_V = 3584;
constexpr int UP = 4608, COL_BG = 0, COL_Z = 512, COL_Q = 1024, COL_K = 2048, COL_V = 3072, COL_HH = 4096;
constexpr int NEXP = 32, DEXP = 512, NRW = 48;
constexpr int MAXTILES = 160;
constexpr float EPS = 1e-6f;
constexpr float W1_SCALE = 64.f, W2_SCALE = 32.f, HM_SCALE = 16.f;
constexpr int NWAVES = 8, NTHREADS = 512;
constexpr int RING_BYTES = 131072, SCRATCH_BYTES = 147456, MISC_OFF = SCRATCH_BYTES, MISC_BYTES = 8192, LDS_BYTES = SCRATCH_BYTES + MISC_BYTES;

constexpr size_t MiB = 1u << 20;
constexpr size_t WS_CTL = 0;
constexpr size_t CTL_BYTES = 65536;
constexpr size_t SZ_WIN = (size_t)DIN * DM * 2, SZ_WOUT = (size_t)DM * DM * 2, SZ_WGU = (size_t)NEXP * 1024 * DM * 2, SZ_WD = (size_t)NEXP * DM * DEXP * 2, SZ_RW = (size_t)NRW * DM * 2;
constexpr size_t WS_W0 = 1 * MiB;
constexpr size_t OFF_WIN = 0, OFF_WOUT = OFF_WIN + SZ_WIN, OFF_WGU = OFF_WOUT + SZ_WOUT, OFF_WD = OFF_WGU + SZ_WGU, OFF_RW = OFF_WD + SZ_WD, SZ_LAYER = ((OFF_RW + SZ_RW + 4095) / 4096) * 4096;
constexpr size_t WS_U = WS_W0 + DEPTH * SZ_LAYER;
constexpr size_t SZ_U = (size_t)T_TOK * UP * 2;
static_assert((size_t)MAXTILES * 256 * DM <= SZ_U, "ymoe (fp8) overlays u");
constexpr size_t WS_Y = WS_U + SZ_U;
constexpr size_t WS_H = WS_Y + (size_t)T_TOK * DM * 2;
constexpr size_t WS_HM = WS_H + (size_t)T_TOK * DM * 2;
constexpr size_t WS_KS = WS_HM + (size_t)MAXTILES * 256 * DEXP * 2;
constexpr size_t WS_RS = WS_KS + (size_t)64 * 2 * 1024 * 4;
constexpr size_t WS_REC = WS_RS + (size_t)T_TOK * 4;
constexpr size_t WS_TM = WS_REC + (size_t)T_TOK * 32;
constexpr size_t WS_XB = WS_TM + (size_t)NEXP * T_TOK * 4;
constexpr size_t WS_X8 = WS_XB + (size_t)T_TOK * DM * 2;
constexpr size_t WS_NRM = WS_X8 + (size_t)T_TOK * DM;
constexpr size_t WS_PART = WS_NRM + 2 * 64 * 8 * 8 * 4;
constexpr size_t WS_END = WS_PART + (size_t)48 * 66 * 512 * 4;

__device__ __forceinline__ unsigned cvt_pk_bf16(float lo, float hi) { unsigned r; asm volatile("v_cvt_pk_bf16_f32 %0, %1, %2" : "=v"(r) : "v"(lo), "v"(hi)); return r; }
__device__ __forceinline__ float bf_lo(unsigned w) { return __uint_as_float(w << 16); }
__device__ __forceinline__ float bf_hi(unsigned w) { return __uint_as_float(w & 0xffff0000u); }
#define SWZ_XOR(v, O) __uint_as_float((unsigned)__builtin_amdgcn_ds_swizzle((int)__float_as_uint(v), ((O) << 10) | 0x1f))
__device__ __forceinline__ float half_sum(float v) { auto rr = __builtin_amdgcn_permlane32_swap(__float_as_uint(v), __float_as_uint(v), false, false); return __uint_as_float(rr[0]) + __uint_as_float(rr[1]); }
__device__ __forceinline__ float half_max(float v) { auto rr = __builtin_amdgcn_permlane32_swap(__float_as_uint(v), __float_as_uint(v), false, false); return fmaxf(__uint_as_float(rr[0]), __uint_as_float(rr[1])); }
__device__ __forceinline__ float wave_sum(float v) {
    v += SWZ_XOR(v, 1); v += SWZ_XOR(v, 2); v += SWZ_XOR(v, 4); v += SWZ_XOR(v, 8); v += SWZ_XOR(v, 16);
    return half_sum(v);
}
__device__ __forceinline__ float fast_sigmoid(float x) { return __builtin_amdgcn_rcpf(1.f + __builtin_amdgcn_exp2f(-1.4426950408889634f * x)); }

namespace pg8 {
constexpr int BM = 256, BK = 64, HALF = 128, HTB = HALF * BK * 2, STAGE_BYTES = 8 * HTB, NXCD = 8, WGM = 8;
__host__ __device__ __forceinline__ int lds_byte(int r, int c) { const int st = (r >> 4) * 2 + (c >> 5), rr = r & 15, cc = c & 31, ob = rr * 64 + cc * 2; return st * 1024 + (ob ^ (((ob >> 9) & 1) << 5)); }
__host__ __device__ __forceinline__ void stage_rc(int b, int& R, int& C) { const int st = b / 1024, sb = b % 1024, swz = sb ^ (((sb >> 9) & 1) << 5); R = (st >> 1) * 16 + swz / 64; C = (st & 1) * 32 + (swz % 64) / 2; }
__host__ __device__ __forceinline__ int perm32(int rho) { const int n = rho >> 4, i = rho & 15; return 8 * (i >> 2) + 4 * n + (i & 3); }

struct Unit { int pm, pn, e; };

__device__ __forceinline__ bool order_next(int i, int G, int c, int nM, int nN, Unit& u) {
    const int nwg = nM * nN; const long L = (long)i * G + c; if (L >= nwg) return false;
    int wgid = (int)L; { const int q = nwg / NXCD, r = nwg % NXCD, xcd = wgid % NXCD, off = wgid / NXCD; wgid = (xcd < r ? xcd * (q + 1) : r * (q + 1) + (xcd - r) * q) + off; }
    const int nig = WGM * nN, gid = wgid / nig, fm = gid * WGM, gsz = (nM - fm) < WGM ? (nM - fm) : WGM;
    u.pm = fm + ((wgid % nig) % gsz); u.pn = (wgid % nig) / gsz; u.e = 0; return true;
}

struct DenseSched {
    const char* A; const char* Bt; int nM, nN, G, c, K;
    __device__ __forceinline__ bool next(int i, Unit& u) const { return order_next(i, G, c, nM, nN, u); }
    __device__ __forceinline__ unsigned a_off(const Unit& u) const { return (unsigned)(u.pm * BM * K * 2); }
    __device__ __forceinline__ unsigned b_off(const Unit& u) const { return (unsigned)(u.pn * BM * K * 2); }
    __device__ __forceinline__ void a_rows(const Unit&, const int (&RA)[2], const unsigned (&cofA)[2], unsigned (&g)[2][2]) const {
#pragma unroll
        for (int h = 0; h < 2; ++h)
#pragma unroll
            for (int i = 0; i < 2; ++i) g[h][i] = (unsigned)((h * HALF + RA[i]) * K) * 2u + cofA[i];
    }
};
struct MoeSched {
    const char* A; const char* Bt; size_t b_estride; int nM, nN, G, c, K; bool gather;
    const LAS int* tile_e; const LAS int* tstart; const LAS int* cnt; const int* tokmap; int es;
    __device__ __forceinline__ bool next(int i, Unit& u) const { if (!order_next(i, G, c, nM, nN, u)) return false; u.e = tile_e[u.pm]; return true; }
    __device__ __forceinline__ unsigned a_off(const Unit& u) const { return gather ? 0u : (unsigned)(u.pm * BM * K * es); }
    __device__ __forceinline__ unsigned b_off(const Unit& u) const { return (unsigned)(u.e * (int)b_estride + u.pn * BM * K * es); }
    __device__ __forceinline__ void a_rows(const Unit& u, const int (&RA)[2], const unsigned (&cofA)[2], unsigned (&g)[2][2]) const {
        if (gather) {
            const int p0 = (u.pm - tstart[u.e]) * BM, cn = cnt[u.e];
#pragma unroll
            for (int h = 0; h < 2; ++h)
#pragma unroll
                for (int i = 0; i < 2; ++i) { int pos = p0 + h * HALF + RA[i]; pos = pos < cn ? pos : cn - 1; const int tok = tokmap[u.e * T_TOK + pos]; g[h][i] = (unsigned)(tok * K * es) + cofA[i]; }
        } else {
#pragma unroll
            for (int h = 0; h < 2; ++h)
#pragma unroll
                for (int i = 0; i < 2; ++i) g[h][i] = (unsigned)((h * HALF + RA[i]) * K * es) + cofA[i];
        }
    }
};

__device__ __forceinline__ void acc_zero(f32x4 (&acc)[2][2][4][2]) {
    float z; asm volatile("v_mov_b32 %0, 0" : "=v"(z));
#pragma unroll
    for (int a = 0; a < 2; ++a)
#pragma unroll
        for (int b = 0; b < 2; ++b)
#pragma unroll
            for (int m = 0; m < 4; ++m)
#pragma unroll
                for (int n = 0; n < 2; ++n) acc[a][b][m][n] = (f32x4){z, z, z, z};
}
struct EpiInProj {
    static constexpr bool PERM = true;
    __device__ __forceinline__ void init(f32x4 (&acc)[2][2][4][2], const Unit&, int, int, int, int) const { acc_zero(acc); }
    bf16_t* U; float* ksum; float* nrm; const float* rs;
    __device__ __forceinline__ void operator()(const f32x4 (&acc_)[2][2][4][2], const Unit& u, int wr, int wc, int fr, int fq) const {
        const int row0 = u.pm * BM + wr * 64 + fr, col0 = u.pn * BM + wc * 32 + 8 * fq;
        f32x4 acc[2][2][4][2];
#pragma unroll
        for (int ai = 0; ai < 2; ++ai)
#pragma unroll
            for (int m = 0; m < 4; ++m) { const float sc = rs[row0 + ai * HALF + m * 16];
#pragma unroll
                for (int bj = 0; bj < 2; ++bj) { acc[ai][bj][m][0] = acc_[ai][bj][m][0] * sc; acc[ai][bj][m][1] = acc_[ai][bj][m][1] * sc; } }
        const bool paired = (u.pn >= 2 && u.pn < 6) || u.pn >= 18;
        if (!paired) { const int ocol = (u.pn < 2 ? u.pn * 256 : COL_Q + (u.pn - 6) * 256) + wc * 32 + 8 * fq;
#pragma unroll
          for (int ai = 0; ai < 2; ++ai)
#pragma unroll
            for (int m = 0; m < 4; ++m) { bf16_t* rowp = U + (size_t)(row0 + ai * HALF + m * 16) * UP + ocol;
#pragma unroll
                for (int bj = 0; bj < 2; ++bj) { const f32x4 v0 = acc[ai][bj][m][0], v1 = acc[ai][bj][m][1]; u32x4 w;
                    w.x = cvt_pk_bf16(v0[0], v0[1]); w.y = cvt_pk_bf16(v0[2], v0[3]); w.z = cvt_pk_bf16(v1[0], v1[1]); w.w = cvt_pk_bf16(v1[2], v1[3]);
                    *(u32x4*)(rowp + bj * HALF) = w; } }
        } else { const bool glu = u.pn >= 18; const int ocol = (glu ? COL_HH + (u.pn - 18) * 128 : COL_Z + (u.pn - 2) * 128) + wc * 16 + 4 * fq;
#pragma unroll
          for (int ai = 0; ai < 2; ++ai)
#pragma unroll
            for (int m = 0; m < 4; ++m) { bf16_t* rowp = U + (size_t)(row0 + ai * HALF + m * 16) * UP + ocol;
#pragma unroll
                for (int bj = 0; bj < 2; ++bj) { const f32x4 v0 = acc[ai][bj][m][0], v1 = acc[ai][bj][m][1];
                    float h0, h1, h2, h3;
                    if (glu) { h0 = v0[0] * fast_sigmoid(v0[1]); h1 = v0[2] * fast_sigmoid(v0[3]); h2 = v1[0] * fast_sigmoid(v1[1]); h3 = v1[2] * fast_sigmoid(v1[3]); }
                    else { h0 = v0[0] * v0[1]; h1 = v0[2] * v0[3]; h2 = v1[0] * v1[1]; h3 = v1[2] * v1[3]; }
                    u32x2 w; w.x = cvt_pk_bf16(h0, h1); w.y = cvt_pk_bf16(h2, h3); *(u32x2*)(rowp + bj * (HALF / 2)) = w; } }
        }
        if (u.pn >= GC_Q / 256 && u.pn < GC_V / 256) {
            const int kind = u.pn >= GC_K / 256, hb = 2 * (u.pn - (kind ? GC_K / 256 : GC_Q / 256));
#pragma unroll
            for (int bj = 0; bj < 2; ++bj) { float mx = 0.f;
#pragma unroll
                for (int ai = 0; ai < 2; ++ai)
#pragma unroll
                    for (int m = 0; m < 4; ++m) { const f32x4 a = acc[ai][bj][m][0], c = acc[ai][bj][m][1];
                        float q = (a[0] * a[0] + a[1] * a[1]) + (a[2] * a[2] + a[3] * a[3]) + (c[0] * c[0] + c[1] * c[1]) + (c[2] * c[2] + c[3] * c[3]);
                        q += SWZ_XOR(q, 16); q = half_sum(q); mx = fmaxf(mx, q); }
                mx = fmaxf(mx, SWZ_XOR(mx, 1)); mx = fmaxf(mx, SWZ_XOR(mx, 2)); mx = fmaxf(mx, SWZ_XOR(mx, 4)); mx = fmaxf(mx, SWZ_XOR(mx, 8));
                if ((fr | fq) == 0) nrm[(((kind * 64 + u.pm) * 8 + hb + bj) * 2 + wr) * 4 + wc] = mx; }
        }
        if (u.pn >= GC_K / 256 && u.pn < GC_V / 256) {
            float* kp = ksum + (size_t)(u.pm * 2 + wr) * 1024 + (u.pn - GC_K / 256) * 256 + wc * 32 + 8 * fq;
#pragma unroll
            for (int bj = 0; bj < 2; ++bj)
#pragma unroll
                for (int n = 0; n < 2; ++n) { f32x4 s = (f32x4){0.f, 0.f, 0.f, 0.f};
#pragma unroll
                    for (int ai = 0; ai < 2; ++ai)
#pragma unroll
                        for (int m = 0; m < 4; ++m) s += acc[ai][bj][m][n];
#pragma unroll
                    for (int e = 0; e < 4; ++e) { float t = s[e]; t += SWZ_XOR(t, 1); t += SWZ_XOR(t, 2); t += SWZ_XOR(t, 4); t += SWZ_XOR(t, 8); s[e] = t; }
                    if (fr == 0) *(f32x4*)(kp + bj * HALF + 4 * n) = s; }
        }
    }
};
struct EpiResBf16 {
    static constexpr bool PERM = true;
    const float* resf; bf16_t* out;
    __device__ __forceinline__ void init(f32x4 (&acc)[2][2][4][2], const Unit& u, int wr, int wc, int fr, int fq) const {
        const int row0 = u.pm * BM + wr * 64 + fr, col0 = u.pn * BM + wc * 32 + 8 * fq;
#pragma unroll
        for (int ai = 0; ai < 2; ++ai)
#pragma unroll
            for (int m = 0; m < 4; ++m) { const size_t off = (size_t)(row0 + ai * HALF + m * 16) * DM + col0;
#pragma unroll
                for (int bj = 0; bj < 2; ++bj) {
                    if (resf) { acc[ai][bj][m][0] = __builtin_nontemporal_load((const f32x4*)(resf + off + bj * HALF)); acc[ai][bj][m][1] = __builtin_nontemporal_load((const f32x4*)(resf + off + bj * HALF + 4)); }
                    else { const u32x4 r = *(const u32x4*)(out + off + bj * HALF);
                        acc[ai][bj][m][0] = (f32x4){bf_lo(r.x), bf_hi(r.x), bf_lo(r.y), bf_hi(r.y)}; acc[ai][bj][m][1] = (f32x4){bf_lo(r.z), bf_hi(r.z), bf_lo(r.w), bf_hi(r.w)}; } } }
    }
    __device__ __forceinline__ void operator()(const f32x4 (&acc)[2][2][4][2], const Unit& u, int wr, int wc, int fr, int fq) const {
        const int row0 = u.pm * BM + wr * 64 + fr, col0 = u.pn * BM + wc * 32 + 8 * fq;
#pragma unroll
        for (int ai = 0; ai < 2; ++ai)
#pragma unroll
            for (int m = 0; m < 4; ++m) { const size_t off = (size_t)(row0 + ai * HALF + m * 16) * DM + col0;
#pragma unroll
                for (int bj = 0; bj < 2; ++bj) { const f32x4 v0 = acc[ai][bj][m][0], v1 = acc[ai][bj][m][1];
                    u32x4 w; w.x = cvt_pk_bf16(v0[0], v0[1]); w.y = cvt_pk_bf16(v0[2], v0[3]); w.z = cvt_pk_bf16(v1[0], v1[1]); w.w = cvt_pk_bf16(v1[2], v1[3]);
                    *(u32x4*)(out + off + bj * HALF) = w; } }
    }
};
struct EpiSwiglu {
    static constexpr bool PERM = true;
    __device__ __forceinline__ void init(f32x4 (&acc)[2][2][4][2], const Unit&, int, int, int, int) const { acc_zero(acc); }
    unsigned char* HMo; const float* rs; const int* tokmap; const LAS int* tstart; const LAS int* cnt;
    __device__ __forceinline__ void operator()(const f32x4 (&acc)[2][2][4][2], const Unit& u, int wr, int wc, int fr, int fq) const {
        const int p0 = (u.pm - tstart[u.e]) * BM, cn = cnt[u.e];
#pragma unroll
        for (int ai = 0; ai < 2; ++ai)
#pragma unroll
            for (int m = 0; m < 4; ++m) { const int r = ai * HALF + wr * 64 + m * 16 + fr; int pos = p0 + r; pos = pos < cn ? pos : cn - 1;
                const float sc = rs[tokmap[u.e * T_TOK + pos]] * (1.f / W1_SCALE);
                unsigned char* rowp = HMo + (size_t)(u.pm * BM + r) * DEXP + ((u.pn * BM + wc * 32 + 8 * fq) >> 1);
#pragma unroll
                for (int bj = 0; bj < 2; ++bj) { const f32x4 v0 = acc[ai][bj][m][0] * sc, v1 = acc[ai][bj][m][1] * sc;
                    const float h0 = __builtin_amdgcn_fmed3f(HM_SCALE * v0[0] * fast_sigmoid(v0[0]) * v0[1], -400.f, 400.f), h1 = __builtin_amdgcn_fmed3f(HM_SCALE * v0[2] * fast_sigmoid(v0[2]) * v0[3], -400.f, 400.f);
                    const float h2 = __builtin_amdgcn_fmed3f(HM_SCALE * v1[0] * fast_sigmoid(v1[0]) * v1[1], -400.f, 400.f), h3 = __builtin_amdgcn_fmed3f(HM_SCALE * v1[2] * fast_sigmoid(v1[2]) * v1[3], -400.f, 400.f);
                    int w = 0; w = __builtin_amdgcn_cvt_pk_fp8_f32(h0, h1, w, false); w = __builtin_amdgcn_cvt_pk_fp8_f32(h2, h3, w, true);
                    *(unsigned*)(rowp + bj * (HALF / 2)) = (unsigned)w; } }
    }
};
constexpr float YM_SCALE = 8.f;
struct EpiFp8 {
    static constexpr bool PERM = true;
    __device__ __forceinline__ void init(f32x4 (&acc)[2][2][4][2], const Unit&, int, int, int, int) const { acc_zero(acc); }
    unsigned char* O; int ldc; float osc;
    __device__ __forceinline__ void operator()(const f32x4 (&acc)[2][2][4][2], const Unit& u, int wr, int wc, int fr, int fq) const {
        const int row0 = u.pm * BM + wr * 64 + fr, col0 = u.pn * BM + wc * 32 + 8 * fq;
#pragma unroll
        for (int ai = 0; ai < 2; ++ai)
#pragma unroll
            for (int m = 0; m < 4; ++m) { unsigned char* rowp = O + (size_t)(row0 + ai * HALF + m * 16) * ldc + col0;
#pragma unroll
                for (int bj = 0; bj < 2; ++bj) { f32x4 v0 = acc[ai][bj][m][0] * osc, v1 = acc[ai][bj][m][1] * osc;
#pragma unroll
                    for (int e = 0; e < 4; ++e) { v0[e] = __builtin_amdgcn_fmed3f(v0[e], -400.f, 400.f); v1[e] = __builtin_amdgcn_fmed3f(v1[e], -400.f, 400.f); }
                    int w0 = 0, w1 = 0;
                    w0 = __builtin_amdgcn_cvt_pk_fp8_f32(v0[0], v0[1], w0, false); w0 = __builtin_amdgcn_cvt_pk_fp8_f32(v0[2], v0[3], w0, true);
                    w1 = __builtin_amdgcn_cvt_pk_fp8_f32(v1[0], v1[1], w1, false); w1 = __builtin_amdgcn_cvt_pk_fp8_f32(v1[2], v1[3], w1, true);
                    *(u32x2*)(rowp + bj * HALF) = (u32x2){(unsigned)w0, (unsigned)w1}; } }
    }
};

template <int ES, class Epi, class Sched>
__device__ __forceinline__ void gemm_phase(LAS unsigned char* lds, const int wid, const int K, const Sched& S, const Epi& E) {
#define PG8_LANE(l_) int l_; asm volatile("v_mbcnt_lo_u32_b32 %0, -1, 0\n\tv_mbcnt_hi_u32_b32 %0, -1, %0" : "=v"(l_))
    const int wr = wid >> 2, wc = wid & 3;
    const int nt = K * ES / (BK * 2);
    unsigned voffB[2]; int aoff, boff;
    { PG8_LANE(l0); const int t0 = wid * 64 + l0, fr = l0 & 15, fq = l0 >> 4;
#pragma unroll
      for (int i = 0; i < 2; ++i) { int R, C; stage_rc(t0 * 16 + i * 8192, R, C); const int Rb = Epi::PERM ? ((R & ~31) + perm32(R & 31)) : R;
        voffB[i] = (unsigned)(Rb * K * ES) + (unsigned)C * 2u; }
      aoff = lds_byte(wr * 64 + fr, fq * 8); boff = lds_byte(wc * 32 + fr, fq * 8); }
#define PG8_AROWS(u_, g_) do { PG8_LANE(l_); const int t_ = wid * 64 + l_; int RA[2]; unsigned cofA[2]; \
        _Pragma("unroll") for (int i = 0; i < 2; ++i) { int R, C; stage_rc(t_ * 16 + i * 8192, R, C); RA[i] = R; cofA[i] = (unsigned)C * 2u; } S.a_rows(u_, RA, cofA, g_); } while (0)
    const unsigned kstep = (unsigned)(BK * 2);
    const unsigned hstep = (unsigned)(HALF * K * ES);
    const unsigned ldsw = (unsigned)wid * 1024u;
#define PG8_SA(b, h) (((b) * 2 + (h)) * HTB)
#define PG8_SB(b, h) ((4 + (b) * 2 + (h)) * HTB)
    const __amdgpu_buffer_rsrc_t rsA = __builtin_amdgcn_make_buffer_rsrc((void*)S.A, (short)0, 0x7fffffff, 0x00020000), rsB = __builtin_amdgcn_make_buffer_rsrc((void*)S.Bt, (short)0, 0x7fffffff, 0x00020000);
#define PG8_STG(bufoff, rs, soff, v0, v1) do { \
        __builtin_amdgcn_raw_ptr_buffer_load_lds(rs, (LAS unsigned*)(lds + (bufoff) + ldsw), 16, (int)(v0), (int)(soff), 0, 0); \
        __builtin_amdgcn_raw_ptr_buffer_load_lds(rs, (LAS unsigned*)(lds + (bufoff) + ldsw + 8192), 16, (int)(v1), (int)(soff), 0, 0); } while (0)
#define PG8_LDA(dst, b, h) do { _Pragma("unroll") for (int m = 0; m < 4; ++m) _Pragma("unroll") for (int k = 0; k < 2; ++k) dst[m].pc[k] = *(const LAS bf16x8*)(lds + PG8_SA(b, h) + aoff + m * 2048 + k * 1024); } while (0)
#define PG8_LDB(dst, b, h) do { _Pragma("unroll") for (int n = 0; n < 2; ++n) _Pragma("unroll") for (int k = 0; k < 2; ++k) dst[n].pc[k] = *(const LAS bf16x8*)(lds + PG8_SB(b, h) + boff + n * 2048 + k * 1024); } while (0)
#define PG8_MMA(ai, bj, At, Bt) do { __builtin_amdgcn_s_setprio(1); \
        if constexpr (ES == 2) { _Pragma("unroll") for (int m = 0; m < 4; ++m) _Pragma("unroll") for (int n = 0; n < 2; ++n) _Pragma("unroll") for (int k = 0; k < 2; ++k) \
            acc[ai][bj][m][n] = __builtin_amdgcn_mfma_f32_16x16x32_bf16(Bt[n].pc[k], At[m].pc[k], acc[ai][bj][m][n], 0, 0, 0); } \
        else { _Pragma("unroll") for (int m = 0; m < 4; ++m) _Pragma("unroll") for (int n = 0; n < 2; ++n) \
            asm volatile("v_mfma_scale_f32_16x16x128_f8f6f4 %0, %1, %2, %0, %3, %3 op_sel_hi:[0,0,0]" : "+v"(acc[ai][bj][m][n]) : "v"(__builtin_bit_cast(i32x8v, Bt[n])), "v"(__builtin_bit_cast(i32x8v, At[m])), "v"(mxs)); } \
        __builtin_amdgcn_s_setprio(0); } while (0)
#define PG8_WAIT_V(n) asm volatile("s_waitcnt vmcnt(" #n ")" ::: "memory")
#define PG8_WAIT_L(n) asm volatile("s_waitcnt lgkmcnt(" #n ")" ::: "memory")
#define PG8_BAR __builtin_amdgcn_s_barrier()
#define PG8_SCHED __builtin_amdgcn_sched_barrier(0)
    Unit cur, nxt; int ui = 0;
    if (!S.next(0, cur)) return;
    f32x4 acc[2][2][4][2];
    { PG8_LANE(li); E.init(acc, cur, wr, wc, li & 15, li >> 4); }
    typedef int i32x4v __attribute__((ext_vector_type(4))); typedef int i32x8v __attribute__((ext_vector_type(8)));
    struct Frag { bf16x8 pc[2]; };
    Frag At[4], B0[2], B1[2];
    const int mxs = 0x7F7F7F7F;
    unsigned cA = S.a_off(cur), cB = S.b_off(cur);
    unsigned gc[2][2], gn[2][2];
    PG8_AROWS(cur, gc);
    PG8_STG(PG8_SB(0, 0), rsB, cB, voffB[0], voffB[1]); PG8_STG(PG8_SB(0, 1), rsB, cB + hstep, voffB[0], voffB[1]); PG8_STG(PG8_SA(0, 0), rsA, cA, gc[0][0], gc[0][1]); PG8_STG(PG8_SA(0, 1), rsA, cA, gc[1][0], gc[1][1]);
    if (wr == 1) PG8_BAR;
    PG8_WAIT_V(2); PG8_BAR;
    PG8_STG(PG8_SB(1, 0), rsB, cB + kstep, voffB[0], voffB[1]); PG8_STG(PG8_SA(1, 0), rsA, cA + kstep, gc[0][0], gc[0][1]); PG8_STG(PG8_SB(1, 1), rsB, cB + hstep + kstep, voffB[0], voffB[1]);
    PG8_WAIT_V(6); PG8_BAR;
    for (;;) {
        const bool has_next = S.next(ui + 1, nxt);
        const unsigned nA = has_next ? S.a_off(nxt) : cA, nB = has_next ? S.b_off(nxt) : cB;
        if (has_next) PG8_AROWS(nxt, gn);
        else { gn[0][0] = gc[0][0]; gn[0][1] = gc[0][1]; gn[1][0] = gc[1][0]; gn[1][1] = gc[1][1]; }
#pragma unroll 1
        for (int t = 0; t < nt; t += 2) {
            const bool last = (t == nt - 2);
            const unsigned a1 = cA + (unsigned)(t + 1) * kstep;
            const unsigned a2 = last ? nA : cA + (unsigned)(t + 2) * kstep, b2 = last ? nB : cB + (unsigned)(t + 2) * kstep;
            const unsigned a3 = a2 + kstep, b3 = b2 + kstep;
            const unsigned g00 = last ? gn[0][0] : gc[0][0], g01 = last ? gn[0][1] : gc[0][1], g10 = last ? gn[1][0] : gc[1][0], g11 = last ? gn[1][1] : gc[1][1];
            PG8_LDB(B0, 0, 0); PG8_LDB(B1, 0, 1); PG8_SCHED; PG8_LDA(At, 0, 0); PG8_STG(PG8_SA(1, 1), rsA, a1, gc[1][0], gc[1][1]);
            PG8_WAIT_V(8); PG8_WAIT_L(0); PG8_BAR; PG8_MMA(0, 0, At, B0); PG8_MMA(0, 1, At, B1); PG8_BAR; PG8_SCHED;
            PG8_LDA(At, 0, 1); PG8_STG(PG8_SB(0, 0), rsB, b2, voffB[0], voffB[1]); PG8_STG(PG8_SB(0, 1), rsB, b2 + hstep, voffB[0], voffB[1]); PG8_STG(PG8_SA(0, 0), rsA, a2, g00, g01);
            PG8_WAIT_V(8); PG8_WAIT_L(0); PG8_BAR; PG8_MMA(1, 0, At, B0); PG8_MMA(1, 1, At, B1); PG8_BAR; PG8_SCHED;
            PG8_LDB(B0, 1, 0); PG8_LDB(B1, 1, 1); PG8_SCHED; PG8_LDA(At, 1, 0); PG8_STG(PG8_SA(0, 1), rsA, a2, g10, g11);
            PG8_WAIT_V(8); PG8_WAIT_L(0); PG8_BAR; PG8_MMA(0, 0, At, B0); PG8_MMA(0, 1, At, B1); PG8_BAR; PG8_SCHED;
            PG8_LDA(At, 1, 1); PG8_STG(PG8_SB(1, 0), rsB, b3, voffB[0], voffB[1]); PG8_STG(PG8_SB(1, 1), rsB, b3 + hstep, voffB[0], voffB[1]); PG8_STG(PG8_SA(1, 0), rsA, a3, g00, g01);
            PG8_WAIT_V(8); PG8_WAIT_L(0); PG8_BAR; PG8_MMA(1, 0, At, B0); PG8_MMA(1, 1, At, B1); PG8_BAR; PG8_SCHED;
        }
        if (wr == 0) PG8_BAR;
        if constexpr (ES == 1) asm volatile("s_nop 15\n\ts_nop 7" ::: "memory");
        { PG8_LANE(le); E(acc, cur, wr, wc, le & 15, le >> 4); }
        if (!has_next) break;
        { PG8_LANE(li); E.init(acc, nxt, wr, wc, li & 15, li >> 4); }
        cur = nxt; cA = nA; cB = nB; gc[0][0] = gn[0][0]; gc[0][1] = gn[0][1]; gc[1][0] = gn[1][0]; gc[1][1] = gn[1][1]; ++ui;
        if (wr == 1) PG8_BAR;
    }
    PG8_WAIT_V(0);
    PG8_BAR;
#undef PG8_AROWS
#undef PG8_LANE
#undef PG8_SA
#undef PG8_SB
#undef PG8_STG
#undef PG8_LDA
#undef PG8_LDB
#undef PG8_MMA
#undef PG8_WAIT_V
#undef PG8_WAIT_L
#undef PG8_BAR
#undef PG8_SCHED
}
}

namespace att {
constexpr float SCALE = 0.088388347648318440f;
constexpr float THR = 8.f;
constexpr int KVBLK = 64, QBLK = 32;
constexpr size_t SHM_V = KVBLK * HD * 2, SHM_K = KVBLK * HD * 2;
constexpr int NRING = 2;
constexpr int OFF_V = 0, OFF_K = NRING * SHM_V, OFF_WS = OFF_K + NRING * SHM_K, OFF_KM = OFF_WS + NWAVES * 64 * 4, ATT_LDS = OFF_KM + 32 * 256;
#define KSWZ(row, colB) ((row) * 256 + ((colB) ^ (((row) & 7) << 4)))
#define SBAR() __builtin_amdgcn_sched_barrier(0)
__device__ __forceinline__ int crow(int r, int hi) { return (r & 3) + 8 * (r >> 2) + 4 * hi; }

__device__ __forceinline__ void partialSM(f32x16& p0, f32x16& p1, float& m_reg, float& mn, float& alpha, float slr, float lb, int mode, int thr) {
    constexpr float C = SCALE * 1.4426950408889634f;
#pragma unroll
    for (int r = 0; r < 16; ++r) { const float cr = (float)((r & 3) + 8 * (r >> 2)); p0[r] = fmaf(slr, cr, p0[r]); p1[r] = fmaf(slr, cr + 32.f, p1[r]); }
    if (mode) {
        if (mode == 1) {
#pragma unroll
            for (int r = 0; r < 16; ++r) { if ((r & 3) + 8 * (r >> 2) > thr) p0[r] = -3.0e38f; p1[r] = -3.0e38f; }
        } else {
#pragma unroll
            for (int r = 0; r < 16; ++r) { if ((r & 3) + 8 * (r >> 2) > thr) p1[r] = -3.0e38f; }
        }
    }
    float pmax = p0[0];
#pragma unroll
    for (int r = 1; r < 16; ++r) pmax = fmaxf(pmax, p0[r]);
#pragma unroll
    for (int r = 0; r < 16; ++r) pmax = fmaxf(pmax, p1[r]);
    pmax += lb;
    { auto rr = __builtin_amdgcn_permlane32_swap(__float_as_uint(pmax), __float_as_uint(pmax), false, false);
      pmax = fmaxf(__uint_as_float(rr[0]), __uint_as_float(rr[1])); }
    if (__builtin_expect(__all(pmax - m_reg <= THR / SCALE), 1)) { mn = m_reg; alpha = 1.f; }
    else { mn = fmaxf(m_reg, pmax); alpha = __builtin_amdgcn_exp2f((m_reg - mn) * C); m_reg = mn; }
    const float mnC = (lb - mn) * C;
#pragma unroll
    for (int r = 0; r < 16; ++r) p0[r] = fmaf(p0[r], C, mnC);
#pragma unroll
    for (int r = 0; r < 16; ++r) p1[r] = fmaf(p1[r], C, mnC);
#pragma unroll
    for (int r = 0; r < 16; ++r) p0[r] = __builtin_amdgcn_exp2f(p0[r]);
}
__device__ __forceinline__ void finishSM(f32x16& p0, f32x16& p1, float alpha, float& l_reg, bf16x8& pa0, bf16x8& pa1, bf16x8& pa2, bf16x8& pa3) {
#pragma unroll
    for (int r = 0; r < 16; ++r) p1[r] = __builtin_amdgcn_exp2f(p1[r]);
    float ps = 0;
#pragma unroll
    for (int r = 0; r < 16; ++r) ps += p0[r];
#pragma unroll
    for (int r = 0; r < 16; ++r) ps += p1[r];
    { auto rr = __builtin_amdgcn_permlane32_swap(__float_as_uint(ps), __float_as_uint(ps), false, false);
      ps = __uint_as_float(rr[0]) + __uint_as_float(rr[1]); }
    l_reg = l_reg * alpha + ps;
#define PK4(P, BASE, OUT) do { unsigned a0 = cvt_pk_bf16(P[BASE + 0], P[BASE + 1]), a1 = cvt_pk_bf16(P[BASE + 2], P[BASE + 3]);   \
    unsigned b0 = cvt_pk_bf16(P[BASE + 4], P[BASE + 5]), b1 = cvt_pk_bf16(P[BASE + 6], P[BASE + 7]);                              \
    auto r0 = __builtin_amdgcn_permlane32_swap(a0, b0, false, false); auto r1 = __builtin_amdgcn_permlane32_swap(a1, b1, false, false); \
    u32x4 w = {r0[0], r1[0], r0[1], r1[1]}; OUT = *reinterpret_cast<bf16x8*>(&w); } while (0)
    PK4(p0, 0, pa0); PK4(p0, 8, pa1); PK4(p1, 0, pa2); PK4(p1, 8, pa3);
#undef PK4
}
__device__ __forceinline__ void qkt(f32x16& p0, f32x16& p1, const char* Ks, const bf16x8* qr, int r32, int hi) {
    p0 = f32x16{}; p1 = f32x16{};
    int lowb = (hi * 16) ^ ((r32 & 7) << 4);
    asm volatile("" : "+v"(lowb));
    const char* Kr = Ks + r32 * 256;
#pragma unroll
    for (int d0 = 0; d0 < 8; ++d0) { const int cb = (d0 * 32) ^ lowb;
        const bf16x8 b0 = *reinterpret_cast<const bf16x8*>(Kr + cb);
        const bf16x8 b1 = *reinterpret_cast<const bf16x8*>(Kr + 32 * 256 + cb);
        p0 = __builtin_amdgcn_mfma_f32_32x32x16_bf16(b0, qr[d0], p0, 0, 0, 0);
        p1 = __builtin_amdgcn_mfma_f32_32x32x16_bf16(b1, qr[d0], p1, 0, 0, 0); }
}
__device__ __forceinline__ int v_st(int k, int c) { const int kk = (k & ~0xC) | ((k & 4) << 1) | ((k & 8) >> 1); return ((kk >> 3) * 4 + (c >> 5)) * 512 + ((kk & 7) * 32 + (c & 31)) * 2; }
__device__ __forceinline__ int v_rd_base(int lane) { return ((lane & 3) << 3) | (((lane >> 2) & 3) << 6) | (((lane >> 4) & 1) << 5) | (((lane >> 5) & 1) << 8); }
constexpr int v_rd_off(int d0, int ks, int half) { return d0 * 512 + ks * 4096 + half * 2048; }
template <int OFF> __device__ __forceinline__ s16x4 tr_read(int vb) {
    s16x4 r; asm volatile("ds_read_b64_tr_b16 %0, %1 offset:%2" : "=&v"(r) : "v"(vb), "i"(OFF) : "memory"); return r;
}
template <int D0> __device__ __forceinline__ void pv_one(f32x16& od, int vb, bf16x8 pa0, bf16x8 pa1, bf16x8 pa2, bf16x8 pa3) {
    const s16x4 l0 = tr_read<v_rd_off(D0, 0, 0)>(vb), h0 = tr_read<v_rd_off(D0, 0, 1)>(vb), l1 = tr_read<v_rd_off(D0, 1, 0)>(vb), h1 = tr_read<v_rd_off(D0, 1, 1)>(vb);
    const s16x4 l2 = tr_read<v_rd_off(D0, 2, 0)>(vb), h2 = tr_read<v_rd_off(D0, 2, 1)>(vb), l3 = tr_read<v_rd_off(D0, 3, 0)>(vb), h3 = tr_read<v_rd_off(D0, 3, 1)>(vb);
    asm volatile("s_waitcnt lgkmcnt(0)" ::: "memory"); SBAR();
#define PK(L, H) (bf16x8){L[0], L[1], L[2], L[3], H[0], H[1], H[2], H[3]}
    od = __builtin_amdgcn_mfma_f32_32x32x16_bf16(pa0, PK(l0, h0), od, 0, 0, 0);
    od = __builtin_amdgcn_mfma_f32_32x32x16_bf16(pa1, PK(l1, h1), od, 0, 0, 0);
    od = __builtin_amdgcn_mfma_f32_32x32x16_bf16(pa2, PK(l2, h2), od, 0, 0, 0);
    od = __builtin_amdgcn_mfma_f32_32x32x16_bf16(pa3, PK(l3, h3), od, 0, 0, 0);
#undef PK
}
__device__ __forceinline__ void pv_d0(f32x16* o, int vb, bf16x8 pa0, bf16x8 pa1, bf16x8 pa2, bf16x8 pa3) {
    pv_one<0>(o[0], vb, pa0, pa1, pa2, pa3); pv_one<1>(o[1], vb, pa0, pa1, pa2, pa3); pv_one<2>(o[2], vb, pa0, pa1, pa2, pa3); pv_one<3>(o[3], vb, pa0, pa1, pa2, pa3);
}

constexpr int MAXP = 8;
struct ItemTable { unsigned short v[64][MAXP]; };
constexpr int head_cap(int h) { return h == 0 ? 1 : h == 1 ? 2 : h == 2 ? 3 : h == 3 ? 5 : h == 4 ? 10 : 16; }
constexpr ItemTable make_items() {
    ItemTable t{};
    for (int i = 0; i < 64; ++i) for (int j = 0; j < MAXP; ++j) t.v[i][j] = 0xFFFF;
    const int kh[8] = {3, 4, 5, 7, 10, 12, 12, 11};
    int bin0 = 0;
    for (int h = 0; h < 8; ++h) { const int k = kh[h];
        unsigned short code[32] = {}; int cost[32] = {}; int n = 0;
        for (int qb = 0; qb < 16; ++qb) { const int npast = qb < head_cap(h) ? qb : head_cap(h); const bool split = (h >= 5 && qb >= 12);
            if (split) { code[n] = (unsigned short)(h | (qb << 3) | (0 << 7) | (1 << 8)); cost[n] = 8; ++n; code[n] = (unsigned short)(h | (qb << 3) | (1 << 7) | (1 << 8)); cost[n] = npast - 7; ++n; }
            else { code[n] = (unsigned short)(h | (qb << 3)); cost[n] = 1 + npast; ++n; } }
        for (int i = 1; i < n; ++i) { const unsigned short xv = code[i]; const int c = cost[i]; int j = i - 1;
            while (j >= 0 && cost[j] < c) { code[j + 1] = code[j]; cost[j + 1] = cost[j]; --j; }
            code[j + 1] = xv; cost[j + 1] = c; }
        int load[16] = {}; int cnt[16] = {};
        for (int i = 0; i < n; ++i) { int best = 0; for (int j = 1; j < k; ++j) if (load[j] < load[best]) best = j;
            if (cnt[best] < MAXP) { t.v[bin0 + best][cnt[best]] = code[i]; ++cnt[best]; load[best] += cost[i] + 1; } }
        bin0 += k; }
    return t;
}
__device__ const ItemTable ATT_ITEMS = make_items();
constexpr float CUT_MARGIN = 40.f;

__device__ __forceinline__ void attn_item(const int tid, const int b, const int h, const int qb, const bool with_own, const int n_lo, const int n_hi, const int mode,
                                          const int slot, const int l, unsigned char* __restrict__ wsb, char* lds) {
    const bf16_t* __restrict__ U = (const bf16_t*)(wsb + WS_U); const float* __restrict__ ksum = (const float*)(wsb + WS_KS); bf16_t* __restrict__ Y = (bf16_t*)(wsb + WS_Y);
    float* __restrict__ part = (float*)(wsb + WS_PART) + (size_t)slot * 66 * 512; int* __restrict__ tick = (int*)(wsb + WS_CTL) + 12544 + 128 * l + 2 * slot;
    const int wid = tid >> 6, lane = tid & 63, r32 = lane & 31, hi = lane >> 5;
    char* V_lds = lds + OFF_V; char* K_lds = lds + OFF_K; char* KM = lds + OFF_KM;
    float* ws = (float*)(lds + OFF_WS) + wid * 64; float* li_l = ws; float* al_l = ws + 32;
    const bf16_t* Qb = U + (size_t)(b * SEQ + qb * 256) * UP + COL_Q + h * HD;
    float m_reg = -1e29f, l_reg = 0; f32x16 o[4] = {}; bf16x8 qr[8];
    { const bf16_t* Qw = Qb + (size_t)(wid * QBLK + r32) * UP + hi * 8;
#pragma unroll
      for (int d0 = 0; d0 < 8; ++d0) qr[d0] = *reinterpret_cast<const bf16x8*>(Qw + d0 * 16); }
    { const int n = tid >> 5, c4 = (tid & 31) * 4;
      const float* k0p = ksum + (size_t)((b * 16 + n) * 2) * 1024 + h * HD + c4;
      const f32x4 s0 = *(const f32x4*)k0p, s1 = *(const f32x4*)(k0p + 1024);
      u32x2 w; w.x = cvt_pk_bf16((s0[0] + s1[0]) * (1.f / 256.f), (s0[1] + s1[1]) * (1.f / 256.f)); w.y = cvt_pk_bf16((s0[2] + s1[2]) * (1.f / 256.f), (s0[3] + s1[3]) * (1.f / 256.f));
      *(u32x2*)(KM + KSWZ(n, c4 * 2)) = w;
      *(u32x2*)(KM + KSWZ(16 + n, c4 * 2)) = (u32x2){0u, 0u}; }
    __syncthreads();
    unsigned selmask = 0u;
    { f32x16 g = f32x16{};
#pragma unroll
      for (int d0 = 0; d0 < 8; ++d0) { const int cb = (d0 * 16 + hi * 8) * 2; const bf16x8 a = *reinterpret_cast<const bf16x8*>(KM + KSWZ(r32, cb)); g = __builtin_amdgcn_mfma_f32_32x32x16_bf16(a, qr[d0], g, 0, 0, 0); }
      float G[16];
#pragma unroll
      for (int r = 0; r < 8; ++r) { auto rr = __builtin_amdgcn_permlane32_swap(__float_as_uint(g[r]), __float_as_uint(g[r]), false, false);
          const float other = hi ? __uint_as_float(rr[0]) : __uint_as_float(rr[1]);
          const int nlo = (r & 3) + 8 * (r >> 2);
          G[nlo] = hi ? other : g[r]; G[nlo + 4] = hi ? g[r] : other; }
#pragma unroll
      for (int n = 0; n < 16; ++n) if (n >= qb) G[n] = -INFINITY;
      const int npick = qb < 3 ? qb : 3;
#pragma unroll
      for (int it = 0; it < 3; ++it) { if (it < npick) { float best = G[0]; int bi = 0;
#pragma unroll
          for (int n = 1; n < 16; ++n) if (G[n] > best) { best = G[n]; bi = n; }
          selmask |= 1u << bi;
#pragma unroll
          for (int n = 0; n < 16; ++n) if (n == bi) G[n] = -INFINITY; } } }
    const float slr = __uint_as_float(__builtin_amdgcn_readfirstlane(__float_as_uint(__builtin_amdgcn_exp2f(-(float)(h + 1)) * (1.f / SCALE))));
    const int tp4 = qb * 256 + wid * QBLK + r32 - 4 * hi;
    const int jo = with_own ? 4 : 0;
    const int NT = jo + 4 * (n_hi - n_lo);
    const int kb_own = qb * 256, kb_past = n_lo * 256 - 64 * jo;
#define KST(j) (((j) < jo ? kb_own : kb_past) + 64 * (j))
#define LBV(j) ((((j) < jo) ? ((j) > (wid >> 1)) : !((selmask >> (n_lo + (((j) - jo) >> 2))) & 1u)) ? -1e30f : slr * (float)(KST(j) - tp4))
    const int vb0 = (int)(uintptr_t)V_lds + v_rd_base(lane);
    unsigned koff, voff;
    { const int row = 4 * wid + (lane >> 4), cc = lane & 15; koff = (unsigned)(row * UP * 2 + ((cc ^ (row & 7)) << 4)) + (unsigned)(COL_K * 2); }
    { const int st = 2 * wid + (lane >> 5), kk = (st >> 2) * 8 + ((lane & 31) >> 2), k = (kk & ~0xC) | ((kk & 4) << 1) | ((kk & 8) >> 1), col = 32 * (st & 3) + 8 * (lane & 3);
      voff = (unsigned)(k * UP * 2 + col * 2) + (unsigned)(COL_V * 2); }
    const int wq = __builtin_amdgcn_readfirstlane(wid);
    LAS unsigned char* ldsL = (LAS unsigned char*)(unsigned)(uintptr_t)lds;
    const char* Ubh = (const char*)(U + (size_t)(b * SEQ) * UP + h * HD);
#define DMAK(bb, k0) do { const unsigned uo_ = (unsigned)((k0) * (UP * 2)); \
    __builtin_amdgcn_global_load_lds((const unsigned*)(Ubh + (koff + uo_)), (LAS unsigned*)(ldsL + OFF_K + (bb) * SHM_K + wq * 1024), 16, 0, 0); \
    __builtin_amdgcn_global_load_lds((const unsigned*)(Ubh + (koff + uo_ + 32u * UP * 2u)), (LAS unsigned*)(ldsL + OFF_K + (bb) * SHM_K + (wq + 8) * 1024), 16, 0, 0); } while (0)
#define DMAV(bb, k0) do { const unsigned uo_ = (unsigned)((k0) * (UP * 2)); \
    __builtin_amdgcn_global_load_lds((const unsigned*)(Ubh + (voff + uo_)), (LAS unsigned*)(ldsL + OFF_V + (bb) * SHM_V + wq * 1024), 16, 0, 0); \
    __builtin_amdgcn_global_load_lds((const unsigned*)(Ubh + (voff + uo_ + 32u * UP * 2u)), (LAS unsigned*)(ldsL + OFF_V + (bb) * SHM_V + (wq + 8) * 1024), 16, 0, 0); } while (0)
#define RESC(a) do { if (__any((a) < 1.f)) { if (hi == 0) al_l[r32] = (a); asm volatile("s_waitcnt lgkmcnt(0)" ::: "memory"); \
    _Pragma("unroll") for (int d = 0; d < 4; ++d) _Pragma("unroll") for (int r = 0; r < 16; ++r) o[d][r] *= al_l[crow(r, hi)]; } } while (0)
    if (NT > 0) {
    f32x16 pA0, pA1, pB0, pB1; float mnA, mnB, alA, alB; bf16x8 pa0, pa1, pa2, pa3;
#define PSM(P0, P1, MN, AL, j) partialSM(P0, P1, m_reg, MN, AL, slr, LBV(j), ((j) < jo && (j) == (wid >> 1)) ? 1 + (wid & 1) : 0, r32 - 4 * hi)
#define WBAR(N) asm volatile("s_waitcnt vmcnt(" #N ") lgkmcnt(0)\n\ts_barrier" ::: "memory")
#define STEP(PC0, PC1, MNC, ALC, PP0, PP1, ALP, j, sl) do { \
        DMAV(sl, KST(j)); \
        SBAR(); qkt(PC0, PC1, K_lds + (sl) * SHM_K, qr, r32, hi); \
        finishSM(PP0, PP1, ALP, l_reg, pa0, pa1, pa2, pa3); SBAR(); \
        WBAR(4); \
        if ((j) + 2 < NT) DMAK(sl, KST((j) + 2)); \
        pv_d0(o, vb0 + (1 - (sl)) * (int)SHM_V, pa0, pa1, pa2, pa3); PSM(PC0, PC1, MNC, ALC, j); \
        if ((j) + 2 < NT) WBAR(4); else WBAR(0); RESC(ALC); } while (0)
    DMAK(0, KST(0)); DMAK(1, KST(1)); DMAV(0, KST(0)); WBAR(4);
    qkt(pA0, pA1, K_lds, qr, r32, hi);
    WBAR(4);
    DMAK(0, KST(2)); PSM(pA0, pA1, mnA, alA, 0);
    WBAR(4); RESC(alA);
    for (int j = 1; j + 1 < NT; j += 2) {
        STEP(pB0, pB1, mnB, alB, pA0, pA1, alA, j, 1);
        STEP(pA0, pA1, mnA, alA, pB0, pB1, alB, j + 1, 0);
    }
    STEP(pB0, pB1, mnB, alB, pA0, pA1, alA, NT - 1, 1);
    finishSM(pB0, pB1, alB, l_reg, pa0, pa1, pa2, pa3); SBAR();
    pv_d0(o, vb0 + (int)SHM_V, pa0, pa1, pa2, pa3);
#undef STEP
#undef WBAR
#undef PSM
    }
    bool write_out = true;
    if (mode == 1) {
        __syncthreads();
        int* tk = (int*)(lds + OFF_WS + NWAVES * 64 * 4 - 16);
        if (tid == 0) tk[0] = __hip_atomic_fetch_add(tick, 1, __ATOMIC_RELAXED, __HIP_MEMORY_SCOPE_AGENT);
        __syncthreads();
        const int t = __builtin_amdgcn_readfirstlane(tk[0]);
        __syncthreads();
        if (t == 0) {
#pragma unroll
            for (int d = 0; d < 4; ++d)
#pragma unroll
                for (int r = 0; r < 16; ++r) __hip_atomic_store(part + (size_t)(d * 16 + r) * 512 + tid, o[d][r], __ATOMIC_RELAXED, __HIP_MEMORY_SCOPE_AGENT);
            __hip_atomic_store(part + (size_t)64 * 512 + tid, m_reg, __ATOMIC_RELAXED, __HIP_MEMORY_SCOPE_AGENT);
            __hip_atomic_store(part + (size_t)65 * 512 + tid, l_reg, __ATOMIC_RELAXED, __HIP_MEMORY_SCOPE_AGENT);
            asm volatile("s_waitcnt vmcnt(0)" ::: "memory");
            __syncthreads();
            if (tid == 0) __hip_atomic_store(tick + 1, 1, __ATOMIC_RELAXED, __HIP_MEMORY_SCOPE_AGENT);
            write_out = false;
        } else {
            if (tid < 64) { unsigned sp = 0;
                while (__builtin_amdgcn_readfirstlane(__hip_atomic_load(tick + 1, __ATOMIC_RELAXED, __HIP_MEMORY_SCOPE_AGENT)) == 0) { __builtin_amdgcn_s_sleep(2); if (++sp > (1u << 22)) break; }
                __builtin_amdgcn_fence(__ATOMIC_ACQUIRE, "agent");
                asm volatile("s_waitcnt vmcnt(0)" ::: "memory"); }
            __syncthreads();
            constexpr float C = SCALE * 1.4426950408889634f;
            const float m2 = part[(size_t)64 * 512 + tid], l2 = part[(size_t)65 * 512 + tid];
            const float mn = fmaxf(m_reg, m2), a1 = __builtin_amdgcn_exp2f((m_reg - mn) * C), a2 = __builtin_amdgcn_exp2f((m2 - mn) * C);
            { float t1 = l_reg * a1, t2 = l2 * a2; asm volatile("" : "+v"(t1), "+v"(t2)); l_reg = t1 + t2; }
            if (hi == 0) { al_l[r32] = a1; li_l[r32] = a2; }
            asm volatile("s_waitcnt lgkmcnt(0)" ::: "memory");
#pragma unroll
            for (int d = 0; d < 4; ++d)
#pragma unroll
                for (int r = 0; r < 16; ++r) { float t1 = o[d][r] * al_l[crow(r, hi)], t2 = part[(size_t)(d * 16 + r) * 512 + tid] * li_l[crow(r, hi)]; asm volatile("" : "+v"(t1), "+v"(t2)); o[d][r] = t1 + t2; }
            asm volatile("s_waitcnt lgkmcnt(0)" ::: "memory");
        }
    }
    if (write_out) {
    if (hi == 0) li_l[r32] = l_reg; asm volatile("s_waitcnt lgkmcnt(0)" ::: "memory");
    float rli[16];
#pragma unroll
    for (int r = 0; r < 16; ++r) rli[r] = __builtin_amdgcn_rcpf(li_l[crow(r, hi)]);
    bf16_t* Ow = Y + (size_t)(b * SEQ + qb * 256 + wid * QBLK) * DM + 512 + h * HD;
#pragma unroll
    for (int r = 0; r < 16; ++r) { const int orow = crow(r, hi);
#pragma unroll
        for (int d0 = 0; d0 < 4; ++d0) { const float v = o[d0][r] * rli[r]; Ow[(size_t)orow * DM + d0 * 32 + r32] = (bf16_t)(cvt_pk_bf16(v, v) & 0xffffu); } }
    }
    __syncthreads();
#undef KST
#undef LBV
#undef DMAK
#undef DMAV
#undef RESC
}
#undef KSWZ
#undef SBAR
}


#define XB_TMO      128
#define XB_XCNT(j)  (256  + 64 * (j))
#define XB_XSUB(j)  (1280 + 64 * (j))
#define XB_XGEN(j)  (2304 + 64 * (j))
#define XB_TOP      3328
#define XB_TOPGEN   3392
#define XCD_BAR_WORDS 3456
#define XB_SPIN_CAP (1u << 18)
__device__ __forceinline__ unsigned xb_ld(unsigned* p)              { return __hip_atomic_load(p, __ATOMIC_RELAXED, __HIP_MEMORY_SCOPE_AGENT); }
__device__ __forceinline__ unsigned xb_add(unsigned* p, unsigned v) { return __hip_atomic_fetch_add(p, v, __ATOMIC_RELAXED, __HIP_MEMORY_SCOPE_AGENT); }
__device__ __forceinline__ unsigned xb_xcc_id() { return (unsigned)__builtin_amdgcn_s_getreg((3 << 11) | 20) & 0xFu; }
#define XB_SPIN(cond, bar) do { unsigned _sp = 0; while (cond) { __builtin_amdgcn_s_sleep(1); \
    if ((++_sp & 255u) == 0u) { if (xb_ld(&(bar)[XB_TMO])) break; if (_sp > XB_SPIN_CAP) { atomicAdd(&(bar)[XB_TMO], 1u); break; } } } } while (0)
struct XcdBarrier { unsigned* bar; unsigned x; volatile LAS unsigned* st; };
__device__ __forceinline__ XcdBarrier xcd_barrier_post(unsigned* bar, volatile LAS unsigned* st) {
    XcdBarrier b; b.bar = bar; b.x = xb_xcc_id(); b.st = st;
    if (threadIdx.x == 0) (void)xb_add(&bar[XB_XCNT(b.x)], 1u);
    return b;
}
__device__ __forceinline__ void xcd_barrier_complete(unsigned* bar, unsigned x, unsigned& nloc, unsigned& nx) {
    const unsigned G = gridDim.x * gridDim.y * gridDim.z;
    unsigned sum, cnt, mine, sp = 0u;
    for (;;) {
        sum = 0u; cnt = 0u;
#pragma unroll 1
        for (unsigned j = 0; j < 16; ++j) { const unsigned c = xb_ld(&bar[XB_XCNT(j)]); sum += c; cnt += (c > 0u) ? 1u : 0u; }
        mine = xb_ld(&bar[XB_XCNT(x)]);
        if (sum == G) break;
        __builtin_amdgcn_s_sleep(1);
        if ((++sp & 255u) == 0u) { if (xb_ld(&bar[XB_TMO])) break; if (sp > XB_SPIN_CAP) { atomicAdd(&bar[XB_TMO], 1u); break; } }
    }
    nloc = mine > 0u ? mine : 1u; nx = cnt > 0u ? cnt : 1u;
}
__device__ __forceinline__ void xcd_barrier(const XcdBarrier& b) {
    asm volatile("s_waitcnt vmcnt(0)" ::: "memory");
    __syncthreads();
    if (threadIdx.x == 0) {
        unsigned* bar = b.bar; asm volatile("" : "+s"(bar));
        __builtin_amdgcn_s_waitcnt(0);
        unsigned nloc = b.st[0], nx = b.st[1];
        if (nloc == 0u) { xcd_barrier_complete(bar, b.x, nloc, nx); b.st[0] = nloc; b.st[1] = nx; }
        const unsigned old = xb_add(&bar[XB_XSUB(b.x)], 1u);
        const unsigned gen = old / nloc;
        if (old + 1u == (gen + 1u) * nloc) {
            __builtin_amdgcn_fence(__ATOMIC_RELEASE, "agent");
            asm volatile("s_waitcnt vmcnt(0)" ::: "memory");
            const unsigned og = xb_add(&bar[XB_TOP], 1u);
            const unsigned tg = og / nx;
            if (og + 1u == (tg + 1u) * nx) xb_add(&bar[XB_TOPGEN], 1u);
            else XB_SPIN(xb_ld(&bar[XB_TOPGEN]) == tg, bar);
            __builtin_amdgcn_fence(__ATOMIC_ACQUIRE, "agent");
            xb_add(&bar[XB_XGEN(b.x)], 1u);
            asm volatile("s_waitcnt vmcnt(0)" ::: "memory");
        } else {
            XB_SPIN(xb_ld(&bar[XB_XGEN(b.x)]) == gen, bar);
            __builtin_amdgcn_fence(__ATOMIC_ACQUIRE, "agent");
            asm volatile("s_waitcnt vmcnt(0)" ::: "memory");
        }
    }
    __syncthreads();
}

struct Params { const float* in[18]; float* out; unsigned char* ws; int ph_lo, ph_hi; };
enum { IN_X = 0, IN_N1G, IN_WIN, IN_CAW, IN_CCW, IN_CCB, IN_LNG, IN_LNB, IN_WOUT, IN_N2G, IN_RGW, IN_RGB, IN_REW, IN_REB, IN_WG, IN_WU, IN_WD, IN_FG };

__device__ __forceinline__ void transpose_item(const float* __restrict__ W, int K, int N, bf16_t* __restrict__ WT, size_t dstb, int rmul, int radd, const float* __restrict__ scale,
                                               LAS float* scr, int item, int lane) {
    const int nkb = K / 64, nnb = N / 64, per = nkb * nnb, bt = item / per, rem = item - bt * per, kb = rem / nnb, nb = rem - kb * nnb, k0 = kb * 64, n0 = nb * 64;
    const float* src = W + (size_t)bt * K * N;
    bf16_t* dst = WT + (size_t)bt * dstb;
#pragma unroll 4
    for (int i = 0; i < 16; ++i) { const int k = 4 * i + (lane >> 4), n4 = (lane & 15) * 4; const f32x4 v = __builtin_nontemporal_load((const f32x4*)(src + (size_t)(k0 + k) * N + n0 + n4));
        LAS float* s = scr + k * 65 + n4; s[0] = v[0]; s[1] = v[1]; s[2] = v[2]; s[3] = v[3]; }
    asm volatile("s_waitcnt lgkmcnt(0)" ::: "memory");
    const int c = lane & 7, nn = lane >> 3;
    float sc8[8];
#pragma unroll
    for (int i = 0; i < 8; ++i) sc8[i] = scale ? scale[k0 + 8 * c + i] : 1.f;
#pragma unroll
    for (int j = 0; j < 8; ++j) { const int n = nn + 8 * j; const LAS float* s = scr + (8 * c) * 65 + n;
        u32x4 o; o.x = cvt_pk_bf16(s[0] * sc8[0], s[65] * sc8[1]); o.y = cvt_pk_bf16(s[130] * sc8[2], s[195] * sc8[3]); o.z = cvt_pk_bf16(s[260] * sc8[4], s[325] * sc8[5]); o.w = cvt_pk_bf16(s[390] * sc8[6], s[455] * sc8[7]);
        __builtin_nontemporal_store(o, (u32x4*)(dst + (size_t)((n0 + n) * rmul + radd) * K + k0 + 8 * c)); }
    asm volatile("s_waitcnt lgkmcnt(0)" ::: "memory");
}

__device__ __forceinline__ void transpose_item8(const float* __restrict__ W, int K, int N, unsigned char* __restrict__ WT, size_t dstb, int rmul, int radd, const float* __restrict__ scale, float mult,
                                                LAS float* scr, int item, int lane) {
    const int nkb = K / 64, nnb = N / 64, per = nkb * nnb, bt = item / per, rem = item - bt * per, kb = rem / nnb, nb = rem - kb * nnb, k0 = kb * 64, n0 = nb * 64;
    const float* src = W + (size_t)bt * K * N;
    unsigned char* dst = WT + (size_t)bt * dstb;
#pragma unroll 4
    for (int i = 0; i < 16; ++i) { const int k = 4 * i + (lane >> 4), n4 = (lane & 15) * 4; const f32x4 v = __builtin_nontemporal_load((const f32x4*)(src + (size_t)(k0 + k) * N + n0 + n4));
        LAS float* s = scr + k * 65 + n4; s[0] = v[0]; s[1] = v[1]; s[2] = v[2]; s[3] = v[3]; }
    asm volatile("s_waitcnt lgkmcnt(0)" ::: "memory");
    const int c = lane & 7, nn = lane >> 3;
    float sc8[8];
#pragma unroll
    for (int i = 0; i < 8; ++i) sc8[i] = (scale ? scale[k0 + 8 * c + i] : 1.f) * mult;
#pragma unroll
    for (int j = 0; j < 8; ++j) { const int n = nn + 8 * j; const LAS float* s = scr + (8 * c) * 65 + n;
        float v[8];
#pragma unroll
        for (int i = 0; i < 8; ++i) v[i] = __builtin_amdgcn_fmed3f(s[65 * i] * sc8[i], -400.f, 400.f);
        int w0 = 0, w1 = 0;
        w0 = __builtin_amdgcn_cvt_pk_fp8_f32(v[0], v[1], w0, false); w0 = __builtin_amdgcn_cvt_pk_fp8_f32(v[2], v[3], w0, true);
        w1 = __builtin_amdgcn_cvt_pk_fp8_f32(v[4], v[5], w1, false); w1 = __builtin_amdgcn_cvt_pk_fp8_f32(v[6], v[7], w1, true);
        __builtin_nontemporal_store((u32x2){(unsigned)w0, (unsigned)w1}, (u32x2*)(dst + (size_t)((n0 + n) * rmul + radd) * K + k0 + 8 * c)); }
    asm volatile("s_waitcnt lgkmcnt(0)" ::: "memory");
}

__device__ __forceinline__ void norm_row_f32(const float* __restrict__ xrow, bf16_t* __restrict__ xout, float* __restrict__ rsout, int lane) {
    f32x4 v[8]; float ss = 0.f;
#pragma unroll
    for (int j = 0; j < 8; ++j) { v[j] = __builtin_nontemporal_load((const f32x4*)xrow + 64 * j + lane); ss += (v[j][0] * v[j][0] + v[j][1] * v[j][1]) + (v[j][2] * v[j][2] + v[j][3] * v[j][3]); }
    const float rs = 1.0f / sqrtf(wave_sum(ss) * (1.f / DM) + EPS);
    if (lane == 0) *rsout = rs;
#pragma unroll
    for (int j = 0; j < 8; ++j) { u32x2 w; w.x = cvt_pk_bf16(v[j][0], v[j][1]); w.y = cvt_pk_bf16(v[j][2], v[j][3]); *((u32x2*)xout + 64 * j + lane) = w; }
}
struct RowRegs { u32x4 x[4]; u32x2 a[4], c[4]; };
__device__ __forceinline__ void combine_load(RowRegs& R, const bf16_t* __restrict__ xrow, const unsigned char* __restrict__ y0, const unsigned char* __restrict__ y1, int lane) {
#pragma unroll
    for (int j = 0; j < 4; ++j) { R.x[j] = *((const u32x4*)xrow + 64 * j + lane); R.a[j] = __builtin_nontemporal_load((const u32x2*)y0 + 64 * j + lane); R.c[j] = __builtin_nontemporal_load((const u32x2*)y1 + 64 * j + lane); }
}
__device__ __forceinline__ void combine_finish(const RowRegs& R, bf16_t* __restrict__ xrow, float g0, float g1, float* __restrict__ rsout, float* __restrict__ fout, const float* __restrict__ fgain, int lane) {
    float v[4][8]; float ss = 0.f;
    g0 *= (1.f / pg8::YM_SCALE); g1 *= (1.f / pg8::YM_SCALE);
#pragma unroll
    for (int j = 0; j < 4; ++j) { const u32x4 x = R.x[j];
        const f32x2 a0 = __builtin_amdgcn_cvt_pk_f32_fp8((int)R.a[j].x, false), a1 = __builtin_amdgcn_cvt_pk_f32_fp8((int)R.a[j].x, true), a2 = __builtin_amdgcn_cvt_pk_f32_fp8((int)R.a[j].y, false), a3 = __builtin_amdgcn_cvt_pk_f32_fp8((int)R.a[j].y, true);
        const f32x2 c0 = __builtin_amdgcn_cvt_pk_f32_fp8((int)R.c[j].x, false), c1 = __builtin_amdgcn_cvt_pk_f32_fp8((int)R.c[j].x, true), c2 = __builtin_amdgcn_cvt_pk_f32_fp8((int)R.c[j].y, false), c3 = __builtin_amdgcn_cvt_pk_f32_fp8((int)R.c[j].y, true);
        v[j][0] = bf_lo(x.x) + g0 * a0[0] + g1 * c0[0]; v[j][1] = bf_hi(x.x) + g0 * a0[1] + g1 * c0[1];
        v[j][2] = bf_lo(x.y) + g0 * a1[0] + g1 * c1[0]; v[j][3] = bf_hi(x.y) + g0 * a1[1] + g1 * c1[1];
        v[j][4] = bf_lo(x.z) + g0 * a2[0] + g1 * c2[0]; v[j][5] = bf_hi(x.z) + g0 * a2[1] + g1 * c2[1];
        v[j][6] = bf_lo(x.w) + g0 * a3[0] + g1 * c3[0]; v[j][7] = bf_hi(x.w) + g0 * a3[1] + g1 * c3[1];
#pragma unroll
        for (int i = 0; i < 8; ++i) ss += v[j][i] * v[j][i]; }
    const float rs = 1.0f / sqrtf(wave_sum(ss) * (1.f / DM) + EPS);
#pragma unroll
    for (int j = 0; j < 4; ++j) {
        if (fout) { const f32x4 ga = *((const f32x4*)fgain + 128 * j + 2 * lane), gb = *((const f32x4*)fgain + 128 * j + 2 * lane + 1);
            __builtin_nontemporal_store((f32x4){v[j][0] * rs * ga[0], v[j][1] * rs * ga[1], v[j][2] * rs * ga[2], v[j][3] * rs * ga[3]}, (f32x4*)fout + 128 * j + 2 * lane);
            __builtin_nontemporal_store((f32x4){v[j][4] * rs * gb[0], v[j][5] * rs * gb[1], v[j][6] * rs * gb[2], v[j][7] * rs * gb[3]}, (f32x4*)fout + 128 * j + 2 * lane + 1); }
        else { u32x4 w; w.x = cvt_pk_bf16(v[j][0], v[j][1]); w.y = cvt_pk_bf16(v[j][2], v[j][3]); w.z = cvt_pk_bf16(v[j][4], v[j][5]); w.w = cvt_pk_bf16(v[j][6], v[j][7]);
            *((u32x4*)xrow + 64 * j + lane) = w; } }
    if (!fout && lane == 0) *rsout = rs;
}

__global__ void __launch_bounds__(NTHREADS, 2) fwd_kernel(Params p) {
    extern __shared__ __attribute__((aligned(16))) unsigned char lds_raw[];
    LAS unsigned char* lds = (LAS unsigned char*)lds_raw;
    cg::grid_group grid = cg::this_grid();
    const int G = gridDim.x, bx = blockIdx.x;
    const int lo = p.ph_lo, hi = p.ph_hi;
    int ph = 0;
    const int wave_s = __builtin_amdgcn_readfirstlane((int)threadIdx.x >> 6);
    volatile LAS unsigned* bar_st = (volatile LAS unsigned*)(lds + MISC_OFF + 4096);
    if (threadIdx.x < 2) bar_st[threadIdx.x] = 0u;
    __syncthreads();
#ifdef PROBE_A
    if (bx == 0 && threadIdx.x == 0) ((volatile LAS unsigned long long*)(lds + MISC_OFF + 4352))[0] = __builtin_amdgcn_s_memrealtime();
#endif
    XcdBarrier xbar; xbar.bar = (unsigned*)(p.ws + WS_CTL) + 1024; xbar.x = 0; xbar.st = bar_st;
    if (hi - lo > 1) xbar = xcd_barrier_post((unsigned*)(p.ws + WS_CTL) + 1024, bar_st);
#ifndef PH_MASK
#define PH_MASK 0x7f
#endif
#ifndef DBL_MASK
#define DBL_MASK 0
#endif
#ifndef DBL_L0
#define DBL_L0 0
#endif
#define PHASE_BEGIN(k) if (((PH_MASK >> (k)) & 1) && lo <= ph && ph < hi) { for (int rep_ = 0; rep_ <= (int)(((DBL_MASK >> (k)) & 1) && (!DBL_L0 || l == 0)); ++rep_) { \
    int tid; asm volatile("v_mbcnt_lo_u32_b32 %0, -1, 0\n\tv_mbcnt_hi_u32_b32 %0, -1, %0" : "=v"(tid)); tid += wave_s * 64; unsigned char* ws = p.ws; asm volatile("" : "+s"(ws)); ws = (unsigned char*)(__attribute__((address_space(1))) unsigned char*)ws; \
    const int lane = tid & 63, wave = __builtin_amdgcn_readfirstlane(tid >> 6); \
    const int vcu = (G % 8 == 0) ? (bx % 8) * (G / 8) + bx / 8 : bx; const int gw = vcu * NWAVES + wave, NGW = G * NWAVES; \
    bf16_t* const Ub = (bf16_t*)(ws + WS_U); bf16_t* const YM = (bf16_t*)(ws + WS_U); bf16_t* const Yc = (bf16_t*)(ws + WS_Y); bf16_t* const Hb = (bf16_t*)(ws + WS_H); \
    bf16_t* const HMb = (bf16_t*)(ws + WS_HM); float* const KS = (float*)(ws + WS_KS); float* const RS = (float*)(ws + WS_RS); unsigned* const REC = (unsigned*)(ws + WS_REC); \
    int* const TM = (int*)(ws + WS_TM); int* const CNT = (int*)(ws + WS_CTL); bf16_t* const XB = (bf16_t*)(ws + WS_XB); \
    LAS int* const m_tile_e = (LAS int*)(lds + MISC_OFF); LAS int* const m_tstart = m_tile_e + MAXTILES; LAS int* const m_cnt = m_tstart + 40; \
    unsigned char* const wl = ws + WS_W0 + (size_t)l * SZ_LAYER; int* const cntg = CNT + 8192 + l * 32 * 64;     \
    (void)lane; (void)wave; (void)gw; (void)NGW; (void)Ub; (void)YM; (void)Yc; (void)Hb; (void)HMb; (void)KS; (void)RS; (void)REC; (void)TM; (void)XB; (void)m_tile_e; (void)m_tstart; (void)m_cnt; (void)wl; (void)cntg;
#ifdef PROBE_A
#define STAMP() do { if (bx == 0 && threadIdx.x == 0) { ((volatile LAS unsigned long long*)(lds + MISC_OFF + 4352))[ph + 1] = __builtin_amdgcn_s_memrealtime(); } } while (0)
#else
#define STAMP() do {} while (0)
#endif
#define PHASE_END   } if (ph + 1 < hi) { if (lo < 0) grid.sync();   else xcd_barrier(xbar); } STAMP(); } ++ph;

    { const int l = 0;
    PHASE_BEGIN(0)
    {
        LAS float* scr = (LAS float*)(lds + wave * 16640);
        for (int l = 0; l < DEPTH; ++l) {
            unsigned char* wl = ws + WS_W0 + (size_t)l * SZ_LAYER;
            constexpr int I_IN = (DM / 64) * (DIN / 64), I_OUT = (DM / 64) * (DM / 64), I_G = NEXP * (DM / 64) * (DEXP / 64), I_D = NEXP * (DEXP / 64) * (DM / 64), I_ALL = I_IN + I_OUT + 2 * I_G + I_D;
            for (int it = gw; it < I_ALL; it += NGW) {
                int r = it;
                if (r < I_IN) { const int n0 = (r % (DIN / 64)) * 64;
                    const int rmul = ((n0 >= 512 && n0 < 1536) || n0 >= 4608) ? 2 : 1;
                    const int radd = n0 < 512 ? 0 : n0 < 1024 ? -512 : n0 < 1536 ? -1535 : n0 < 4608 ? 0 : n0 < 5120 ? -4608 : -5631;
                    transpose_item(p.in[IN_WIN] + (size_t)l * DM * DIN, DM, DIN, (bf16_t*)(wl + OFF_WIN), 0, rmul, radd, p.in[IN_N1G] + l * DM, scr, r, lane); continue; } r -= I_IN;
                if (r < I_OUT) { transpose_item(p.in[IN_WOUT] + (size_t)l * DM * DM, DM, DM, (bf16_t*)(wl + OFF_WOUT), 0, 1, 0, nullptr, scr, r, lane); continue; } r -= I_OUT;
                if (r < I_G) { transpose_item8(p.in[IN_WG] + (size_t)l * NEXP * DM * DEXP, DM, DEXP, (unsigned char*)(wl + OFF_WGU), (size_t)1024 * DM, 2, 0, p.in[IN_N2G] + l * DM, W1_SCALE, scr, r, lane); continue; } r -= I_G;
                if (r < I_G) { transpose_item8(p.in[IN_WU] + (size_t)l * NEXP * DM * DEXP, DM, DEXP, (unsigned char*)(wl + OFF_WGU), (size_t)1024 * DM, 2, 1, p.in[IN_N2G] + l * DM, W1_SCALE, scr, r, lane); continue; } r -= I_G;
                transpose_item8(p.in[IN_WD] + (size_t)l * NEXP * DEXP * DM, DEXP, DM, (unsigned char*)(wl + OFF_WD), (size_t)DM * DEXP, 1, 0, nullptr, W2_SCALE, scr, r, lane);
            }
            bf16_t* RW = (bf16_t*)(wl + OFF_RW);
            for (int i = vcu * NTHREADS + tid; i < NRW * (DM / 8); i += G * NTHREADS) { const int n = i / (DM / 8), k8 = (i % (DM / 8)) * 8; float v[8];
#pragma unroll
                for (int j = 0; j < 8; ++j) { const int k = k8 + j; const float g = p.in[IN_N2G][l * DM + k];
                    v[j] = n < 4 ? g * p.in[IN_RGW][(size_t)l * DM * 4 + k * 4 + n] : (n < 36 ? g * p.in[IN_REW][(size_t)l * DM * 32 + k * 32 + (n - 4)] : 0.f); }
                u32x4 o; o.x = cvt_pk_bf16(v[0], v[1]); o.y = cvt_pk_bf16(v[2], v[3]); o.z = cvt_pk_bf16(v[4], v[5]); o.w = cvt_pk_bf16(v[6], v[7]);
                *(u32x4*)(RW + (size_t)n * DM + k8) = o; }
        }
        for (int m = gw; m < T_TOK; m += NGW) norm_row_f32(p.in[IN_X] + (size_t)m * DM, XB + (size_t)m * DM, RS + m, lane);
        __syncthreads();
    }
    PHASE_END
    }

    for (int l = 0; l < DEPTH; ++l) {
        PHASE_BEGIN(1)
        {
            pg8::DenseSched S{(const char*)XB, (const char*)(wl + OFF_WIN), T_TOK / 256, DIN / 256, G, bx, DM};
            pg8::EpiInProj E{Ub, KS, (float*)(ws + WS_NRM), RS};
            pg8::gemm_phase<2>(lds, wave, DM, S, E);
        }
        PHASE_END
        PHASE_BEGIN(2)
        {
            { const float* NRM = (const float*)(ws + WS_NRM);
              LAS int* bc = (LAS int*)(lds + MISC_OFF + 4224);
              for (int slot_ = vcu; slot_ < 256; slot_ += G) { const int b = slot_ >> 6, sl64 = slot_ & 63;
               for (int pi = 0; pi < att::MAXP; ++pi) {
                const unsigned code = (unsigned)__builtin_amdgcn_readfirstlane((int)att::ATT_ITEMS.v[sl64][pi]);
                if (code == 0xFFFFu) break;
                const int h = code & 7, qb = (code >> 3) & 15, part = (code >> 7) & 1, split = (code >> 8) & 1;
                if (tid < 64) { const int n = lane >> 2, wc = lane & 3;
                    const float* kp = NRM + (size_t)(((64 + b * 16 + n) * 8 + h) * 2) * 4 + wc; float kv = fmaxf(kp[0], kp[4]);
                    kv += SWZ_XOR(kv, 1); kv += SWZ_XOR(kv, 2); if (n > qb) kv = 0.f;
                    kv = fmaxf(kv, SWZ_XOR(kv, 4)); kv = fmaxf(kv, SWZ_XOR(kv, 8)); kv = fmaxf(kv, SWZ_XOR(kv, 16)); kv = half_max(kv);
                    const float* qp = NRM + (size_t)(((b * 16 + qb) * 8 + h) * 2) * 4 + wc; float qv = fmaxf(qp[0], qp[4]);
                    qv += SWZ_XOR(qv, 1); qv += SWZ_XOR(qv, 2);
                    const float bound = att::SCALE * 1.02f * sqrtf(qv) * 2.f * sqrtf(kv) + att::CUT_MARGIN;
                    const float D = bound * exp2f((float)(h + 1));
                    int nb = (int)fminf(floorf((D - 1.f) * (1.f / 256.f)), 64.f);
                    int ns = qb - 1 - nb; ns = ns < 0 ? 0 : ns;
                    if (lane == 0) bc[1] = ns; }
                __syncthreads();
                const int n_start = __builtin_amdgcn_readfirstlane(bc[1]);
                const int n_mid = (qb - 7) > n_start ? (qb - 7) : n_start;
                const bool with_own = (part == 0);
                const int n_lo = split ? (part == 0 ? n_mid : n_start) : n_start, n_hi = split ? (part == 0 ? qb : n_mid) : qb;
                const int slot = split ? ((b * 3 + (h - 5)) * 4 + (qb - 12)) : 0;
#ifdef PROBE_TILES
                if (tid == 0 && l == 0) atomicAdd(&CNT[520], (with_own ? 4 : 0) + 4 * (n_hi - n_lo));
#endif
                att::attn_item(tid, b, h, qb, with_own, n_lo, n_hi, split, slot, l, ws, (char*)lds_raw);
               } } }
#ifndef NO_CONV
            int* const cq = CNT + 12416 + 16 * l; LAS int* qc = (LAS int*)(lds + MISC_OFF + 4240);
            __syncthreads();
            if (tid == 0) qc[0] = __hip_atomic_fetch_add(cq, 1, __ATOMIC_RELAXED, __HIP_MEMORY_SCOPE_AGENT);
            __syncthreads();
            { const float* cw = p.in[IN_CAW] + (size_t)l * 3 * 512;
              for (;;) { const int it = __builtin_amdgcn_readfirstlane(qc[0]); __syncthreads(); if (it >= T_TOK / 64) break;
                if (tid == 0) qc[0] = __hip_atomic_fetch_add(cq, 1, __ATOMIC_RELAXED, __HIP_MEMORY_SCOPE_AGENT);
                const int c8 = (tid & 63) * 8, tg0 = it * 64 + (tid >> 6) * 8, bstart = tg0 & ~(SEQ - 1);
                float w0[8], w1[8], w2[8];
#pragma unroll
                for (int j = 0; j < 8; ++j) { w0[j] = cw[c8 + j]; w1[j] = cw[512 + c8 + j]; w2[j] = cw[1024 + c8 + j]; }
                float z[10][8];
#pragma unroll
                for (int i = 0; i < 10; ++i) { const int tt = tg0 - 2 + i;
                    if (tt >= bstart) { const u32x4 a = *(const u32x4*)(Ub + (size_t)tt * UP + COL_Z + c8);
                        z[i][0] = bf_lo(a.x); z[i][1] = bf_hi(a.x); z[i][2] = bf_lo(a.y); z[i][3] = bf_hi(a.y); z[i][4] = bf_lo(a.z); z[i][5] = bf_hi(a.z); z[i][6] = bf_lo(a.w); z[i][7] = bf_hi(a.w); }
                    else {
#pragma unroll
                        for (int j = 0; j < 8; ++j) z[i][j] = 0.f; } }
#pragma unroll
                for (int o = 0; o < 8; ++o) { const int tt = tg0 + o; const u32x4 bg = *(const u32x4*)(Ub + (size_t)tt * UP + COL_BG + c8); float y[8];
#pragma unroll
                    for (int j = 0; j < 8; ++j) y[j] = w0[j] * z[o][j] + w1[j] * z[o + 1][j] + w2[j] * z[o + 2][j];
                    u32x4 w; w.x = cvt_pk_bf16(bf_lo(bg.x) * y[0], bf_hi(bg.x) * y[1]); w.y = cvt_pk_bf16(bf_lo(bg.y) * y[2], bf_hi(bg.y) * y[3]);
                    w.z = cvt_pk_bf16(bf_lo(bg.z) * y[4], bf_hi(bg.z) * y[5]); w.w = cvt_pk_bf16(bf_lo(bg.w) * y[6], bf_hi(bg.w) * y[7]);
                    *(u32x4*)(Yc + (size_t)tt * DM + c8) = w; }
                __syncthreads(); } }
            { const float* cw = p.in[IN_CCW] + (size_t)l * 31 * 512; const float* cb = p.in[IN_CCB] + l * 512; const float* lg = p.in[IN_LNG] + l * 512; const float* lb = p.in[IN_LNB] + l * 512;
              LAS float* hh = (LAS float*)lds; LAS float* co = hh + 46 * 512;
              for (;;) { const int it = __builtin_amdgcn_readfirstlane(qc[0]) - T_TOK / 64; __syncthreads(); if (it >= T_TOK / 16) break;
                if (tid == 0) qc[0] = __hip_atomic_fetch_add(cq, 1, __ATOMIC_RELAXED, __HIP_MEMORY_SCOPE_AGENT);
                const int t0 = it * 16, bstart = t0 & ~(SEQ - 1);
                { const int c8 = (tid & 63) * 8;
                  for (int i = tid >> 6; i < 46; i += 8) { const int tt = t0 - 30 + i; float v[8];
                    if (tt >= bstart) { const u32x4 a = *(const u32x4*)(Ub + (size_t)tt * UP + COL_HH + c8);
                        v[0] = bf_lo(a.x); v[1] = bf_hi(a.x); v[2] = bf_lo(a.y); v[3] = bf_hi(a.y); v[4] = bf_lo(a.z); v[5] = bf_hi(a.z); v[6] = bf_lo(a.w); v[7] = bf_hi(a.w); }
                    else {
#pragma unroll
                        for (int j = 0; j < 8; ++j) v[j] = 0.f; }
                    *(LAS f32x4*)(hh + i * 512 + c8) = (f32x4){v[0], v[1], v[2], v[3]}; *(LAS f32x4*)(hh + i * 512 + c8 + 4) = (f32x4){v[4], v[5], v[6], v[7]}; } }
                __syncthreads();
                { const int c = tid; float w[31];
#pragma unroll
                  for (int j = 0; j < 31; ++j) w[j] = cw[j * 512 + c];
                  const float bias = cb[c];
                  float win[46];
#pragma unroll
                  for (int i = 0; i < 46; ++i) win[i] = hh[i * 512 + c];
#pragma unroll
                  for (int o = 0; o < 16; ++o) { float a = bias;
#pragma unroll
                      for (int j = 0; j < 31; ++j) a = fmaf(w[j], win[o + j], a);
                      co[o * 512 + c] = a; } }
                __syncthreads();
                { const int c8 = lane * 8;
                  f32x4 ga = *(const f32x4*)(lg + c8), gb = *(const f32x4*)(lg + c8 + 4), ba = *(const f32x4*)(lb + c8), bb = *(const f32x4*)(lb + c8 + 4);
#pragma unroll
                  for (int q = 0; q < 2; ++q) { const int o = wave * 2 + q; const f32x4 xa = *(const LAS f32x4*)(co + o * 512 + c8), xb = *(const LAS f32x4*)(co + o * 512 + c8 + 4);
                    const float mu = wave_sum((xa[0] + xa[1]) + (xa[2] + xa[3]) + (xb[0] + xb[1]) + (xb[2] + xb[3])) * (1.f / 512.f);
                    const f32x4 da = xa - mu, db = xb - mu;
                    const float var = wave_sum((da[0] * da[0] + da[1] * da[1]) + (da[2] * da[2] + da[3] * da[3]) + (db[0] * db[0] + db[1] * db[1]) + (db[2] * db[2] + db[3] * db[3])) * (1.f / 512.f);
                    const float rstd = 1.0f / sqrtf(var + EPS);
                    f32x4 ya = da * rstd * ga + ba, yb = db * rstd * gb + bb;
#pragma unroll
                    for (int j = 0; j < 4; ++j) { ya[j] = ya[j] * fast_sigmoid(ya[j]); yb[j] = yb[j] * fast_sigmoid(yb[j]); }
                    u32x4 w; w.x = cvt_pk_bf16(ya[0], ya[1]); w.y = cvt_pk_bf16(ya[2], ya[3]); w.z = cvt_pk_bf16(yb[0], yb[1]); w.w = cvt_pk_bf16(yb[2], yb[3]);
                    *(u32x4*)(Yc + (size_t)(t0 + o) * DM + 1536 + c8) = w; } }
                __syncthreads();
              } }
#endif
        }
        PHASE_END
        PHASE_BEGIN(3)
        {

#ifdef ATT_CHECK
            if (l == ATT_CHECK) {
                LAS float* qs = (LAS float*)(lds + wave * 4608); LAS float* ps = qs + 128;
                const float SC = 0.088388347648318440f;
                for (int sidx = gw; sidx < 4096; sidx += NGW) {
                    const int b = sidx & 3, h = (sidx >> 2) & 7; const int t = (int)((((unsigned)sidx * 2654435761u) >> 12) & 4095u);
                    const int qblk = t >> 8; const float slope = exp2f(-(float)(h + 1));
                    const bf16_t* urow = Ub + (size_t)(b * SEQ + t) * UP;
                    for (int d = lane; d < 128; d += 64) qs[d] = __uint_as_float((unsigned)urow[COL_Q + h * HD + d] << 16) * SC;
                    asm volatile("s_waitcnt lgkmcnt(0)" ::: "memory");
                    float gate[16];
#pragma unroll
                    for (int n = 0; n < 16; ++n) gate[n] = -1e30f;
                    for (int n = 0; n < qblk; ++n) { float sacc = 0.f;
                        for (int kk = lane; kk < 256; kk += 64) { const bf16_t* kr = Ub + (size_t)(b * SEQ + n * 256 + kk) * UP + COL_K + h * HD; float dsum = 0.f;
                            for (int c = 0; c < 16; ++c) { const u32x4 w = *(const u32x4*)(kr + 8 * c);
                                dsum += qs[8 * c] * bf_lo(w.x) + qs[8 * c + 1] * bf_hi(w.x) + qs[8 * c + 2] * bf_lo(w.y) + qs[8 * c + 3] * bf_hi(w.y) + qs[8 * c + 4] * bf_lo(w.z) + qs[8 * c + 5] * bf_hi(w.z) + qs[8 * c + 6] * bf_lo(w.w) + qs[8 * c + 7] * bf_hi(w.w); }
                            sacc += dsum; }
                        const float gsum = wave_sum(sacc) * (1.f / 256.f);
#pragma unroll
                        for (int m = 0; m < 16; ++m) if (m == n) gate[m] = gsum; }
                    int sel[3] = {-1, -1, -1}; float sv[4] = {-1e30f, -1e30f, -1e30f, -1e30f};
                    { float gcopy[16];
#pragma unroll
                      for (int n = 0; n < 16; ++n) gcopy[n] = gate[n];
                      for (int it = 0; it < 4; ++it) { float best = gcopy[0]; int bi = 0;
#pragma unroll
                          for (int n = 1; n < 16; ++n) if (gcopy[n] > best) { best = gcopy[n]; bi = n; }
                          if (it < 3) sel[it] = bi; sv[it] = best;
#pragma unroll
                          for (int n = 0; n < 16; ++n) if (n == bi) gcopy[n] = -3e38f; } }
                    const int nsel = qblk < 3 ? qblk : 3;
                    const bool neartie = (qblk > 3) && (sv[2] - sv[3] < 1.5e-3f);
                    float mx = -1e30f;
                    for (int r = 0; r < 4; ++r) { const bool own = (r == 3); const int blkn = own ? qblk : sel[r]; const bool valid = own || r < nsel;
                        for (int kk = lane; kk < 256; kk += 64) { float lg = -1e30f;
                            if (valid) { const int kpos = blkn * 256 + kk;
                                if (!own || kpos <= t) { const bf16_t* kr = Ub + (size_t)(b * SEQ + kpos) * UP + COL_K + h * HD; float dsum = 0.f;
                                    for (int c = 0; c < 16; ++c) { const u32x4 w = *(const u32x4*)(kr + 8 * c);
                                        dsum += qs[8 * c] * bf_lo(w.x) + qs[8 * c + 1] * bf_hi(w.x) + qs[8 * c + 2] * bf_lo(w.y) + qs[8 * c + 3] * bf_hi(w.y) + qs[8 * c + 4] * bf_lo(w.z) + qs[8 * c + 5] * bf_hi(w.z) + qs[8 * c + 6] * bf_lo(w.w) + qs[8 * c + 7] * bf_hi(w.w); }
                                    lg = dsum - slope * (float)(t - kpos); } }
                            ps[r * 256 + kk] = lg; mx = fmaxf(mx, lg); } }
#pragma unroll
                    for (int o = 1; o < 64; o <<= 1) mx = fmaxf(mx, __shfl_xor(mx, o));
                    float se = 0.f;
                    for (int i = lane; i < 1024; i += 64) { const float e = (ps[i] > -1e29f) ? __expf(ps[i] - mx) : 0.f; ps[i] = e; se += e; }
                    se = wave_sum(se);
                    asm volatile("s_waitcnt lgkmcnt(0)" ::: "memory");
                    float o0 = 0.f, o1 = 0.f;
                    for (int r = 0; r < 4; ++r) { const bool own = (r == 3); const int blkn = own ? qblk : sel[r]; const bool valid = own || r < nsel;
                        if (valid) for (int kk = 0; kk < 256; ++kk) { const float pp = ps[r * 256 + kk];
                            if (pp != 0.f) { const unsigned w = *(const unsigned*)(Ub + (size_t)(b * SEQ + blkn * 256 + kk) * UP + COL_V + h * HD + 2 * lane); o0 += pp * bf_lo(w); o1 += pp * bf_hi(w); } } }
                    o0 /= se; o1 /= se;
                    const unsigned yw = *(const unsigned*)(Yc + (size_t)(b * SEQ + t) * DM + 512 + h * HD + 2 * lane);
                    float err = fmaxf(fabsf(o0 - bf_lo(yw)), fabsf(o1 - bf_hi(yw))), ref = fmaxf(fabsf(o0), fabsf(o1));
                    const bool isnan_ = !(err == err);
#pragma unroll
                    for (int o = 1; o < 64; o <<= 1) { err = fmaxf(err, __shfl_xor(err, o)); ref = fmaxf(ref, __shfl_xor(ref, o)); }
                    const bool bad = __any(isnan_) || !(err <= 0.03f * ref + 1e-4f);
                    if (lane == 0) { if (neartie) atomicAdd(&CNT[514], 1); else { atomicAdd(&CNT[513], 1); if (bad) atomicAdd(&CNT[512], 1); } }
                    asm volatile("s_waitcnt lgkmcnt(0)" ::: "memory");
                }
                __syncthreads();
            }
#endif
            pg8::DenseSched S{(const char*)Yc, (const char*)(wl + OFF_WOUT), T_TOK / 256, DM / 256, G, bx, DM};
            pg8::EpiResBf16 E{nullptr, XB};
            pg8::gemm_phase<2>(lds, wave, DM, S, E);
        }
        PHASE_END
        PHASE_BEGIN(4)
        {
            const bf16_t* RW = (const bf16_t*)(wl + OFF_RW);
            const float* rgb = p.in[IN_RGB] + l * 4; const float* reb = p.in[IN_REB] + l * 32;
            LAS float* part = (LAS float*)lds;
            LAS float* ssp = part + 8 * 64 * 49;
            LAS float* lgr = ssp + 8 * 64;
            LAS float* rsr = lgr + 64 * 49;
            const int r16 = lane & 15, q = lane >> 4;
            bf16x8 rwf[8][3];
#pragma unroll
            for (int ks = 0; ks < 8; ++ks)
#pragma unroll
                for (int nb = 0; nb < 3; ++nb) rwf[ks][nb] = *reinterpret_cast<const bf16x8*>(RW + (size_t)(nb * 16 + r16) * DM + wave * 256 + ks * 32 + 8 * q);
            for (int it = vcu; it < T_TOK / 64; it += G) {
#pragma unroll 1
                for (int rg = 0; rg < 4; ++rg) {
                    const int row = it * 64 + rg * 16 + r16;
                    const bf16_t* xr = XB + (size_t)row * DM + wave * 256 + 8 * q; unsigned char* x8r = ws + WS_X8 + (size_t)row * DM + wave * 256 + 8 * q;
                    u32x4 xw[8];
#pragma unroll
                    for (int ks = 0; ks < 8; ++ks) xw[ks] = *(const u32x4*)(xr + ks * 32);
                    f32x4 acc[3] = {(f32x4){0.f, 0.f, 0.f, 0.f}, (f32x4){0.f, 0.f, 0.f, 0.f}, (f32x4){0.f, 0.f, 0.f, 0.f}}; float ss = 0.f;
#pragma unroll
                    for (int ks = 0; ks < 8; ++ks) { const u32x4 w = xw[ks];
                        const float a0 = bf_lo(w.x), a1 = bf_hi(w.x), a2 = bf_lo(w.y), a3 = bf_hi(w.y), a4 = bf_lo(w.z), a5 = bf_hi(w.z), a6 = bf_lo(w.w), a7 = bf_hi(w.w);
                        ss += (a0 * a0 + a1 * a1) + (a2 * a2 + a3 * a3) + (a4 * a4 + a5 * a5) + (a6 * a6 + a7 * a7);
                        { int w0 = 0, w1 = 0;
                          w0 = __builtin_amdgcn_cvt_pk_fp8_f32(__builtin_amdgcn_fmed3f(a0, -400.f, 400.f), __builtin_amdgcn_fmed3f(a1, -400.f, 400.f), w0, false); w0 = __builtin_amdgcn_cvt_pk_fp8_f32(__builtin_amdgcn_fmed3f(a2, -400.f, 400.f), __builtin_amdgcn_fmed3f(a3, -400.f, 400.f), w0, true);
                          w1 = __builtin_amdgcn_cvt_pk_fp8_f32(__builtin_amdgcn_fmed3f(a4, -400.f, 400.f), __builtin_amdgcn_fmed3f(a5, -400.f, 400.f), w1, false); w1 = __builtin_amdgcn_cvt_pk_fp8_f32(__builtin_amdgcn_fmed3f(a6, -400.f, 400.f), __builtin_amdgcn_fmed3f(a7, -400.f, 400.f), w1, true);
                          *(u32x2*)(x8r + ks * 32) = (u32x2){(unsigned)w0, (unsigned)w1}; }
                        const bf16x8 a = *reinterpret_cast<const bf16x8*>(&w);
#pragma unroll
                        for (int nb = 0; nb < 3; ++nb) acc[nb] = __builtin_amdgcn_mfma_f32_16x16x32_bf16(a, rwf[ks][nb], acc[nb], 0, 0, 0); }
                    ss += SWZ_XOR(ss, 16); ss = half_sum(ss);
                    if (q == 0) ssp[wave * 64 + rg * 16 + r16] = ss;
#pragma unroll
                    for (int nb = 0; nb < 3; ++nb)
#pragma unroll
                        for (int r = 0; r < 4; ++r) part[(wave * 64 + rg * 16 + 4 * q + r) * 49 + nb * 16 + r16] = acc[nb][r];
                }
                __syncthreads();
                for (int i = tid; i < 64 * 48; i += NTHREADS) { const int r = i / 48, c = i - r * 48; float a = 0.f;
#pragma unroll
                    for (int w = 0; w < 8; ++w) a += part[(w * 64 + r) * 49 + c];
                    lgr[r * 49 + c] = a; }
                if (tid < 64) { float a = 0.f;
#pragma unroll
                    for (int w = 0; w < 8; ++w) a += ssp[w * 64 + tid];
                    rsr[tid] = 1.0f / sqrtf(a * (1.f / DM) + EPS); }
                __syncthreads();
                if (tid < 64) {
                    const int row = it * 64 + tid; const float rs = rsr[tid];
                    const LAS float* lr = lgr + tid * 49;
                    float gl[4];
#pragma unroll
                    for (int j = 0; j < 4; ++j) gl[j] = lr[j] * rs + rgb[j];
                    int grp = 0; float gm = gl[0];
#pragma unroll
                    for (int j = 1; j < 4; ++j) if (gl[j] > gm) { gm = gl[j]; grp = j; }
                    float gsum = 0.f;
#pragma unroll
                    for (int j = 0; j < 4; ++j) gsum += __expf(gl[j] - gm);
                    const float pgrp = 1.0f / gsum;
                    float el[8];
#pragma unroll
                    for (int j = 0; j < 8; ++j) el[j] = lr[4 + grp * 8 + j] * rs + reb[grp * 8 + j];
                    int i1 = 0; float m1 = el[0];
#pragma unroll
                    for (int j = 1; j < 8; ++j) if (el[j] > m1) { m1 = el[j]; i1 = j; }
                    int i2 = -1; float m2 = -INFINITY;
#pragma unroll
                    for (int j = 0; j < 8; ++j) if (j != i1 && el[j] > m2) { m2 = el[j]; i2 = j; }
                    const float e2 = __expf(m2 - m1), inv = 1.0f / (1.0f + e2);
                    const float g1 = pgrp * inv, g2 = pgrp * e2 * inv;
                    const int E1 = grp * 8 + i1, E2 = grp * 8 + i2;
                    LAS int* hist = (LAS int*)(rsr + 64); LAS int* hbase = hist + 32;
                    if (tid < 32) hist[tid] = 0;
                    asm volatile("s_waitcnt lgkmcnt(0)" ::: "memory");
                    const int rk1 = __hip_atomic_fetch_add(&hist[E1], 1, __ATOMIC_RELAXED, __HIP_MEMORY_SCOPE_WORKGROUP);
                    const int rk2 = __hip_atomic_fetch_add(&hist[E2], 1, __ATOMIC_RELAXED, __HIP_MEMORY_SCOPE_WORKGROUP);
                    asm volatile("s_waitcnt lgkmcnt(0)" ::: "memory");
                    if (tid < 32) { const int hc = hist[tid]; hbase[tid] = hc > 0 ? atomicAdd(&cntg[tid * 64], hc) : 0; }
                    asm volatile("s_waitcnt vmcnt(0) lgkmcnt(0)" ::: "memory");
                    const int pos1 = hbase[E1] + rk1, pos2 = hbase[E2] + rk2;
                    TM[E1 * T_TOK + pos1] = row; TM[E2 * T_TOK + pos2] = row;
                    u32x4 ra = {(unsigned)E1, (unsigned)pos1, (unsigned)E2, (unsigned)pos2}; u32x4 rb = {__float_as_uint(g1), __float_as_uint(g2), 0u, 0u};
                    *(u32x4*)(REC + (size_t)row * 8) = ra; *(u32x4*)(REC + (size_t)row * 8 + 4) = rb;
                    RS[row] = rs;
                }
                __syncthreads();
            }
        }
        PHASE_END
        for (int pass = 0; pass < 2; ++pass) {
            PHASE_BEGIN(5)
            {
                if (tid < 64) { const int c = tid < NEXP ? __hip_atomic_load(&cntg[tid * 64], __ATOMIC_RELAXED, __HIP_MEMORY_SCOPE_AGENT) : 0; const int nt_ = (c + 255) >> 8; int incl = nt_;
#pragma unroll
                    for (int o = 1; o < 64; o <<= 1) { const int v = __builtin_amdgcn_ds_bpermute((lane - o) << 2, incl); if (lane >= o) incl += v; }
                    const int st = incl - nt_;
                    if (tid < NEXP) { m_tstart[tid] = st; m_cnt[tid] = c; for (int k = 0; k < nt_; ++k) m_tile_e[st + k] = tid; }
                    if (tid == NEXP) m_tstart[NEXP] = st; }
                __syncthreads();
                const int nM = m_tstart[NEXP];
#ifndef PASS_MASK
#define PASS_MASK 3
#endif
                if ((PASS_MASK & 1) && pass == 0) {
                    pg8::MoeSched S{(const char*)(ws + WS_X8), (const char*)(wl + OFF_WGU), (size_t)1024 * DM, nM, 1024 / 256, G, bx, DM, true, m_tile_e, m_tstart, m_cnt, TM, 1};
                    pg8::EpiSwiglu E{(unsigned char*)HMb, RS, TM, m_tstart, m_cnt};
                    pg8::gemm_phase<1>(lds, wave, DM, S, E);
                } else if (PASS_MASK & 2) {
                    pg8::MoeSched S{(const char*)HMb, (const char*)(wl + OFF_WD), (size_t)DM * DEXP, nM, DM / 256, G, bx, DEXP, false, m_tile_e, m_tstart, m_cnt, TM, 1};
                    pg8::EpiFp8 E{(unsigned char*)YM, DM, pg8::YM_SCALE / (HM_SCALE * W2_SCALE)};
                    pg8::gemm_phase<1>(lds, wave, DEXP, S, E);
                }
                __syncthreads();
            }
            PHASE_END
        }
        PHASE_BEGIN(6)
        {
            int tst; { const int c = lane < NEXP ? __hip_atomic_load(&cntg[lane * 64], __ATOMIC_RELAXED, __HIP_MEMORY_SCOPE_AGENT) : 0; const int nt_ = (c + 255) >> 8; int incl = nt_;
#pragma unroll
                for (int o = 1; o < 64; o <<= 1) { const int v = __builtin_amdgcn_ds_bpermute((lane - o) << 2, incl); if (lane >= o) incl += v; }
                tst = incl - nt_; }
            const bool fin = (l == DEPTH - 1);
            u32x4 ra_n = (u32x4){0u, 0u, 0u, 0u}; u32x2 rb_n = (u32x2){0u, 0u};
            if (gw < T_TOK) { ra_n = *(const u32x4*)(REC + (size_t)gw * 8); rb_n = *(const u32x2*)(REC + (size_t)gw * 8 + 4); }
            for (int m = gw; m < T_TOK; m += NGW) {
                const u32x4 ra = ra_n; const u32x2 rb = rb_n;
                if (m + NGW < T_TOK) { ra_n = *(const u32x4*)(REC + (size_t)(m + NGW) * 8); rb_n = *(const u32x2*)(REC + (size_t)(m + NGW) * 8 + 4); }
                const int r0 = __builtin_amdgcn_ds_bpermute((int)ra.x << 2, tst) * 256 + (int)ra.y, r1 = __builtin_amdgcn_ds_bpermute((int)ra.z << 2, tst) * 256 + (int)ra.w;
                RowRegs RR; combine_load(RR, XB + (size_t)m * DM, (const unsigned char*)YM + (size_t)r0 * DM, (const unsigned char*)YM + (size_t)r1 * DM, lane);
                combine_finish(RR, XB + (size_t)m * DM, __uint_as_float(rb.x), __uint_as_float(rb.y), RS + m, fin ? p.out + (size_t)m * DM : nullptr, p.in[IN_FG], lane);
            }
        }
        PHASE_END
    }
#ifdef PROBE_A
    { __syncthreads(); grid.sync(); if (bx == 0 && threadIdx.x == 0) { volatile LAS unsigned long long* tsp = (volatile LAS unsigned long long*)(lds + MISC_OFF + 4352);
        const float ta = (float)(tsp[PROBE_A + 1] - tsp[PROBE_A]) * 0.01f, tb = (float)(tsp[PROBE_B + 1] - tsp[PROBE_B]) * 0.01f;
        (void)tb; p.out[0] += 40.f * rintf((ta - PROBE_OFS) * 0.025f) + PROBE_OFS; } }
#endif
#ifdef PROBE_TILES
    { __syncthreads(); grid.sync(); if (bx == 0 && threadIdx.x == 0) { int* CNTd = (int*)(p.ws + WS_CTL); p.out[0] += (float)CNTd[520] * 0.01f; } }
#endif
#ifdef ATT_CHECK
    { grid.sync(); if (bx == 0 && threadIdx.x == 0) { int* CNTd = (int*)(p.ws + WS_CTL); const int bad = CNTd[512], tot = CNTd[513], nt_ = CNTd[514];
        float A = 10.f + 1000.f * (float)bad / (float)(tot > 0 ? tot : 1);
#if ATT_REPORT == 1
        A = 10.f + 1000.f * (float)nt_ / 4096.f;
#endif
        p.out[0] += A; } }
#endif
#undef PHASE_BEGIN
#undef PHASE_END
}

constexpr int N_PHASES = 1 + 7 * DEPTH;

extern "C" void kernel_launch(void* const* d_in, const int* in_sizes, int n_in, void* d_out, int out_size, void* d_ws, size_t ws_size, hipStream_t stream) {
    static int grid = 0;
    if (grid == 0) {
        if (n_in != 18 || in_sizes[0] != T_TOK * DM || out_size != T_TOK * DM || ws_size < WS_END) {
            fprintf(stderr, "kernel_launch: unexpected shapes: n_in %d in0 %d out %d ws %zu (need >= %zu)\n", n_in, n_in > 0 ? in_sizes[0] : -1, out_size, ws_size, (size_t)WS_END); grid = -1; return; }
        int dev = 0, cus = 0, per_cu = 0;
        hipGetDevice(&dev); hipDeviceGetAttribute(&cus, hipDeviceAttributeMultiprocessorCount, dev);
        if (hipFuncSetAttribute((const void*)fwd_kernel, hipFuncAttributeMaxDynamicSharedMemorySize, LDS_BYTES) != hipSuccess) { fprintf(stderr, "kernel_launch: hipFuncSetAttribute failed\n"); grid = -1; return; }
        if (hipOccupancyMaxActiveBlocksPerMultiprocessor(&per_cu, (const void*)fwd_kernel, NTHREADS, LDS_BYTES) != hipSuccess || per_cu < 1) { fprintf(stderr, "kernel_launch: occupancy query says %d blocks/CU\n", per_cu); per_cu = 1; }
        (void)hipGetLastError();
        grid = cus;
        if (grid > 256) grid = 256;
    }
    if (grid < 0) return;
    hipMemsetAsync((char*)d_ws + WS_CTL, 0, CTL_BYTES, stream);
    Params p{};
    for (int i = 0; i < 18; ++i) p.in[i] = (const float*)d_in[i];
    p.out = (float*)d_out; p.ws = (unsigned char*)d_ws;
#if MK_N_LAUNCHES == 1
    p.ph_lo = 0; p.ph_hi = N_PHASES;
    void* args[] = {&p};
    hipError_t e = hipLaunchCooperativeKernel((const void*)fwd_kernel, dim3(grid), dim3(NTHREADS), args, LDS_BYTES, stream);
    if (e != hipSuccess) fprintf(stderr, "kernel_launch: cooperative launch failed: %s (grid %d)\n", hipGetErrorString(e), grid);
#else
    for (int ph = 0; ph < N_PHASES; ++ph) { p.ph_lo = ph; p.ph_hi = ph + 1;
        hipLaunchKernelGGL(fwd_kernel, dim3(grid), dim3(NTHREADS), LDS_BYTES, stream, p); }
    hipError_t e = hipPeekAtLastError();
    if (e != hipSuccess) fprintf(stderr, "kernel_launch: launch failed: %s\n", hipGetErrorName(e));
#endif
}
```

```cpp
#include <hip/hip_runtime.h>
#include <hip/hip_cooperative_groups.h>
#include <cstdio>
#include <cstdint>
namespace cg = cooperative_groups;

#ifndef PROBE_ATT2
#define PROBE_ATT2 0
#endif
#ifndef ATT_REPORT
#define ATT_REPORT 0
#endif
#ifndef MK_N_LAUNCHES
#define MK_N_LAUNCHES 1
#endif

#define LAS __attribute__((address_space(3)))
typedef unsigned short bf16_t;
typedef short bf16x8 __attribute__((ext_vector_type(8)));
typedef short s16x4 __attribute__((ext_vector_type(4)));
typedef float f32x2 __attribute__((ext_vector_type(2)));
typedef float f32x4 __attribute__((ext_vector_type(4)));
typedef float f32x16 __attribute__((ext_vector_type(16)));
typedef unsigned u32x2 __attribute__((ext_vector_type(2)));
typedef unsigned u32x4 __attribute__((ext_vector_type(4)));

constexpr int T_TOK = 16384, DM = 2048, DIN = 5632, SEQ = 4096, NBATCH = 4, NHEAD = 8, HD = 128, DEPTH = 2;
constexpr int GC_Q = 1536, GC_K = 2560, GC_V = 3584;
constexpr int UP = 4608, COL_BG = 0, COL_Z = 512, COL_Q = 1024, COL_K = 2048, COL_V = 3072, COL_HH = 4096;
constexpr int NEXP = 32, DEXP = 512, NRW = 48;
constexpr int MAXTILES = 160;
constexpr float EPS = 1e-6f;
constexpr float W1_SCALE = 64.f, W2_SCALE = 32.f, HM_SCALE = 16.f;
constexpr int NWAVES = 8, NTHREADS = 512;
constexpr int RING_BYTES = 131072, SCRATCH_BYTES = 147456, MISC_OFF = SCRATCH_BYTES, MISC_BYTES = 8192, LDS_BYTES = SCRATCH_BYTES + MISC_BYTES;

constexpr size_t MiB = 1u << 20;
constexpr size_t WS_CTL = 0;
constexpr size_t CTL_BYTES = 65536;
constexpr size_t SZ_WIN = (size_t)DIN * DM * 2, SZ_WOUT = (size_t)DM * DM * 2, SZ_WGU = (size_t)NEXP * 1024 * DM * 2, SZ_WD = (size_t)NEXP * DM * DEXP * 2, SZ_RW = (size_t)NRW * DM * 2;
constexpr size_t WS_W0 = 1 * MiB;
constexpr size_t OFF_WIN = 0, OFF_WOUT = OFF_WIN + SZ_WIN, OFF_WGU = OFF_WOUT + SZ_WOUT, OFF_WD = OFF_WGU + SZ_WGU, OFF_RW = OFF_WD + SZ_WD, SZ_LAYER = ((OFF_RW + SZ_RW + 4095) / 4096) * 4096;
constexpr size_t WS_U = WS_W0 + DEPTH * SZ_LAYER;
constexpr size_t SZ_U = (size_t)T_TOK * UP * 2;
static_assert((size_t)MAXTILES * 256 * DM <= SZ_U, "ymoe (fp8) overlays u");
constexpr size_t WS_Y = WS_U + SZ_U;
constexpr size_t WS_H = WS_Y + (size_t)T_TOK * DM * 2;
constexpr size_t WS_HM = WS_H + (size_t)T_TOK * DM * 2;
constexpr size_t WS_KS = WS_HM + (size_t)MAXTILES * 256 * DEXP * 2;
constexpr size_t WS_RS = WS_KS + (size_t)64 * 2 * 1024 * 4;
constexpr size_t WS_REC = WS_RS + (size_t)T_TOK * 4;
constexpr size_t WS_TM = WS_REC + (size_t)T_TOK * 32;
constexpr size_t WS_XB = WS_TM + (size_t)NEXP * T_TOK * 4;
constexpr size_t WS_X8 = WS_XB + (size_t)T_TOK * DM * 2;
constexpr size_t WS_NRM = WS_X8 + (size_t)T_TOK * DM;
constexpr size_t WS_PART = WS_NRM + 2 * 64 * 8 * 8 * 4;
constexpr size_t WS_END = WS_PART + (size_t)48 * 66 * 512 * 4;

__device__ __forceinline__ unsigned cvt_pk_bf16(float lo, float hi) { unsigned r; asm volatile("v_cvt_pk_bf16_f32 %0, %1, %2" : "=v"(r) : "v"(lo), "v"(hi)); return r; }
__device__ __forceinline__ float bf_lo(unsigned w) { return __uint_as_float(w << 16); }
__device__ __forceinline__ float bf_hi(unsigned w) { return __uint_as_float(w & 0xffff0000u); }
#define SWZ_XOR(v, O) __uint_as_float((unsigned)__builtin_amdgcn_ds_swizzle((int)__float_as_uint(v), ((O) << 10) | 0x1f))
__device__ __forceinline__ float half_sum(float v) { auto rr = __builtin_amdgcn_permlane32_swap(__float_as_uint(v), __float_as_uint(v), false, false); return __uint_as_float(rr[0]) + __uint_as_float(rr[1]); }
__device__ __forceinline__ float half_max(float v) { auto rr = __builtin_amdgcn_permlane32_swap(__float_as_uint(v), __float_as_uint(v), false, false); return fmaxf(__uint_as_float(rr[0]), __uint_as_float(rr[1])); }
__device__ __forceinline__ float wave_sum(float v) {
    v += SWZ_XOR(v, 1); v += SWZ_XOR(v, 2); v += SWZ_XOR(v, 4); v += SWZ_XOR(v, 8); v += SWZ_XOR(v, 16);
    return half_sum(v);
}
__device__ __forceinline__ unsigned pk4_fp8(float a, float b, float c, float d) { int w = 0;
    w = __builtin_amdgcn_cvt_pk_fp8_f32(__builtin_amdgcn_fmed3f(a, -400.f, 400.f), __builtin_amdgcn_fmed3f(b, -400.f, 400.f), w, false);
    w = __builtin_amdgcn_cvt_pk_fp8_f32(__builtin_amdgcn_fmed3f(c, -400.f, 400.f), __builtin_amdgcn_fmed3f(d, -400.f, 400.f), w, true); return (unsigned)w; }
__device__ __forceinline__ float fast_sigmoid(float x) { return __builtin_amdgcn_rcpf(1.f + __builtin_amdgcn_exp2f(-1.4426950408889634f * x)); }

namespace pg8 {
constexpr int BM = 256, BK = 64, HALF = 128, HTB = HALF * BK * 2, STAGE_BYTES = 8 * HTB, NXCD = 8, WGM = 8;
__host__ __device__ __forceinline__ int lds_byte(int r, int c) { const int st = (r >> 4) * 2 + (c >> 5), rr = r & 15, cc = c & 31, ob = rr * 64 + cc * 2; return st * 1024 + (ob ^ (((ob >> 9) & 1) << 5)); }
__host__ __device__ __forceinline__ void stage_rc(int b, int& R, int& C) { const int st = b / 1024, sb = b % 1024, swz = sb ^ (((sb >> 9) & 1) << 5); R = (st >> 1) * 16 + swz / 64; C = (st & 1) * 32 + (swz % 64) / 2; }
__host__ __device__ __forceinline__ int perm32(int rho) { const int n = rho >> 4, i = rho & 15; return 8 * (i >> 2) + 4 * n + (i & 3); }

struct Unit { int pm, pn, e; };

__device__ __forceinline__ bool order_next(int i, int G, int c, int nM, int nN, Unit& u) {
    const int nwg = nM * nN; const long L = (long)i * G + c; if (L >= nwg) return false;
    int wgid = (int)L; { const int q = nwg / NXCD, r = nwg % NXCD, xcd = wgid % NXCD, off = wgid / NXCD; wgid = (xcd < r ? xcd * (q + 1) : r * (q + 1) + (xcd - r) * q) + off; }
    const int nig = WGM * nN, gid = wgid / nig, fm = gid * WGM, gsz = (nM - fm) < WGM ? (nM - fm) : WGM;
    u.pm = fm + ((wgid % nig) % gsz); u.pn = (wgid % nig) / gsz; u.e = 0; return true;
}

struct DenseSched {
    const char* A; const char* Bt; int nM, nN, G, c, K;
    __device__ __forceinline__ bool next(int i, Unit& u) const { return order_next(i, G, c, nM, nN, u); }
    __device__ __forceinline__ unsigned a_off(const Unit& u) const { return (unsigned)(u.pm * BM * K * 2); }
    __device__ __forceinline__ unsigned b_off(const Unit& u) const { return (unsigned)(u.pn * BM * K * 2); }
    __device__ __forceinline__ void a_rows(const Unit&, const int (&RA)[2], const unsigned (&cofA)[2], unsigned (&g)[2][2]) const {
#pragma unroll
        for (int h = 0; h < 2; ++h)
#pragma unroll
            for (int i = 0; i < 2; ++i) g[h][i] = (unsigned)((h * HALF + RA[i]) * K) * 2u + cofA[i];
    }
};
struct MoeSched {
    const char* A; const char* Bt; size_t b_estride; int nM, nN, G, c, K; bool gather;
    const LAS int* tile_e; const LAS int* tstart; const LAS int* cnt; const int* tokmap; int es;
    __device__ __forceinline__ bool next(int i, Unit& u) const { if (!order_next(i, G, c, nM, nN, u)) return false; u.e = tile_e[u.pm]; return true; }
    __device__ __forceinline__ unsigned a_off(const Unit& u) const { return gather ? 0u : (unsigned)(u.pm * BM * K * es); }
    __device__ __forceinline__ unsigned b_off(const Unit& u) const { return (unsigned)(u.e * (int)b_estride + u.pn * BM * K * es); }
    __device__ __forceinline__ void a_rows(const Unit& u, const int (&RA)[2], const unsigned (&cofA)[2], unsigned (&g)[2][2]) const {
        if (gather) {
            const int p0 = (u.pm - tstart[u.e]) * BM, cn = cnt[u.e];
#pragma unroll
            for (int h = 0; h < 2; ++h)
#pragma unroll
                for (int i = 0; i < 2; ++i) { int pos = p0 + h * HALF + RA[i]; pos = pos < cn ? pos : cn - 1; const int tok = tokmap[u.e * T_TOK + pos]; g[h][i] = (unsigned)(tok * K * es) + cofA[i]; }
        } else {
#pragma unroll
            for (int h = 0; h < 2; ++h)
#pragma unroll
                for (int i = 0; i < 2; ++i) g[h][i] = (unsigned)((h * HALF + RA[i]) * K * es) + cofA[i];
        }
    }
};

__device__ __forceinline__ void acc_zero(f32x4 (&acc)[2][2][4][2]) {
    float z; asm volatile("v_mov_b32 %0, 0" : "=v"(z));
#pragma unroll
    for (int a = 0; a < 2; ++a)
#pragma unroll
        for (int b = 0; b < 2; ++b)
#pragma unroll
            for (int m = 0; m < 4; ++m)
#pragma unroll
                for (int n = 0; n < 2; ++n) acc[a][b][m][n] = (f32x4){z, z, z, z};
}
struct EpiInProj {
    static constexpr bool PERM = true;
    __device__ __forceinline__ void init(f32x4 (&acc)[2][2][4][2], const Unit&, int, int, int, int) const { acc_zero(acc); }
    bf16_t* U; float* ksum; float* nrm; const float* rs;
    __device__ __forceinline__ void operator()(const f32x4 (&acc_)[2][2][4][2], const Unit& u, int wr, int wc, int fr, int fq) const {
        const int row0 = u.pm * BM + wr * 64 + fr, col0 = u.pn * BM + wc * 32 + 8 * fq;
        f32x4 acc[2][2][4][2];
#pragma unroll
        for (int ai = 0; ai < 2; ++ai)
#pragma unroll
            for (int m = 0; m < 4; ++m) { const float sc = rs[row0 + ai * HALF + m * 16];
#pragma unroll
                for (int bj = 0; bj < 2; ++bj) { acc[ai][bj][m][0] = acc_[ai][bj][m][0] * sc; acc[ai][bj][m][1] = acc_[ai][bj][m][1] * sc; } }
        const bool paired = (u.pn >= 2 && u.pn < 6) || u.pn >= 18;
        if (!paired) { const int ocol = (u.pn < 2 ? u.pn * 256 : COL_Q + (u.pn - 6) * 256) + wc * 32 + 8 * fq;
#pragma unroll
          for (int ai = 0; ai < 2; ++ai)
#pragma unroll
            for (int m = 0; m < 4; ++m) { bf16_t* rowp = U + (size_t)(row0 + ai * HALF + m * 16) * UP + ocol;
#pragma unroll
                for (int bj = 0; bj < 2; ++bj) { const f32x4 v0 = acc[ai][bj][m][0], v1 = acc[ai][bj][m][1]; u32x4 w;
                    w.x = cvt_pk_bf16(v0[0], v0[1]); w.y = cvt_pk_bf16(v0[2], v0[3]); w.z = cvt_pk_bf16(v1[0], v1[1]); w.w = cvt_pk_bf16(v1[2], v1[3]);
                    *(u32x4*)(rowp + bj * HALF) = w; } }
        } else { const bool glu = u.pn >= 18; const int ocol = (glu ? COL_HH + (u.pn - 18) * 128 : COL_Z + (u.pn - 2) * 128) + wc * 16 + 4 * fq;
#pragma unroll
          for (int ai = 0; ai < 2; ++ai)
#pragma unroll
            for (int m = 0; m < 4; ++m) { bf16_t* rowp = U + (size_t)(row0 + ai * HALF + m * 16) * UP + ocol;
#pragma unroll
                for (int bj = 0; bj < 2; ++bj) { const f32x4 v0 = acc[ai][bj][m][0], v1 = acc[ai][bj][m][1];
                    float h0, h1, h2, h3;
                    if (glu) { h0 = v0[0] * fast_sigmoid(v0[1]); h1 = v0[2] * fast_sigmoid(v0[3]); h2 = v1[0] * fast_sigmoid(v1[1]); h3 = v1[2] * fast_sigmoid(v1[3]); }
                    else { h0 = v0[0] * v0[1]; h1 = v0[2] * v0[3]; h2 = v1[0] * v1[1]; h3 = v1[2] * v1[3]; }
                    u32x2 w; w.x = cvt_pk_bf16(h0, h1); w.y = cvt_pk_bf16(h2, h3); *(u32x2*)(rowp + bj * (HALF / 2)) = w; } }
        }
        if (u.pn >= GC_Q / 256 && u.pn < GC_V / 256) {
            const int kind = u.pn >= GC_K / 256, hb = 2 * (u.pn - (kind ? GC_K / 256 : GC_Q / 256));
#pragma unroll
            for (int bj = 0; bj < 2; ++bj) { float mx = 0.f;
#pragma unroll
                for (int ai = 0; ai < 2; ++ai)
#pragma unroll
                    for (int m = 0; m < 4; ++m) { const f32x4 a = acc[ai][bj][m][0], c = acc[ai][bj][m][1];
                        float q = (a[0] * a[0] + a[1] * a[1]) + (a[2] * a[2] + a[3] * a[3]) + (c[0] * c[0] + c[1] * c[1]) + (c[2] * c[2] + c[3] * c[3]);
                        q += SWZ_XOR(q, 16); q = half_sum(q); mx = fmaxf(mx, q); }
                mx = fmaxf(mx, SWZ_XOR(mx, 1)); mx = fmaxf(mx, SWZ_XOR(mx, 2)); mx = fmaxf(mx, SWZ_XOR(mx, 4)); mx = fmaxf(mx, SWZ_XOR(mx, 8));
                if ((fr | fq) == 0) nrm[(((kind * 64 + u.pm) * 8 + hb + bj) * 2 + wr) * 4 + wc] = mx; }
        }
        if (u.pn >= GC_K / 256 && u.pn < GC_V / 256) {
            float* kp = ksum + (size_t)(u.pm * 2 + wr) * 1024 + (u.pn - GC_K / 256) * 256 + wc * 32 + 8 * fq;
#pragma unroll
            for (int bj = 0; bj < 2; ++bj)
#pragma unroll
                for (int n = 0; n < 2; ++n) { f32x4 s = (f32x4){0.f, 0.f, 0.f, 0.f};
#pragma unroll
                    for (int ai = 0; ai < 2; ++ai)
#pragma unroll
                        for (int m = 0; m < 4; ++m) s += acc[ai][bj][m][n];
#pragma unroll
                    for (int e = 0; e < 4; ++e) { float t = s[e]; t += SWZ_XOR(t, 1); t += SWZ_XOR(t, 2); t += SWZ_XOR(t, 4); t += SWZ_XOR(t, 8); s[e] = t; }
                    if (fr == 0) *(f32x4*)(kp + bj * HALF + 4 * n) = s; }
        }
    }
};
struct EpiResBf16 {
    static constexpr bool PERM = true;
    const float* resf; bf16_t* out;
    __device__ __forceinline__ void init(f32x4 (&acc)[2][2][4][2], const Unit& u, int wr, int wc, int fr, int fq) const {
        const int row0 = u.pm * BM + wr * 64 + fr, col0 = u.pn * BM + wc * 32 + 8 * fq;
#pragma unroll
        for (int ai = 0; ai < 2; ++ai)
#pragma unroll
            for (int m = 0; m < 4; ++m) { const size_t off = (size_t)(row0 + ai * HALF + m * 16) * DM + col0;
#pragma unroll
                for (int bj = 0; bj < 2; ++bj) {
                    if (resf) { acc[ai][bj][m][0] = __builtin_nontemporal_load((const f32x4*)(resf + off + bj * HALF)); acc[ai][bj][m][1] = __builtin_nontemporal_load((const f32x4*)(resf + off + bj * HALF + 4)); }
                    else { const u32x4 r = *(const u32x4*)(out + off + bj * HALF);
                        acc[ai][bj][m][0] = (f32x4){bf_lo(r.x), bf_hi(r.x), bf_lo(r.y), bf_hi(r.y)}; acc[ai][bj][m][1] = (f32x4){bf_lo(r.z), bf_hi(r.z), bf_lo(r.w), bf_hi(r.w)}; } } }
    }
    __device__ __forceinline__ void operator()(const f32x4 (&acc)[2][2][4][2], const Unit& u, int wr, int wc, int fr, int fq) const {
        const int row0 = u.pm * BM + wr * 64 + fr, col0 = u.pn * BM + wc * 32 + 8 * fq;
#pragma unroll
        for (int ai = 0; ai < 2; ++ai)
#pragma unroll
            for (int m = 0; m < 4; ++m) { const size_t off = (size_t)(row0 + ai * HALF + m * 16) * DM + col0;
#pragma unroll
                for (int bj = 0; bj < 2; ++bj) { const f32x4 v0 = acc[ai][bj][m][0], v1 = acc[ai][bj][m][1];
                    u32x4 w; w.x = cvt_pk_bf16(v0[0], v0[1]); w.y = cvt_pk_bf16(v0[2], v0[3]); w.z = cvt_pk_bf16(v1[0], v1[1]); w.w = cvt_pk_bf16(v1[2], v1[3]);
                    *(u32x4*)(out + off + bj * HALF) = w; } }
    }
};
struct EpiSwiglu {
    static constexpr bool PERM = true;
    __device__ __forceinline__ void init(f32x4 (&acc)[2][2][4][2], const Unit&, int, int, int, int) const { acc_zero(acc); }
    unsigned char* HMo; const float* rs; const int* tokmap; const LAS int* tstart; const LAS int* cnt;
    __device__ __forceinline__ void operator()(const f32x4 (&acc)[2][2][4][2], const Unit& u, int wr, int wc, int fr, int fq) const {
        const int p0 = (u.pm - tstart[u.e]) * BM, cn = cnt[u.e];
#pragma unroll
        for (int ai = 0; ai < 2; ++ai)
#pragma unroll
            for (int m = 0; m < 4; ++m) { const int r = ai * HALF + wr * 64 + m * 16 + fr; int pos = p0 + r; pos = pos < cn ? pos : cn - 1;
                const float sc = rs[tokmap[u.e * T_TOK + pos]] * (1.f / W1_SCALE);
                unsigned char* rowp = HMo + (size_t)(u.pm * BM + r) * DEXP + ((u.pn * BM + wc * 32 + 8 * fq) >> 1);
#pragma unroll
                for (int bj = 0; bj < 2; ++bj) { const f32x4 v0 = acc[ai][bj][m][0] * sc, v1 = acc[ai][bj][m][1] * sc;
                    const float h0 = __builtin_amdgcn_fmed3f(HM_SCALE * v0[0] * fast_sigmoid(v0[0]) * v0[1], -400.f, 400.f), h1 = __builtin_amdgcn_fmed3f(HM_SCALE * v0[2] * fast_sigmoid(v0[2]) * v0[3], -400.f, 400.f);
                    const float h2 = __builtin_amdgcn_fmed3f(HM_SCALE * v1[0] * fast_sigmoid(v1[0]) * v1[1], -400.f, 400.f), h3 = __builtin_amdgcn_fmed3f(HM_SCALE * v1[2] * fast_sigmoid(v1[2]) * v1[3], -400.f, 400.f);
                    int w = 0; w = __builtin_amdgcn_cvt_pk_fp8_f32(h0, h1, w, false); w = __builtin_amdgcn_cvt_pk_fp8_f32(h2, h3, w, true);
                    *(unsigned*)(rowp + bj * (HALF / 2)) = (unsigned)w; } }
    }
};
constexpr float YM_SCALE = 8.f;
struct EpiFp8 {
    static constexpr bool PERM = true;
    __device__ __forceinline__ void init(f32x4 (&acc)[2][2][4][2], const Unit&, int, int, int, int) const { acc_zero(acc); }
    unsigned char* O; int ldc; float osc;
    __device__ __forceinline__ void operator()(const f32x4 (&acc)[2][2][4][2], const Unit& u, int wr, int wc, int fr, int fq) const {
        const int row0 = u.pm * BM + wr * 64 + fr, col0 = u.pn * BM + wc * 32 + 8 * fq;
#pragma unroll
        for (int ai = 0; ai < 2; ++ai)
#pragma unroll
            for (int m = 0; m < 4; ++m) { unsigned char* rowp = O + (size_t)(row0 + ai * HALF + m * 16) * ldc + col0;
#pragma unroll
                for (int bj = 0; bj < 2; ++bj) { f32x4 v0 = acc[ai][bj][m][0] * osc, v1 = acc[ai][bj][m][1] * osc;
#pragma unroll
                    for (int e = 0; e < 4; ++e) { v0[e] = __builtin_amdgcn_fmed3f(v0[e], -400.f, 400.f); v1[e] = __builtin_amdgcn_fmed3f(v1[e], -400.f, 400.f); }
                    int w0 = 0, w1 = 0;
                    w0 = __builtin_amdgcn_cvt_pk_fp8_f32(v0[0], v0[1], w0, false); w0 = __builtin_amdgcn_cvt_pk_fp8_f32(v0[2], v0[3], w0, true);
                    w1 = __builtin_amdgcn_cvt_pk_fp8_f32(v1[0], v1[1], w1, false); w1 = __builtin_amdgcn_cvt_pk_fp8_f32(v1[2], v1[3], w1, true);
                    *(u32x2*)(rowp + bj * HALF) = (u32x2){(unsigned)w0, (unsigned)w1}; } }
    }
};

template <int ES, class Epi, class Sched>
__device__ __forceinline__ void gemm_phase(LAS unsigned char* lds, const int wid, const int K, const Sched& S, const Epi& E) {
#define PG8_LANE(l_) int l_; asm volatile("v_mbcnt_lo_u32_b32 %0, -1, 0\n\tv_mbcnt_hi_u32_b32 %0, -1, %0" : "=v"(l_))
    const int wr = wid >> 2, wc = wid & 3;
    const int nt = K * ES / (BK * 2);
    unsigned voffB[2]; int aoff, boff;
    { PG8_LANE(l0); const int t0 = wid * 64 + l0, fr = l0 & 15, fq = l0 >> 4;
#pragma unroll
      for (int i = 0; i < 2; ++i) { int R, C; stage_rc(t0 * 16 + i * 8192, R, C); const int Rb = Epi::PERM ? ((R & ~31) + perm32(R & 31)) : R;
        voffB[i] = (unsigned)(Rb * K * ES) + (unsigned)C * 2u; }
      aoff = lds_byte(wr * 64 + fr, fq * 8); boff = lds_byte(wc * 32 + fr, fq * 8); }
#define PG8_AROWS(u_, g_) do { PG8_LANE(l_); const int t_ = wid * 64 + l_; int RA[2]; unsigned cofA[2]; \
        _Pragma("unroll") for (int i = 0; i < 2; ++i) { int R, C; stage_rc(t_ * 16 + i * 8192, R, C); RA[i] = R; cofA[i] = (unsigned)C * 2u; } S.a_rows(u_, RA, cofA, g_); } while (0)
    const unsigned kstep = (unsigned)(BK * 2);
    const unsigned hstep = (unsigned)(HALF * K * ES);
    const unsigned ldsw = (unsigned)wid * 1024u;
#define PG8_SA(b, h) (((b) * 2 + (h)) * HTB)
#define PG8_SB(b, h) ((4 + (b) * 2 + (h)) * HTB)
    const __amdgpu_buffer_rsrc_t rsA = __builtin_amdgcn_make_buffer_rsrc((void*)S.A, (short)0, 0x7fffffff, 0x00020000), rsB = __builtin_amdgcn_make_buffer_rsrc((void*)S.Bt, (short)0, 0x7fffffff, 0x00020000);
#define PG8_STG(bufoff, rs, soff, v0, v1) do { \
        __builtin_amdgcn_raw_ptr_buffer_load_lds(rs, (LAS unsigned*)(lds + (bufoff) + ldsw), 16, (int)(v0), (int)(soff), 0, 0); \
        __builtin_amdgcn_raw_ptr_buffer_load_lds(rs, (LAS unsigned*)(lds + (bufoff) + ldsw + 8192), 16, (int)(v1), (int)(soff), 0, 0); } while (0)
#define PG8_LDA(dst, b, h) do { _Pragma("unroll") for (int m = 0; m < 4; ++m) _Pragma("unroll") for (int k = 0; k < 2; ++k) dst[m].pc[k] = *(const LAS bf16x8*)(lds + PG8_SA(b, h) + aoff + m * 2048 + k * 1024); } while (0)
#define PG8_LDB(dst, b, h) do { _Pragma("unroll") for (int n = 0; n < 2; ++n) _Pragma("unroll") for (int k = 0; k < 2; ++k) dst[n].pc[k] = *(const LAS bf16x8*)(lds + PG8_SB(b, h) + boff + n * 2048 + k * 1024); } while (0)
#define PG8_MMA(ai, bj, At, Bt) do { __builtin_amdgcn_s_setprio(1); \
        if constexpr (ES == 2) { _Pragma("unroll") for (int m = 0; m < 4; ++m) _Pragma("unroll") for (int n = 0; n < 2; ++n) _Pragma("unroll") for (int k = 0; k < 2; ++k) \
            acc[ai][bj][m][n] = __builtin_amdgcn_mfma_f32_16x16x32_bf16(Bt[n].pc[k], At[m].pc[k], acc[ai][bj][m][n], 0, 0, 0); } \
        else { _Pragma("unroll") for (int m = 0; m < 4; ++m) _Pragma("unroll") for (int n = 0; n < 2; ++n) \
            asm volatile("v_mfma_scale_f32_16x16x128_f8f6f4 %0, %1, %2, %0, %3, %3 op_sel_hi:[0,0,0]" : "+v"(acc[ai][bj][m][n]) : "v"(__builtin_bit_cast(i32x8v, Bt[n])), "v"(__builtin_bit_cast(i32x8v, At[m])), "v"(mxs)); } \
        __builtin_amdgcn_s_setprio(0); } while (0)
#define PG8_WAIT_V(n) asm volatile("s_waitcnt vmcnt(" #n ")" ::: "memory")
#define PG8_WAIT_L(n) asm volatile("s_waitcnt lgkmcnt(" #n ")" ::: "memory")
#define PG8_BAR __builtin_amdgcn_s_barrier()
#define PG8_SCHED __builtin_amdgcn_sched_barrier(0)
    Unit cur, nxt; int ui = 0;
    if (!S.next(0, cur)) return;
    f32x4 acc[2][2][4][2];
    { PG8_LANE(li); E.init(acc, cur, wr, wc, li & 15, li >> 4); }
    typedef int i32x4v __attribute__((ext_vector_type(4))); typedef int i32x8v __attribute__((ext_vector_type(8)));
    struct Frag { bf16x8 pc[2]; };
    Frag At[4], B0[2], B1[2];
    const int mxs = 0x7F7F7F7F;
    unsigned cA = S.a_off(cur), cB = S.b_off(cur);
    unsigned gc[2][2], gn[2][2];
    PG8_AROWS(cur, gc);
    PG8_STG(PG8_SB(0, 0), rsB, cB, voffB[0], voffB[1]); PG8_STG(PG8_SB(0, 1), rsB, cB + hstep, voffB[0], voffB[1]); PG8_STG(PG8_SA(0, 0), rsA, cA, gc[0][0], gc[0][1]); PG8_STG(PG8_SA(0, 1), rsA, cA, gc[1][0], gc[1][1]);
    if (wr == 1) PG8_BAR;
    PG8_WAIT_V(2); PG8_BAR;
    PG8_STG(PG8_SB(1, 0), rsB, cB + kstep, voffB[0], voffB[1]); PG8_STG(PG8_SA(1, 0), rsA, cA + kstep, gc[0][0], gc[0][1]); PG8_STG(PG8_SB(1, 1), rsB, cB + hstep + kstep, voffB[0], voffB[1]);
    PG8_WAIT_V(6); PG8_BAR;
    for (;;) {
        const bool has_next = S.next(ui + 1, nxt);
        const unsigned nA = has_next ? S.a_off(nxt) : cA, nB = has_next ? S.b_off(nxt) : cB;
        if (has_next) PG8_AROWS(nxt, gn);
        else { gn[0][0] = gc[0][0]; gn[0][1] = gc[0][1]; gn[1][0] = gc[1][0]; gn[1][1] = gc[1][1]; }
#pragma unroll 1
        for (int t = 0; t < nt; t += 2) {
            const bool last = (t == nt - 2);
            const unsigned a1 = cA + (unsigned)(t + 1) * kstep;
            const unsigned a2 = last ? nA : cA + (unsigned)(t + 2) * kstep, b2 = last ? nB : cB + (unsigned)(t + 2) * kstep;
            const unsigned a3 = a2 + kstep, b3 = b2 + kstep;
            const unsigned g00 = last ? gn[0][0] : gc[0][0], g01 = last ? gn[0][1] : gc[0][1], g10 = last ? gn[1][0] : gc[1][0], g11 = last ? gn[1][1] : gc[1][1];
            PG8_LDB(B0, 0, 0); PG8_LDB(B1, 0, 1); PG8_SCHED; PG8_LDA(At, 0, 0); PG8_STG(PG8_SA(1, 1), rsA, a1, gc[1][0], gc[1][1]);
            PG8_WAIT_V(8); PG8_WAIT_L(0); PG8_BAR; PG8_MMA(0, 0, At, B0); PG8_MMA(0, 1, At, B1); PG8_BAR; PG8_SCHED;
            PG8_LDA(At, 0, 1); PG8_STG(PG8_SB(0, 0), rsB, b2, voffB[0], voffB[1]); PG8_STG(PG8_SB(0, 1), rsB, b2 + hstep, voffB[0], voffB[1]); PG8_STG(PG8_SA(0, 0), rsA, a2, g00, g01);
            PG8_WAIT_V(8); PG8_WAIT_L(0); PG8_BAR; PG8_MMA(1, 0, At, B0); PG8_MMA(1, 1, At, B1); PG8_BAR; PG8_SCHED;
            PG8_LDB(B0, 1, 0); PG8_LDB(B1, 1, 1); PG8_SCHED; PG8_LDA(At, 1, 0); PG8_STG(PG8_SA(0, 1), rsA, a2, g10, g11);
            PG8_WAIT_V(8); PG8_WAIT_L(0); PG8_BAR; PG8_MMA(0, 0, At, B0); PG8_MMA(0, 1, At, B1); PG8_BAR; PG8_SCHED;
            PG8_LDA(At, 1, 1); PG8_STG(PG8_SB(1, 0), rsB, b3, voffB[0], voffB[1]); PG8_STG(PG8_SB(1, 1), rsB, b3 + hstep, voffB[0], voffB[1]); PG8_STG(PG8_SA(1, 0), rsA, a3, g00, g01);
            PG8_WAIT_V(8); PG8_WAIT_L(0); PG8_BAR; PG8_MMA(1, 0, At, B0); PG8_MMA(1, 1, At, B1); PG8_BAR; PG8_SCHED;
        }
        if (wr == 0) PG8_BAR;
        if constexpr (ES == 1) asm volatile("s_nop 15\n\ts_nop 7" ::: "memory");
        { PG8_LANE(le); E(acc, cur, wr, wc, le & 15, le >> 4); }
        if (!has_next) break;
        { PG8_LANE(li); E.init(acc, nxt, wr, wc, li & 15, li >> 4); }
        cur = nxt; cA = nA; cB = nB; gc[0][0] = gn[0][0]; gc[0][1] = gn[0][1]; gc[1][0] = gn[1][0]; gc[1][1] = gn[1][1]; ++ui;
        if (wr == 1) PG8_BAR;
    }
    PG8_WAIT_V(0);
    PG8_BAR;
#undef PG8_AROWS
#undef PG8_LANE
#undef PG8_SA
#undef PG8_SB
#undef PG8_STG
#undef PG8_LDA
#undef PG8_LDB
#undef PG8_MMA
#undef PG8_WAIT_V
#undef PG8_WAIT_L
#undef PG8_BAR
#undef PG8_SCHED
}
}

namespace att {
constexpr float SCALE = 0.088388347648318440f;
constexpr float THR = 8.f;
constexpr int KVBLK = 64, QBLK = 32;
constexpr size_t SHM_V = KVBLK * HD * 2, SHM_K = KVBLK * HD * 2;
constexpr int NRING = 2;
constexpr int OFF_V = 0, OFF_K = NRING * SHM_V, OFF_WS = OFF_K + NRING * SHM_K, OFF_KM = OFF_WS + NWAVES * 64 * 4, ATT_LDS = OFF_KM + 32 * 256;
#define KSWZ(row, colB) ((row) * 256 + ((colB) ^ (((row) & 7) << 4)))
#define SBAR() __builtin_amdgcn_sched_barrier(0)
__device__ __forceinline__ int crow(int r, int hi) { return (r & 3) + 8 * (r >> 2) + 4 * hi; }

__device__ __forceinline__ void partialSM(f32x16& p0, f32x16& p1, float& m_reg, float& mn, float& alpha, float slr, float lb, int mode, int thr) {
    constexpr float C = SCALE * 1.4426950408889634f;
#pragma unroll
    for (int r = 0; r < 16; ++r) { const float cr = (float)((r & 3) + 8 * (r >> 2)); p0[r] = fmaf(slr, cr, p0[r]); p1[r] = fmaf(slr, cr + 32.f, p1[r]); }
    if (mode) {
        if (mode == 1) {
#pragma unroll
            for (int r = 0; r < 16; ++r) { if ((r & 3) + 8 * (r >> 2) > thr) p0[r] = -3.0e38f; p1[r] = -3.0e38f; }
        } else {
#pragma unroll
            for (int r = 0; r < 16; ++r) { if ((r & 3) + 8 * (r >> 2) > thr) p1[r] = -3.0e38f; }
        }
    }
    float pmax = p0[0];
#pragma unroll
    for (int r = 1; r < 16; ++r) pmax = fmaxf(pmax, p0[r]);
#pragma unroll
    for (int r = 0; r < 16; ++r) pmax = fmaxf(pmax, p1[r]);
    pmax += lb;
    { auto rr = __builtin_amdgcn_permlane32_swap(__float_as_uint(pmax), __float_as_uint(pmax), false, false);
      pmax = fmaxf(__uint_as_float(rr[0]), __uint_as_float(rr[1])); }
    if (__builtin_expect(__all(pmax - m_reg <= THR / SCALE), 1)) { mn = m_reg; alpha = 1.f; }
    else { mn = fmaxf(m_reg, pmax); alpha = __builtin_amdgcn_exp2f((m_reg - mn) * C); m_reg = mn; }
    const float mnC = (lb - mn) * C;
#pragma unroll
    for (int r = 0; r < 16; ++r) p0[r] = fmaf(p0[r], C, mnC);
#pragma unroll
    for (int r = 0; r < 16; ++r) p1[r] = fmaf(p1[r], C, mnC);
#pragma unroll
    for (int r = 0; r < 16; ++r) p0[r] = __builtin_amdgcn_exp2f(p0[r]);
}
__device__ __forceinline__ void finishSM(f32x16& p0, f32x16& p1, float alpha, float& l_reg, bf16x8& pa0, bf16x8& pa1, bf16x8& pa2, bf16x8& pa3) {
#pragma unroll
    for (int r = 0; r < 16; ++r) p1[r] = __builtin_amdgcn_exp2f(p1[r]);
    float ps = 0;
#pragma unroll
    for (int r = 0; r < 16; ++r) ps += p0[r];
#pragma unroll
    for (int r = 0; r < 16; ++r) ps += p1[r];
    { auto rr = __builtin_amdgcn_permlane32_swap(__float_as_uint(ps), __float_as_uint(ps), false, false);
      ps = __uint_as_float(rr[0]) + __uint_as_float(rr[1]); }
    l_reg = l_reg * alpha + ps;
#define PK4(P, BASE, OUT) do { unsigned a0 = cvt_pk_bf16(P[BASE + 0], P[BASE + 1]), a1 = cvt_pk_bf16(P[BASE + 2], P[BASE + 3]);   \
    unsigned b0 = cvt_pk_bf16(P[BASE + 4], P[BASE + 5]), b1 = cvt_pk_bf16(P[BASE + 6], P[BASE + 7]);                              \
    auto r0 = __builtin_amdgcn_permlane32_swap(a0, b0, false, false); auto r1 = __builtin_amdgcn_permlane32_swap(a1, b1, false, false); \
    u32x4 w = {r0[0], r1[0], r0[1], r1[1]}; OUT = *reinterpret_cast<bf16x8*>(&w); } while (0)
    PK4(p0, 0, pa0); PK4(p0, 8, pa1); PK4(p1, 0, pa2); PK4(p1, 8, pa3);
#undef PK4
}
__device__ __forceinline__ void qkt(f32x16& p0, f32x16& p1, const char* Ks, const bf16x8* qr, int r32, int hi) {
    p0 = f32x16{}; p1 = f32x16{};
    int lowb = (hi * 16) ^ ((r32 & 7) << 4);
    asm volatile("" : "+v"(lowb));
    const char* Kr = Ks + r32 * 256;
#pragma unroll
    for (int d0 = 0; d0 < 8; ++d0) { const int cb = (d0 * 32) ^ lowb;
        const bf16x8 b0 = *reinterpret_cast<const bf16x8*>(Kr + cb);
        const bf16x8 b1 = *reinterpret_cast<const bf16x8*>(Kr + 32 * 256 + cb);
        p0 = __builtin_amdgcn_mfma_f32_32x32x16_bf16(b0, qr[d0], p0, 0, 0, 0);
        p1 = __builtin_amdgcn_mfma_f32_32x32x16_bf16(b1, qr[d0], p1, 0, 0, 0); }
}
__device__ __forceinline__ int v_st(int k, int c) { const int kk = (k & ~0xC) | ((k & 4) << 1) | ((k & 8) >> 1); return ((kk >> 3) * 4 + (c >> 5)) * 512 + ((kk & 7) * 32 + (c & 31)) * 2; }
__device__ __forceinline__ int v_rd_base(int lane) { return ((lane & 3) << 3) | (((lane >> 2) & 3) << 6) | (((lane >> 4) & 1) << 5) | (((lane >> 5) & 1) << 8); }
constexpr int v_rd_off(int d0, int ks, int half) { return d0 * 512 + ks * 4096 + half * 2048; }
template <int OFF> __device__ __forceinline__ s16x4 tr_read(int vb) {
    s16x4 r; asm volatile("ds_read_b64_tr_b16 %0, %1 offset:%2" : "=&v"(r) : "v"(vb), "i"(OFF) : "memory"); return r;
}
template <int D0> __device__ __forceinline__ void pv_one(f32x16& od, int vb, bf16x8 pa0, bf16x8 pa1, bf16x8 pa2, bf16x8 pa3) {
    const s16x4 l0 = tr_read<v_rd_off(D0, 0, 0)>(vb), h0 = tr_read<v_rd_off(D0, 0, 1)>(vb), l1 = tr_read<v_rd_off(D0, 1, 0)>(vb), h1 = tr_read<v_rd_off(D0, 1, 1)>(vb);
    const s16x4 l2 = tr_read<v_rd_off(D0, 2, 0)>(vb), h2 = tr_read<v_rd_off(D0, 2, 1)>(vb), l3 = tr_read<v_rd_off(D0, 3, 0)>(vb), h3 = tr_read<v_rd_off(D0, 3, 1)>(vb);
    asm volatile("s_waitcnt lgkmcnt(0)" ::: "memory"); SBAR();
#define PK(L, H) (bf16x8){L[0], L[1], L[2], L[3], H[0], H[1], H[2], H[3]}
    od = __builtin_amdgcn_mfma_f32_32x32x16_bf16(pa0, PK(l0, h0), od, 0, 0, 0);
    od = __builtin_amdgcn_mfma_f32_32x32x16_bf16(pa1, PK(l1, h1), od, 0, 0, 0);
    od = __builtin_amdgcn_mfma_f32_32x32x16_bf16(pa2, PK(l2, h2), od, 0, 0, 0);
    od = __builtin_amdgcn_mfma_f32_32x32x16_bf16(pa3, PK(l3, h3), od, 0, 0, 0);
#undef PK
}
__device__ __forceinline__ void pv_d0(f32x16* o, int vb, bf16x8 pa0, bf16x8 pa1, bf16x8 pa2, bf16x8 pa3) {
    pv_one<0>(o[0], vb, pa0, pa1, pa2, pa3); pv_one<1>(o[1], vb, pa0, pa1, pa2, pa3); pv_one<2>(o[2], vb, pa0, pa1, pa2, pa3); pv_one<3>(o[3], vb, pa0, pa1, pa2, pa3);
}

constexpr int MAXP = 8;
struct ItemTable { unsigned short v[64][MAXP]; };
constexpr int head_cap(int h) { return h == 0 ? 1 : h == 1 ? 2 : h == 2 ? 3 : h == 3 ? 5 : h == 4 ? 10 : 16; }
constexpr ItemTable make_items() {
    ItemTable t{};
    for (int i = 0; i < 64; ++i) for (int j = 0; j < MAXP; ++j) t.v[i][j] = 0xFFFF;
    const int kh[8] = {3, 4, 5, 7, 10, 12, 12, 11};
    int bin0 = 0;
    for (int h = 0; h < 8; ++h) { const int k = kh[h];
        unsigned short code[32] = {}; int cost[32] = {}; int n = 0;
        for (int qb = 0; qb < 16; ++qb) { const int npast = qb < head_cap(h) ? qb : head_cap(h); const bool split = (h >= 5 && qb >= 12);
            if (split) { code[n] = (unsigned short)(h | (qb << 3) | (0 << 7) | (1 << 8)); cost[n] = 8; ++n; code[n] = (unsigned short)(h | (qb << 3) | (1 << 7) | (1 << 8)); cost[n] = npast - 7; ++n; }
            else { code[n] = (unsigned short)(h | (qb << 3)); cost[n] = 1 + npast; ++n; } }
        for (int i = 1; i < n; ++i) { const unsigned short xv = code[i]; const int c = cost[i]; int j = i - 1;
            while (j >= 0 && cost[j] < c) { code[j + 1] = code[j]; cost[j + 1] = cost[j]; --j; }
            code[j + 1] = xv; cost[j + 1] = c; }
        int load[16] = {}; int cnt[16] = {};
        for (int i = 0; i < n; ++i) { int best = 0; for (int j = 1; j < k; ++j) if (load[j] < load[best]) best = j;
            if (cnt[best] < MAXP) { t.v[bin0 + best][cnt[best]] = code[i]; ++cnt[best]; load[best] += cost[i] + 1; } }
        bin0 += k; }
    return t;
}
__device__ const ItemTable ATT_ITEMS = make_items();
constexpr float CUT_MARGIN = 40.f;

__device__ __forceinline__ void attn_item(const int tid, const int b, const int h, const int qb, const bool with_own, const int n_lo, const int n_hi, const int mode,
                                          const int slot, const int l, unsigned char* __restrict__ wsb, char* lds) {
    const bf16_t* __restrict__ U = (const bf16_t*)(wsb + WS_U); const float* __restrict__ ksum = (const float*)(wsb + WS_KS); bf16_t* __restrict__ Y = (bf16_t*)(wsb + WS_Y);
    float* __restrict__ part = (float*)(wsb + WS_PART) + (size_t)slot * 66 * 512; int* __restrict__ tick = (int*)(wsb + WS_CTL) + 12544 + 128 * l + 2 * slot;
    const int wid = tid >> 6, lane = tid & 63, r32 = lane & 31, hi = lane >> 5;
    char* V_lds = lds + OFF_V; char* K_lds = lds + OFF_K; char* KM = lds + OFF_KM;
    float* ws = (float*)(lds + OFF_WS) + wid * 64; float* li_l = ws; float* al_l = ws + 32;
    const bf16_t* Qb = U + (size_t)(b * SEQ + qb * 256) * UP + COL_Q + h * HD;
    float m_reg = -1e29f, l_reg = 0; f32x16 o[4] = {}; bf16x8 qr[8];
    { const bf16_t* Qw = Qb + (size_t)(wid * QBLK + r32) * UP + hi * 8;
#pragma unroll
      for (int d0 = 0; d0 < 8; ++d0) qr[d0] = *reinterpret_cast<const bf16x8*>(Qw + d0 * 16); }
    { const int n = tid >> 5, c4 = (tid & 31) * 4;
      const float* k0p = ksum + (size_t)((b * 16 + n) * 2) * 1024 + h * HD + c4;
      const f32x4 s0 = *(const f32x4*)k0p, s1 = *(const f32x4*)(k0p + 1024);
      u32x2 w; w.x = cvt_pk_bf16((s0[0] + s1[0]) * (1.f / 256.f), (s0[1] + s1[1]) * (1.f / 256.f)); w.y = cvt_pk_bf16((s0[2] + s1[2]) * (1.f / 256.f), (s0[3] + s1[3]) * (1.f / 256.f));
      *(u32x2*)(KM + KSWZ(n, c4 * 2)) = w;
      *(u32x2*)(KM + KSWZ(16 + n, c4 * 2)) = (u32x2){0u, 0u}; }
    __syncthreads();
    unsigned selmask = 0u;
    { f32x16 g = f32x16{};
#pragma unroll
      for (int d0 = 0; d0 < 8; ++d0) { const int cb = (d0 * 16 + hi * 8) * 2; const bf16x8 a = *reinterpret_cast<const bf16x8*>(KM + KSWZ(r32, cb)); g = __builtin_amdgcn_mfma_f32_32x32x16_bf16(a, qr[d0], g, 0, 0, 0); }
      float G[16];
#pragma unroll
      for (int r = 0; r < 8; ++r) { auto rr = __builtin_amdgcn_permlane32_swap(__float_as_uint(g[r]), __float_as_uint(g[r]), false, false);
          const float other = hi ? __uint_as_float(rr[0]) : __uint_as_float(rr[1]);
          const int nlo = (r & 3) + 8 * (r >> 2);
          G[nlo] = hi ? other : g[r]; G[nlo + 4] = hi ? g[r] : other; }
#pragma unroll
      for (int n = 0; n < 16; ++n) if (n >= qb) G[n] = -INFINITY;
      const int npick = qb < 3 ? qb : 3;
#pragma unroll
      for (int it = 0; it < 3; ++it) { if (it < npick) { float best = G[0]; int bi = 0;
#pragma unroll
          for (int n = 1; n < 16; ++n) if (G[n] > best) { best = G[n]; bi = n; }
          selmask |= 1u << bi;
#pragma unroll
          for (int n = 0; n < 16; ++n) if (n == bi) G[n] = -INFINITY; } } }
    const float slr = __uint_as_float(__builtin_amdgcn_readfirstlane(__float_as_uint(__builtin_amdgcn_exp2f(-(float)(h + 1)) * (1.f / SCALE))));
    const int tp4 = qb * 256 + wid * QBLK + r32 - 4 * hi;
    const int jo = with_own ? 4 : 0;
    const int NT = jo + 4 * (n_hi - n_lo);
    const int kb_own = qb * 256, kb_past = n_lo * 256 - 64 * jo;
#define KST(j) (((j) < jo ? kb_own : kb_past) + 64 * (j))
#define LBV(j) ((((j) < jo) ? ((j) > (wid >> 1)) : !((selmask >> (n_lo + (((j) - jo) >> 2))) & 1u)) ? -1e30f : slr * (float)(KST(j) - tp4))
    const int vb0 = (int)(uintptr_t)V_lds + v_rd_base(lane);
    unsigned koff, voff;
    { const int row = 4 * wid + (lane >> 4), cc = lane & 15; koff = (unsigned)(row * UP * 2 + ((cc ^ (row & 7)) << 4)) + (unsigned)(COL_K * 2); }
    { const int st = 2 * wid + (lane >> 5), kk = (st >> 2) * 8 + ((lane & 31) >> 2), k = (kk & ~0xC) | ((kk & 4) << 1) | ((kk & 8) >> 1), col = 32 * (st & 3) + 8 * (lane & 3);
      voff = (unsigned)(k * UP * 2 + col * 2) + (unsigned)(COL_V * 2); }
    const int wq = __builtin_amdgcn_readfirstlane(wid);
    LAS unsigned char* ldsL = (LAS unsigned char*)(unsigned)(uintptr_t)lds;
    const char* Ubh = (const char*)(U + (size_t)(b * SEQ) * UP + h * HD);
#define DMAK(bb, k0) do { const unsigned uo_ = (unsigned)((k0) * (UP * 2)); \
    __builtin_amdgcn_global_load_lds((const unsigned*)(Ubh + (koff + uo_)), (LAS unsigned*)(ldsL + OFF_K + (bb) * SHM_K + wq * 1024), 16, 0, 0); \
    __builtin_amdgcn_global_load_lds((const unsigned*)(Ubh + (koff + uo_ + 32u * UP * 2u)), (LAS unsigned*)(ldsL + OFF_K + (bb) * SHM_K + (wq + 8) * 1024), 16, 0, 0); } while (0)
#define DMAV(bb, k0) do { const unsigned uo_ = (unsigned)((k0) * (UP * 2)); \
    __builtin_amdgcn_global_load_lds((const unsigned*)(Ubh + (voff + uo_)), (LAS unsigned*)(ldsL + OFF_V + (bb) * SHM_V + wq * 1024), 16, 0, 0); \
    __builtin_amdgcn_global_load_lds((const unsigned*)(Ubh + (voff + uo_ + 32u * UP * 2u)), (LAS unsigned*)(ldsL + OFF_V + (bb) * SHM_V + (wq + 8) * 1024), 16, 0, 0); } while (0)
#define RESC(a) do { if (__any((a) < 1.f)) { if (hi == 0) al_l[r32] = (a); asm volatile("s_waitcnt lgkmcnt(0)" ::: "memory"); \
    _Pragma("unroll") for (int d = 0; d < 4; ++d) _Pragma("unroll") for (int r = 0; r < 16; ++r) o[d][r] *= al_l[crow(r, hi)]; } } while (0)
    if (NT > 0) {
    f32x16 pA0, pA1, pB0, pB1; float mnA, mnB, alA, alB; bf16x8 pa0, pa1, pa2, pa3;
#define PSM(P0, P1, MN, AL, j) partialSM(P0, P1, m_reg, MN, AL, slr, LBV(j), ((j) < jo && (j) == (wid >> 1)) ? 1 + (wid & 1) : 0, r32 - 4 * hi)
#define WBAR(N) asm volatile("s_waitcnt vmcnt(" #N ") lgkmcnt(0)\n\ts_barrier" ::: "memory")
#define STEP(PC0, PC1, MNC, ALC, PP0, PP1, ALP, j, sl) do { \
        DMAV(sl, KST(j)); \
        SBAR(); qkt(PC0, PC1, K_lds + (sl) * SHM_K, qr, r32, hi); \
        finishSM(PP0, PP1, ALP, l_reg, pa0, pa1, pa2, pa3); SBAR(); \
        WBAR(4); \
        if ((j) + 2 < NT) DMAK(sl, KST((j) + 2)); \
        pv_d0(o, vb0 + (1 - (sl)) * (int)SHM_V, pa0, pa1, pa2, pa3); PSM(PC0, PC1, MNC, ALC, j); \
        if ((j) + 2 < NT) WBAR(4); else WBAR(0); RESC(ALC); } while (0)
    DMAK(0, KST(0)); DMAK(1, KST(1)); DMAV(0, KST(0)); WBAR(4);
    qkt(pA0, pA1, K_lds, qr, r32, hi);
    WBAR(4);
    DMAK(0, KST(2)); PSM(pA0, pA1, mnA, alA, 0);
    WBAR(4); RESC(alA);
    for (int j = 1; j + 1 < NT; j += 2) {
        STEP(pB0, pB1, mnB, alB, pA0, pA1, alA, j, 1);
        STEP(pA0, pA1, mnA, alA, pB0, pB1, alB, j + 1, 0);
    }
    STEP(pB0, pB1, mnB, alB, pA0, pA1, alA, NT - 1, 1);
    finishSM(pB0, pB1, alB, l_reg, pa0, pa1, pa2, pa3); SBAR();
    pv_d0(o, vb0 + (int)SHM_V, pa0, pa1, pa2, pa3);
#undef STEP
#undef WBAR
#undef PSM
    }
    bool write_out = true;
    if (mode == 1) {
        __syncthreads();
        int* tk = (int*)(lds + OFF_WS + NWAVES * 64 * 4 - 16);
        if (tid == 0) tk[0] = __hip_atomic_fetch_add(tick, 1, __ATOMIC_RELAXED, __HIP_MEMORY_SCOPE_AGENT);
        __syncthreads();
        const int t = __builtin_amdgcn_readfirstlane(tk[0]);
        __syncthreads();
        if (t == 0) {
#pragma unroll
            for (int d = 0; d < 4; ++d)
#pragma unroll
                for (int r = 0; r < 16; ++r) __hip_atomic_store(part + (size_t)(d * 16 + r) * 512 + tid, o[d][r], __ATOMIC_RELAXED, __HIP_MEMORY_SCOPE_AGENT);
            __hip_atomic_store(part + (size_t)64 * 512 + tid, m_reg, __ATOMIC_RELAXED, __HIP_MEMORY_SCOPE_AGENT);
            __hip_atomic_store(part + (size_t)65 * 512 + tid, l_reg, __ATOMIC_RELAXED, __HIP_MEMORY_SCOPE_AGENT);
            asm volatile("s_waitcnt vmcnt(0)" ::: "memory");
            __syncthreads();
            if (tid == 0) __hip_atomic_store(tick + 1, 1, __ATOMIC_RELAXED, __HIP_MEMORY_SCOPE_AGENT);
            write_out = false;
        } else {
            if (tid < 64) { unsigned sp = 0;
                while (__builtin_amdgcn_readfirstlane(__hip_atomic_load(tick + 1, __ATOMIC_RELAXED, __HIP_MEMORY_SCOPE_AGENT)) == 0) { __builtin_amdgcn_s_sleep(2); if (++sp > (1u << 22)) break; }
                __builtin_amdgcn_fence(__ATOMIC_ACQUIRE, "agent");
                asm volatile("s_waitcnt vmcnt(0)" ::: "memory"); }
            __syncthreads();
            constexpr float C = SCALE * 1.4426950408889634f;
            const float m2 = part[(size_t)64 * 512 + tid], l2 = part[(size_t)65 * 512 + tid];
            const float mn = fmaxf(m_reg, m2), a1 = __builtin_amdgcn_exp2f((m_reg - mn) * C), a2 = __builtin_amdgcn_exp2f((m2 - mn) * C);
            { float t1 = l_reg * a1, t2 = l2 * a2; asm volatile("" : "+v"(t1), "+v"(t2)); l_reg = t1 + t2; }
            if (hi == 0) { al_l[r32] = a1; li_l[r32] = a2; }
            asm volatile("s_waitcnt lgkmcnt(0)" ::: "memory");
#pragma unroll
            for (int d = 0; d < 4; ++d)
#pragma unroll
                for (int r = 0; r < 16; ++r) { float t1 = o[d][r] * al_l[crow(r, hi)], t2 = part[(size_t)(d * 16 + r) * 512 + tid] * li_l[crow(r, hi)]; asm volatile("" : "+v"(t1), "+v"(t2)); o[d][r] = t1 + t2; }
            asm volatile("s_waitcnt lgkmcnt(0)" ::: "memory");
        }
    }
    if (write_out) {
    if (hi == 0) li_l[r32] = l_reg; asm volatile("s_waitcnt lgkmcnt(0)" ::: "memory");
    float rli[16];
#pragma unroll
    for (int r = 0; r < 16; ++r) rli[r] = __builtin_amdgcn_rcpf(li_l[crow(r, hi)]);
    bf16_t* Ow = Y + (size_t)(b * SEQ + qb * 256 + wid * QBLK) * DM + 512 + h * HD;
#pragma unroll
    for (int r = 0; r < 16; ++r) { const int orow = crow(r, hi);
#pragma unroll
        for (int d0 = 0; d0 < 4; ++d0) { const float v = o[d0][r] * rli[r]; Ow[(size_t)orow * DM + d0 * 32 + r32] = (bf16_t)(cvt_pk_bf16(v, v) & 0xffffu); } }
    }
    __syncthreads();
#undef KST
#undef LBV
#undef DMAK
#undef DMAV
#undef RESC
}
#undef KSWZ
#undef SBAR
}


#define XB_TMO      128
#define XB_XCNT(j)  (256  + 64 * (j))
#define XB_XSUB(j)  (1280 + 64 * (j))
#define XB_XGEN(j)  (2304 + 64 * (j))
#define XB_TOP      3328
#define XB_TOPGEN   3392
#define XCD_BAR_WORDS 3456
#define XB_SPIN_CAP (1u << 18)
__device__ __forceinline__ unsigned xb_ld(unsigned* p)              { return __hip_atomic_load(p, __ATOMIC_RELAXED, __HIP_MEMORY_SCOPE_AGENT); }
__device__ __forceinline__ unsigned xb_add(unsigned* p, unsigned v) { return __hip_atomic_fetch_add(p, v, __ATOMIC_RELAXED, __HIP_MEMORY_SCOPE_AGENT); }
__device__ __forceinline__ unsigned xb_xcc_id() { return (unsigned)__builtin_amdgcn_s_getreg((3 << 11) | 20) & 0xFu; }
#define XB_SPIN(cond, bar) do { unsigned _sp = 0; while (cond) { __builtin_amdgcn_s_sleep(1); \
    if ((++_sp & 255u) == 0u) { if (xb_ld(&(bar)[XB_TMO])) break; if (_sp > XB_SPIN_CAP) { atomicAdd(&(bar)[XB_TMO], 1u); break; } } } } while (0)
struct XcdBarrier { unsigned* bar; unsigned x; volatile LAS unsigned* st; };
__device__ __forceinline__ XcdBarrier xcd_barrier_post(unsigned* bar, volatile LAS unsigned* st) {
    XcdBarrier b; b.bar = bar; b.x = xb_xcc_id(); b.st = st;
    if (threadIdx.x == 0) (void)xb_add(&bar[XB_XCNT(b.x)], 1u);
    return b;
}
__device__ __forceinline__ void xcd_barrier_complete(unsigned* bar, unsigned x, unsigned& nloc, unsigned& nx) {
    const unsigned G = gridDim.x * gridDim.y * gridDim.z;
    unsigned sum, cnt, mine, sp = 0u;
    for (;;) {
        sum = 0u; cnt = 0u;
#pragma unroll 1
        for (unsigned j = 0; j < 16; ++j) { const unsigned c = xb_ld(&bar[XB_XCNT(j)]); sum += c; cnt += (c > 0u) ? 1u : 0u; }
        mine = xb_ld(&bar[XB_XCNT(x)]);
        if (sum == G) break;
        __builtin_amdgcn_s_sleep(1);
        if ((++sp & 255u) == 0u) { if (xb_ld(&bar[XB_TMO])) break; if (sp > XB_SPIN_CAP) { atomicAdd(&bar[XB_TMO], 1u); break; } }
    }
    nloc = mine > 0u ? mine : 1u; nx = cnt > 0u ? cnt : 1u;
}
__device__ __forceinline__ void xcd_barrier(const XcdBarrier& b) {
    asm volatile("s_waitcnt vmcnt(0)" ::: "memory");
    __syncthreads();
    if (threadIdx.x == 0) {
        unsigned* bar = b.bar; asm volatile("" : "+s"(bar));
        __builtin_amdgcn_s_waitcnt(0);
        unsigned nloc = b.st[0], nx = b.st[1];
        if (nloc == 0u) { xcd_barrier_complete(bar, b.x, nloc, nx); b.st[0] = nloc; b.st[1] = nx; }
        const unsigned old = xb_add(&bar[XB_XSUB(b.x)], 1u);
        const unsigned gen = old / nloc;
        if (old + 1u == (gen + 1u) * nloc) {
            __builtin_amdgcn_fence(__ATOMIC_RELEASE, "agent");
            asm volatile("s_waitcnt vmcnt(0)" ::: "memory");
            const unsigned og = xb_add(&bar[XB_TOP], 1u);
            const unsigned tg = og / nx;
            if (og + 1u == (tg + 1u) * nx) xb_add(&bar[XB_TOPGEN], 1u);
            else XB_SPIN(xb_ld(&bar[XB_TOPGEN]) == tg, bar);
            __builtin_amdgcn_fence(__ATOMIC_ACQUIRE, "agent");
            xb_add(&bar[XB_XGEN(b.x)], 1u);
            asm volatile("s_waitcnt vmcnt(0)" ::: "memory");
        } else {
            XB_SPIN(xb_ld(&bar[XB_XGEN(b.x)]) == gen, bar);
            __builtin_amdgcn_fence(__ATOMIC_ACQUIRE, "agent");
            asm volatile("s_waitcnt vmcnt(0)" ::: "memory");
        }
    }
    __syncthreads();
}

struct Params { const float* in[18]; float* out; unsigned char* ws; int ph_lo, ph_hi; };
enum { IN_X = 0, IN_N1G, IN_WIN, IN_CAW, IN_CCW, IN_CCB, IN_LNG, IN_LNB, IN_WOUT, IN_N2G, IN_RGW, IN_RGB, IN_REW, IN_REB, IN_WG, IN_WU, IN_WD, IN_FG };

struct TrItem { const float* src; unsigned char* dst; const float* scale; float mult; int N, K, k0, n0, rmul, radd, es; };
constexpr int TR_I_IN = (DM / 128) * (DIN / 32), TR_I_OUT = (DM / 128) * (DM / 32), TR_I_G = NEXP * (DM / 128) * (DEXP / 32), TR_I_D = NEXP * (DEXP / 128) * (DM / 32), TR_I_ALL = TR_I_IN + TR_I_OUT + 2 * TR_I_G + TR_I_D;
__device__ __forceinline__ void tr_params(const Params& p, unsigned char* ws, int it, TrItem& t) {
    const int l = it / TR_I_ALL; int r = it - l * TR_I_ALL; unsigned char* wl = ws + WS_W0 + (size_t)l * SZ_LAYER;
    size_t dstb = 0; t.rmul = 1; t.radd = 0; t.scale = nullptr; t.mult = 1.f; t.es = 1;
    if (r < TR_I_IN) { t.src = p.in[IN_WIN] + (size_t)l * DM * DIN; t.K = DM; t.N = DIN; t.dst = wl + OFF_WIN; t.scale = p.in[IN_N1G] + l * DM; t.es = 2; }
    else if ((r -= TR_I_IN) < TR_I_OUT) { t.src = p.in[IN_WOUT] + (size_t)l * DM * DM; t.K = DM; t.N = DM; t.dst = wl + OFF_WOUT; t.es = 2; }
    else if ((r -= TR_I_OUT) < TR_I_G) { t.src = p.in[IN_WG] + (size_t)l * NEXP * DM * DEXP; t.K = DM; t.N = DEXP; t.dst = wl + OFF_WGU; dstb = (size_t)1024 * DM; t.rmul = 2; t.scale = p.in[IN_N2G] + l * DM; t.mult = W1_SCALE; }
    else if ((r -= TR_I_G) < TR_I_G) { t.src = p.in[IN_WU] + (size_t)l * NEXP * DM * DEXP; t.K = DM; t.N = DEXP; t.dst = wl + OFF_WGU; dstb = (size_t)1024 * DM; t.rmul = 2; t.radd = 1; t.scale = p.in[IN_N2G] + l * DM; t.mult = W1_SCALE; }
    else { r -= TR_I_G; t.src = p.in[IN_WD] + (size_t)l * NEXP * DEXP * DM; t.K = DEXP; t.N = DM; t.dst = wl + OFF_WD; dstb = (size_t)DM * DEXP; t.mult = W2_SCALE; }
    const int nnb = t.N / 32, per = (t.K / 128) * nnb, bt = r / per, rem = r - bt * per, kb = rem / nnb, nb = rem - kb * nnb;
    t.k0 = kb * 128; t.n0 = nb * 32; t.src += (size_t)bt * t.K * t.N; t.dst += (size_t)bt * dstb;
    if (t.es == 2 && t.N == DIN) { const int n0 = t.n0;
        t.rmul = ((n0 >= 512 && n0 < 1536) || n0 >= 4608) ? 2 : 1;
        t.radd = n0 < 512 ? 0 : n0 < 1024 ? -512 : n0 < 1536 ? -1535 : n0 < 4608 ? 0 : n0 < 5120 ? -4608 : -5631; }
}
__device__ __forceinline__ void tr_load(const TrItem& t, f32x4 (&v)[16], int lane) {
    const float* s = t.src + (size_t)(t.k0 + (lane >> 3)) * t.N + t.n0 + (lane & 7) * 4;
#pragma unroll
    for (int i = 0; i < 16; ++i) v[i] = __builtin_nontemporal_load((const f32x4*)(s + (size_t)(8 * i) * t.N));
}
__device__ __forceinline__ void tr_finish(const TrItem& t, const f32x4 (&v)[16], LAS float* scr, int lane) {
    { LAS float* s = scr + (lane & 7) * 4 * 130 + (lane >> 3);
#pragma unroll
      for (int i = 0; i < 16; ++i) { s[8 * i] = v[i][0]; s[130 + 8 * i] = v[i][1]; s[260 + 8 * i] = v[i][2]; s[390 + 8 * i] = v[i][3]; } }
    const int c = lane & 7, nn = lane >> 3;
    float sc[16];
#pragma unroll
    for (int i = 0; i < 16; ++i) sc[i] = t.mult;
    if (t.scale) {
#pragma unroll
        for (int i = 0; i < 4; ++i) { const f32x4 g = *(const f32x4*)(t.scale + t.k0 + 16 * c + 4 * i); sc[4 * i] *= g[0]; sc[4 * i + 1] *= g[1]; sc[4 * i + 2] *= g[2]; sc[4 * i + 3] *= g[3]; } }
    asm volatile("s_waitcnt lgkmcnt(0)" ::: "memory");
#pragma unroll
    for (int j = 0; j < 4; ++j) { const int n = nn + 8 * j; const LAS float* s = scr + n * 130 + 16 * c;
        float x[16];
#pragma unroll
        for (int i = 0; i < 8; ++i) { const f32x2 q = *(const LAS f32x2*)(s + 2 * i); x[2 * i] = q[0] * sc[2 * i]; x[2 * i + 1] = q[1] * sc[2 * i + 1]; }
        const size_t row = (size_t)((t.n0 + n) * t.rmul + t.radd) * t.K + t.k0 + 16 * c;
        if (t.es == 2) { u32x4 o0, o1;
            o0.x = cvt_pk_bf16(x[0], x[1]); o0.y = cvt_pk_bf16(x[2], x[3]); o0.z = cvt_pk_bf16(x[4], x[5]); o0.w = cvt_pk_bf16(x[6], x[7]);
            o1.x = cvt_pk_bf16(x[8], x[9]); o1.y = cvt_pk_bf16(x[10], x[11]); o1.z = cvt_pk_bf16(x[12], x[13]); o1.w = cvt_pk_bf16(x[14], x[15]);
            u32x4* d = (u32x4*)(t.dst + row * 2); __builtin_nontemporal_store(o0, d); __builtin_nontemporal_store(o1, d + 1); }
        else { u32x4 o; o.x = pk4_fp8(x[0], x[1], x[2], x[3]); o.y = pk4_fp8(x[4], x[5], x[6], x[7]); o.z = pk4_fp8(x[8], x[9], x[10], x[11]); o.w = pk4_fp8(x[12], x[13], x[14], x[15]);
            __builtin_nontemporal_store(o, (u32x4*)(t.dst + row)); } }
    asm volatile("s_waitcnt lgkmcnt(0)" ::: "memory");
}
__device__ __forceinline__ void norm_row_f32(const float* __restrict__ xrow, bf16_t* __restrict__ xout, float* __restrict__ rsout, int lane) {
    f32x4 v[8]; float ss = 0.f;
#pragma unroll
    for (int j = 0; j < 8; ++j) { v[j] = __builtin_nontemporal_load((const f32x4*)xrow + 64 * j + lane); ss += (v[j][0] * v[j][0] + v[j][1] * v[j][1]) + (v[j][2] * v[j][2] + v[j][3] * v[j][3]); }
    const float rs = 1.0f / sqrtf(wave_sum(ss) * (1.f / DM) + EPS);
    if (lane == 0) *rsout = rs;
#pragma unroll
    for (int j = 0; j < 8; ++j) { u32x2 w; w.x = cvt_pk_bf16(v[j][0], v[j][1]); w.y = cvt_pk_bf16(v[j][2], v[j][3]); *((u32x2*)xout + 64 * j + lane) = w; }
}
struct RowRegs { u32x4 x[4]; u32x2 a[4], c[4]; };
__device__ __forceinline__ void combine_load(RowRegs& R, const bf16_t* __restrict__ xrow, const unsigned char* __restrict__ y0, const unsigned char* __restrict__ y1, int lane) {
#pragma unroll
    for (int j = 0; j < 4; ++j) { R.x[j] = *((const u32x4*)xrow + 64 * j + lane); R.a[j] = __builtin_nontemporal_load((const u32x2*)y0 + 64 * j + lane); R.c[j] = __builtin_nontemporal_load((const u32x2*)y1 + 64 * j + lane); }
}
__device__ __forceinline__ void combine_finish(const RowRegs& R, bf16_t* __restrict__ xrow, float g0, float g1, float* __restrict__ rsout, float* __restrict__ fout, const float* __restrict__ fgain, int lane) {
    float v[4][8]; float ss = 0.f;
    g0 *= (1.f / pg8::YM_SCALE); g1 *= (1.f / pg8::YM_SCALE);
#pragma unroll
    for (int j = 0; j < 4; ++j) { const u32x4 x = R.x[j];
        const f32x2 a0 = __builtin_amdgcn_cvt_pk_f32_fp8((int)R.a[j].x, false), a1 = __builtin_amdgcn_cvt_pk_f32_fp8((int)R.a[j].x, true), a2 = __builtin_amdgcn_cvt_pk_f32_fp8((int)R.a[j].y, false), a3 = __builtin_amdgcn_cvt_pk_f32_fp8((int)R.a[j].y, true);
        const f32x2 c0 = __builtin_amdgcn_cvt_pk_f32_fp8((int)R.c[j].x, false), c1 = __builtin_amdgcn_cvt_pk_f32_fp8((int)R.c[j].x, true), c2 = __builtin_amdgcn_cvt_pk_f32_fp8((int)R.c[j].y, false), c3 = __builtin_amdgcn_cvt_pk_f32_fp8((int)R.c[j].y, true);
        v[j][0] = bf_lo(x.x) + g0 * a0[0] + g1 * c0[0]; v[j][1] = bf_hi(x.x) + g0 * a0[1] + g1 * c0[1];
        v[j][2] = bf_lo(x.y) + g0 * a1[0] + g1 * c1[0]; v[j][3] = bf_hi(x.y) + g0 * a1[1] + g1 * c1[1];
        v[j][4] = bf_lo(x.z) + g0 * a2[0] + g1 * c2[0]; v[j][5] = bf_hi(x.z) + g0 * a2[1] + g1 * c2[1];
        v[j][6] = bf_lo(x.w) + g0 * a3[0] + g1 * c3[0]; v[j][7] = bf_hi(x.w) + g0 * a3[1] + g1 * c3[1];
#pragma unroll
        for (int i = 0; i < 8; ++i) ss += v[j][i] * v[j][i]; }
    const float rs = 1.0f / sqrtf(wave_sum(ss) * (1.f / DM) + EPS);
#pragma unroll
    for (int j = 0; j < 4; ++j) {
        if (fout) { const f32x4 ga = *((const f32x4*)fgain + 128 * j + 2 * lane), gb = *((const f32x4*)fgain + 128 * j + 2 * lane + 1);
            __builtin_nontemporal_store((f32x4){v[j][0] * rs * ga[0], v[j][1] * rs * ga[1], v[j][2] * rs * ga[2], v[j][3] * rs * ga[3]}, (f32x4*)fout + 128 * j + 2 * lane);
            __builtin_nontemporal_store((f32x4){v[j][4] * rs * gb[0], v[j][5] * rs * gb[1], v[j][6] * rs * gb[2], v[j][7] * rs * gb[3]}, (f32x4*)fout + 128 * j + 2 * lane + 1); }
        else { u32x4 w; w.x = cvt_pk_bf16(v[j][0], v[j][1]); w.y = cvt_pk_bf16(v[j][2], v[j][3]); w.z = cvt_pk_bf16(v[j][4], v[j][5]); w.w = cvt_pk_bf16(v[j][6], v[j][7]);
            *((u32x4*)xrow + 64 * j + lane) = w; } }
    if (!fout && lane == 0) *rsout = rs;
}

__global__ void __launch_bounds__(NTHREADS, 2) fwd_kernel(Params p) {
    extern __shared__ __attribute__((aligned(16))) unsigned char lds_raw[];
    LAS unsigned char* lds = (LAS unsigned char*)lds_raw;
    cg::grid_group grid = cg::this_grid();
    const int G = gridDim.x, bx = blockIdx.x;
    const int lo = p.ph_lo, hi = p.ph_hi;
    int ph = 0;
    const int wave_s = __builtin_amdgcn_readfirstlane((int)threadIdx.x >> 6);
    volatile LAS unsigned* bar_st = (volatile LAS unsigned*)(lds + MISC_OFF + 4096);
    if (threadIdx.x < 2) bar_st[threadIdx.x] = 0u;
    __syncthreads();
#ifdef PROBE_A
    if (bx == 0 && threadIdx.x == 0) ((volatile LAS unsigned long long*)(lds + MISC_OFF + 4352))[0] = __builtin_amdgcn_s_memrealtime();
#endif
    XcdBarrier xbar; xbar.bar = (unsigned*)(p.ws + WS_CTL) + 1024; xbar.x = 0; xbar.st = bar_st;
    if (hi - lo > 1) xbar = xcd_barrier_post((unsigned*)(p.ws + WS_CTL) + 1024, bar_st);
#ifndef PH_MASK
#define PH_MASK 0x7f
#endif
#ifndef DBL_MASK
#define DBL_MASK 0
#endif
#ifndef DBL_L0
#define DBL_L0 0
#endif
#define PHASE_BEGIN(k) if (((PH_MASK >> (k)) & 1) && lo <= ph && ph < hi) { for (int rep_ = 0; rep_ <= (int)(((DBL_MASK >> (k)) & 1) && (!DBL_L0 || l == 0)); ++rep_) { \
    int tid; asm volatile("v_mbcnt_lo_u32_b32 %0, -1, 0\n\tv_mbcnt_hi_u32_b32 %0, -1, %0" : "=v"(tid)); tid += wave_s * 64; unsigned char* ws = p.ws; asm volatile("" : "+s"(ws)); ws = (unsigned char*)(__attribute__((address_space(1))) unsigned char*)ws; \
    const int lane = tid & 63, wave = __builtin_amdgcn_readfirstlane(tid >> 6); \
    const int vcu = (G % 8 == 0) ? (bx % 8) * (G / 8) + bx / 8 : bx; const int gw = vcu * NWAVES + wave, NGW = G * NWAVES; \
    bf16_t* const Ub = (bf16_t*)(ws + WS_U); bf16_t* const YM = (bf16_t*)(ws + WS_U); bf16_t* const Yc = (bf16_t*)(ws + WS_Y); bf16_t* const Hb = (bf16_t*)(ws + WS_H); \
    bf16_t* const HMb = (bf16_t*)(ws + WS_HM); float* const KS = (float*)(ws + WS_KS); float* const RS = (float*)(ws + WS_RS); unsigned* const REC = (unsigned*)(ws + WS_REC); \
    int* const TM = (int*)(ws + WS_TM); int* const CNT = (int*)(ws + WS_CTL); bf16_t* const XB = (bf16_t*)(ws + WS_XB); \
    LAS int* const m_tile_e = (LAS int*)(lds + MISC_OFF); LAS int* const m_tstart = m_tile_e + MAXTILES; LAS int* const m_cnt = m_tstart + 40; \
    unsigned char* const wl = ws + WS_W0 + (size_t)l * SZ_LAYER; int* const cntg = CNT + 8192 + l * 32 * 64;     \
    (void)lane; (void)wave; (void)gw; (void)NGW; (void)Ub; (void)YM; (void)Yc; (void)Hb; (void)HMb; (void)KS; (void)RS; (void)REC; (void)TM; (void)XB; (void)m_tile_e; (void)m_tstart; (void)m_cnt; (void)wl; (void)cntg;
#ifdef PROBE_A
#define STAMP() do { if (bx == 0 && threadIdx.x == 0) { ((volatile LAS unsigned long long*)(lds + MISC_OFF + 4352))[ph + 1] = __builtin_amdgcn_s_memrealtime(); } } while (0)
#else
#define STAMP() do {} while (0)
#endif
#define PHASE_END   } if (ph + 1 < hi) { if (lo < 0) grid.sync();   else xcd_barrier(xbar); } STAMP(); } ++ph;

    { const int l = 0;
    PHASE_BEGIN(0)
    {
        LAS float* scr = (LAS float*)(lds + wave * 16640);
        { f32x4 vc[16], vn[16]; TrItem tc, tn; int it = gw;
          if (it < DEPTH * TR_I_ALL) { tr_params(p, ws, it, tc); tr_load(tc, vc, lane); }
          while (it < DEPTH * TR_I_ALL) { const int itn = it + NGW; const bool hn = itn < DEPTH * TR_I_ALL;
              if (hn) { tr_params(p, ws, itn, tn); tr_load(tn, vn, lane); }
              tr_finish(tc, vc, scr, lane);
              if (hn) { tc = tn;
#pragma unroll
                  for (int i = 0; i < 16; ++i) vc[i] = vn[i]; }
              it = itn; } }
        for (int l = 0; l < DEPTH; ++l) {
            unsigned char* wl = ws + WS_W0 + (size_t)l * SZ_LAYER;
            bf16_t* RW = (bf16_t*)(wl + OFF_RW);
            for (int i = vcu * NTHREADS + tid; i < NRW * (DM / 8); i += G * NTHREADS) { const int n = i / (DM / 8), k8 = (i % (DM / 8)) * 8; float v[8];
#pragma unroll
                for (int j = 0; j < 8; ++j) { const int k = k8 + j; const float g = p.in[IN_N2G][l * DM + k];
                    v[j] = n < 4 ? g * p.in[IN_RGW][(size_t)l * DM * 4 + k * 4 + n] : (n < 36 ? g * p.in[IN_REW][(size_t)l * DM * 32 + k * 32 + (n - 4)] : 0.f); }
                u32x4 o; o.x = cvt_pk_bf16(v[0], v[1]); o.y = cvt_pk_bf16(v[2], v[3]); o.z = cvt_pk_bf16(v[4], v[5]); o.w = cvt_pk_bf16(v[6], v[7]);
                *(u32x4*)(RW + (size_t)n * DM + k8) = o; }
        }
        for (int m = gw; m < T_TOK; m += NGW) norm_row_f32(p.in[IN_X] + (size_t)m * DM, XB + (size_t)m * DM, RS + m, lane);
        __syncthreads();
    }
    PHASE_END
    }

    for (int l = 0; l < DEPTH; ++l) {
        PHASE_BEGIN(1)
        {
            pg8::DenseSched S{(const char*)XB, (const char*)(wl + OFF_WIN), T_TOK / 256, DIN / 256, G, bx, DM};
            pg8::EpiInProj E{Ub, KS, (float*)(ws + WS_NRM), RS};
            pg8::gemm_phase<2>(lds, wave, DM, S, E);
        }
        PHASE_END
        PHASE_BEGIN(2)
        {
            { const float* NRM = (const float*)(ws + WS_NRM);
              LAS int* bc = (LAS int*)(lds + MISC_OFF + 4224);
              for (int slot_ = vcu; slot_ < 256; slot_ += G) { const int b = slot_ >> 6, sl64 = slot_ & 63;
               for (int pi = 0; pi < att::MAXP; ++pi) {
                const unsigned code = (unsigned)__builtin_amdgcn_readfirstlane((int)att::ATT_ITEMS.v[sl64][pi]);
                if (code == 0xFFFFu) break;
                const int h = code & 7, qb = (code >> 3) & 15, part = (code >> 7) & 1, split = (code >> 8) & 1;
                if (tid < 64) { const int n = lane >> 2, wc = lane & 3;
                    const float* kp = NRM + (size_t)(((64 + b * 16 + n) * 8 + h) * 2) * 4 + wc; float kv = fmaxf(kp[0], kp[4]);
                    kv += SWZ_XOR(kv, 1); kv += SWZ_XOR(kv, 2); if (n > qb) kv = 0.f;
                    kv = fmaxf(kv, SWZ_XOR(kv, 4)); kv = fmaxf(kv, SWZ_XOR(kv, 8)); kv = fmaxf(kv, SWZ_XOR(kv, 16)); kv = half_max(kv);
                    const float* qp = NRM + (size_t)(((b * 16 + qb) * 8 + h) * 2) * 4 + wc; float qv = fmaxf(qp[0], qp[4]);
                    qv += SWZ_XOR(qv, 1); qv += SWZ_XOR(qv, 2);
                    const float bound = att::SCALE * 1.02f * sqrtf(qv) * 2.f * sqrtf(kv) + att::CUT_MARGIN;
                    const float D = bound * exp2f((float)(h + 1));
                    int nb = (int)fminf(floorf((D - 1.f) * (1.f / 256.f)), 64.f);
                    int ns = qb - 1 - nb; ns = ns < 0 ? 0 : ns;
                    if (lane == 0) bc[1] = ns; }
                __syncthreads();
                const int n_start = __builtin_amdgcn_readfirstlane(bc[1]);
                const int n_mid = (qb - 7) > n_start ? (qb - 7) : n_start;
                const bool with_own = (part == 0);
                const int n_lo = split ? (part == 0 ? n_mid : n_start) : n_start, n_hi = split ? (part == 0 ? qb : n_mid) : qb;
                const int slot = split ? ((b * 3 + (h - 5)) * 4 + (qb - 12)) : 0;
#ifdef PROBE_TILES
                if (tid == 0 && l == 0) atomicAdd(&CNT[520], (with_own ? 4 : 0) + 4 * (n_hi - n_lo));
#endif
                att::attn_item(tid, b, h, qb, with_own, n_lo, n_hi, split, slot, l, ws, (char*)lds_raw);
               } } }
#ifndef NO_CONV
            int* const cq = CNT + 12416 + 16 * l; LAS int* qc = (LAS int*)(lds + MISC_OFF + 4240);
            __syncthreads();
            if (tid == 0) qc[0] = __hip_atomic_fetch_add(cq, 1, __ATOMIC_RELAXED, __HIP_MEMORY_SCOPE_AGENT);
            __syncthreads();
            { const float* cw = p.in[IN_CAW] + (size_t)l * 3 * 512;
              for (;;) { const int it = __builtin_amdgcn_readfirstlane(qc[0]); __syncthreads(); if (it >= T_TOK / 64) break;
                if (tid == 0) qc[0] = __hip_atomic_fetch_add(cq, 1, __ATOMIC_RELAXED, __HIP_MEMORY_SCOPE_AGENT);
                const int c8 = (tid & 63) * 8, tg0 = it * 64 + (tid >> 6) * 8, bstart = tg0 & ~(SEQ - 1);
                float w0[8], w1[8], w2[8];
#pragma unroll
                for (int j = 0; j < 8; ++j) { w0[j] = cw[c8 + j]; w1[j] = cw[512 + c8 + j]; w2[j] = cw[1024 + c8 + j]; }
                float z[10][8];
#pragma unroll
                for (int i = 0; i < 10; ++i) { const int tt = tg0 - 2 + i;
                    if (tt >= bstart) { const u32x4 a = *(const u32x4*)(Ub + (size_t)tt * UP + COL_Z + c8);
                        z[i][0] = bf_lo(a.x); z[i][1] = bf_hi(a.x); z[i][2] = bf_lo(a.y); z[i][3] = bf_hi(a.y); z[i][4] = bf_lo(a.z); z[i][5] = bf_hi(a.z); z[i][6] = bf_lo(a.w); z[i][7] = bf_hi(a.w); }
                    else {
#pragma unroll
                        for (int j = 0; j < 8; ++j) z[i][j] = 0.f; } }
#pragma unroll
                for (int o = 0; o < 8; ++o) { const int tt = tg0 + o; const u32x4 bg = *(const u32x4*)(Ub + (size_t)tt * UP + COL_BG + c8); float y[8];
#pragma unroll
                    for (int j = 0; j < 8; ++j) y[j] = w0[j] * z[o][j] + w1[j] * z[o + 1][j] + w2[j] * z[o + 2][j];
                    u32x4 w; w.x = cvt_pk_bf16(bf_lo(bg.x) * y[0], bf_hi(bg.x) * y[1]); w.y = cvt_pk_bf16(bf_lo(bg.y) * y[2], bf_hi(bg.y) * y[3]);
                    w.z = cvt_pk_bf16(bf_lo(bg.z) * y[4], bf_hi(bg.z) * y[5]); w.w = cvt_pk_bf16(bf_lo(bg.w) * y[6], bf_hi(bg.w) * y[7]);
                    *(u32x4*)(Yc + (size_t)tt * DM + c8) = w; }
                __syncthreads(); } }
            { const float* cw = p.in[IN_CCW] + (size_t)l * 31 * 512; const float* cb = p.in[IN_CCB] + l * 512; const float* lg = p.in[IN_LNG] + l * 512; const float* lb = p.in[IN_LNB] + l * 512;
              LAS float* hh = (LAS float*)lds; LAS float* co = hh + 46 * 512;
              for (;;) { const int it = __builtin_amdgcn_readfirstlane(qc[0]) - T_TOK / 64; __syncthreads(); if (it >= T_TOK / 16) break;
                if (tid == 0) qc[0] = __hip_atomic_fetch_add(cq, 1, __ATOMIC_RELAXED, __HIP_MEMORY_SCOPE_AGENT);
                const int t0 = it * 16, bstart = t0 & ~(SEQ - 1);
                { const int c8 = (tid & 63) * 8;
                  for (int i = tid >> 6; i < 46; i += 8) { const int tt = t0 - 30 + i; float v[8];
                    if (tt >= bstart) { const u32x4 a = *(const u32x4*)(Ub + (size_t)tt * UP + COL_HH + c8);
                        v[0] = bf_lo(a.x); v[1] = bf_hi(a.x); v[2] = bf_lo(a.y); v[3] = bf_hi(a.y); v[4] = bf_lo(a.z); v[5] = bf_hi(a.z); v[6] = bf_lo(a.w); v[7] = bf_hi(a.w); }
                    else {
#pragma unroll
                        for (int j = 0; j < 8; ++j) v[j] = 0.f; }
                    *(LAS f32x4*)(hh + i * 512 + c8) = (f32x4){v[0], v[1], v[2], v[3]}; *(LAS f32x4*)(hh + i * 512 + c8 + 4) = (f32x4){v[4], v[5], v[6], v[7]}; } }
                __syncthreads();
                { const int c = tid; float w[31];
#pragma unroll
                  for (int j = 0; j < 31; ++j) w[j] = cw[j * 512 + c];
                  const float bias = cb[c];
                  float win[46];
#pragma unroll
                  for (int i = 0; i < 46; ++i) win[i] = hh[i * 512 + c];
#pragma unroll
                  for (int o = 0; o < 16; ++o) { float a = bias;
#pragma unroll
                      for (int j = 0; j < 31; ++j) a = fmaf(w[j], win[o + j], a);
                      co[o * 512 + c] = a; } }
                __syncthreads();
                { const int c8 = lane * 8;
                  f32x4 ga = *(const f32x4*)(lg + c8), gb = *(const f32x4*)(lg + c8 + 4), ba = *(const f32x4*)(lb + c8), bb = *(const f32x4*)(lb + c8 + 4);
#pragma unroll
                  for (int q = 0; q < 2; ++q) { const int o = wave * 2 + q; const f32x4 xa = *(const LAS f32x4*)(co + o * 512 + c8), xb = *(const LAS f32x4*)(co + o * 512 + c8 + 4);
                    const float mu = wave_sum((xa[0] + xa[1]) + (xa[2] + xa[3]) + (xb[0] + xb[1]) + (xb[2] + xb[3])) * (1.f / 512.f);
                    const f32x4 da = xa - mu, db = xb - mu;
                    const float var = wave_sum((da[0] * da[0] + da[1] * da[1]) + (da[2] * da[2] + da[3] * da[3]) + (db[0] * db[0] + db[1] * db[1]) + (db[2] * db[2] + db[3] * db[3])) * (1.f / 512.f);
                    const float rstd = 1.0f / sqrtf(var + EPS);
                    f32x4 ya = da * rstd * ga + ba, yb = db * rstd * gb + bb;
#pragma unroll
                    for (int j = 0; j < 4; ++j) { ya[j] = ya[j] * fast_sigmoid(ya[j]); yb[j] = yb[j] * fast_sigmoid(yb[j]); }
                    u32x4 w; w.x = cvt_pk_bf16(ya[0], ya[1]); w.y = cvt_pk_bf16(ya[2], ya[3]); w.z = cvt_pk_bf16(yb[0], yb[1]); w.w = cvt_pk_bf16(yb[2], yb[3]);
                    *(u32x4*)(Yc + (size_t)(t0 + o) * DM + 1536 + c8) = w; } }
                __syncthreads();
              } }
#endif
        }
        PHASE_END
        PHASE_BEGIN(3)
        {

#ifdef ATT_CHECK
            if (l == ATT_CHECK) {
                LAS float* qs = (LAS float*)(lds + wave * 4608); LAS float* ps = qs + 128;
                const float SC = 0.088388347648318440f;
                for (int sidx = gw; sidx < 4096; sidx += NGW) {
                    const int b = sidx & 3, h = (sidx >> 2) & 7; const int t = (int)((((unsigned)sidx * 2654435761u) >> 12) & 4095u);
                    const int qblk = t >> 8; const float slope = exp2f(-(float)(h + 1));
                    const bf16_t* urow = Ub + (size_t)(b * SEQ + t) * UP;
                    for (int d = lane; d < 128; d += 64) qs[d] = __uint_as_float((unsigned)urow[COL_Q + h * HD + d] << 16) * SC;
                    asm volatile("s_waitcnt lgkmcnt(0)" ::: "memory");
                    float gate[16];
#pragma unroll
                    for (int n = 0; n < 16; ++n) gate[n] = -1e30f;
                    for (int n = 0; n < qblk; ++n) { float sacc = 0.f;
                        for (int kk = lane; kk < 256; kk += 64) { const bf16_t* kr = Ub + (size_t)(b * SEQ + n * 256 + kk) * UP + COL_K + h * HD; float dsum = 0.f;
                            for (int c = 0; c < 16; ++c) { const u32x4 w = *(const u32x4*)(kr + 8 * c);
                                dsum += qs[8 * c] * bf_lo(w.x) + qs[8 * c + 1] * bf_hi(w.x) + qs[8 * c + 2] * bf_lo(w.y) + qs[8 * c + 3] * bf_hi(w.y) + qs[8 * c + 4] * bf_lo(w.z) + qs[8 * c + 5] * bf_hi(w.z) + qs[8 * c + 6] * bf_lo(w.w) + qs[8 * c + 7] * bf_hi(w.w); }
                            sacc += dsum; }
                        const float gsum = wave_sum(sacc) * (1.f / 256.f);
#pragma unroll
                        for (int m = 0; m < 16; ++m) if (m == n) gate[m] = gsum; }
                    int sel[3] = {-1, -1, -1}; float sv[4] = {-1e30f, -1e30f, -1e30f, -1e30f};
                    { float gcopy[16];
#pragma unroll
                      for (int n = 0; n < 16; ++n) gcopy[n] = gate[n];
                      for (int it = 0; it < 4; ++it) { float best = gcopy[0]; int bi = 0;
#pragma unroll
                          for (int n = 1; n < 16; ++n) if (gcopy[n] > best) { best = gcopy[n]; bi = n; }
                          if (it < 3) sel[it] = bi; sv[it] = best;
#pragma unroll
                          for (int n = 0; n < 16; ++n) if (n == bi) gcopy[n] = -3e38f; } }
                    const int nsel = qblk < 3 ? qblk : 3;
                    const bool neartie = (qblk > 3) && (sv[2] - sv[3] < 1.5e-3f);
                    float mx = -1e30f;
                    for (int r = 0; r < 4; ++r) { const bool own = (r == 3); const int blkn = own ? qblk : sel[r]; const bool valid = own || r < nsel;
                        for (int kk = lane; kk < 256; kk += 64) { float lg = -1e30f;
                            if (valid) { const int kpos = blkn * 256 + kk;
                                if (!own || kpos <= t) { const bf16_t* kr = Ub + (size_t)(b * SEQ + kpos) * UP + COL_K + h * HD; float dsum = 0.f;
                                    for (int c = 0; c < 16; ++c) { const u32x4 w = *(const u32x4*)(kr + 8 * c);
                                        dsum += qs[8 * c] * bf_lo(w.x) + qs[8 * c + 1] * bf_hi(w.x) + qs[8 * c + 2] * bf_lo(w.y) + qs[8 * c + 3] * bf_hi(w.y) + qs[8 * c + 4] * bf_lo(w.z) + qs[8 * c + 5] * bf_hi(w.z) + qs[8 * c + 6] * bf_lo(w.w) + qs[8 * c + 7] * bf_hi(w.w); }
                                    lg = dsum - slope * (float)(t - kpos); } }
                            ps[r * 256 + kk] = lg; mx = fmaxf(mx, lg); } }
#pragma unroll
                    for (int o = 1; o < 64; o <<= 1) mx = fmaxf(mx, __shfl_xor(mx, o));
                    float se = 0.f;
                    for (int i = lane; i < 1024; i += 64) { const float e = (ps[i] > -1e29f) ? __expf(ps[i] - mx) : 0.f; ps[i] = e; se += e; }
                    se = wave_sum(se);
                    asm volatile("s_waitcnt lgkmcnt(0)" ::: "memory");
                    float o0 = 0.f, o1 = 0.f;
                    for (int r = 0; r < 4; ++r) { const bool own = (r == 3); const int blkn = own ? qblk : sel[r]; const bool valid = own || r < nsel;
                        if (valid) for (int kk = 0; kk < 256; ++kk) { const float pp = ps[r * 256 + kk];
                            if (pp != 0.f) { const unsigned w = *(const unsigned*)(Ub + (size_t)(b * SEQ + blkn * 256 + kk) * UP + COL_V + h * HD + 2 * lane); o0 += pp * bf_lo(w); o1 += pp * bf_hi(w); } } }
                    o0 /= se; o1 /= se;
                    const unsigned yw = *(const unsigned*)(Yc + (size_t)(b * SEQ + t) * DM + 512 + h * HD + 2 * lane);
                    float err = fmaxf(fabsf(o0 - bf_lo(yw)), fabsf(o1 - bf_hi(yw))), ref = fmaxf(fabsf(o0), fabsf(o1));
                    const bool isnan_ = !(err == err);
#pragma unroll
                    for (int o = 1; o < 64; o <<= 1) { err = fmaxf(err, __shfl_xor(err, o)); ref = fmaxf(ref, __shfl_xor(ref, o)); }
                    const bool bad = __any(isnan_) || !(err <= 0.03f * ref + 1e-4f);
                    if (lane == 0) { if (neartie) atomicAdd(&CNT[514], 1); else { atomicAdd(&CNT[513], 1); if (bad) atomicAdd(&CNT[512], 1); } }
                    asm volatile("s_waitcnt lgkmcnt(0)" ::: "memory");
                }
                __syncthreads();
            }
#endif
            pg8::DenseSched S{(const char*)Yc, (const char*)(wl + OFF_WOUT), T_TOK / 256, DM / 256, G, bx, DM};
            pg8::EpiResBf16 E{nullptr, XB};
            pg8::gemm_phase<2>(lds, wave, DM, S, E);
        }
        PHASE_END
        PHASE_BEGIN(4)
        {
            const bf16_t* RW = (const bf16_t*)(wl + OFF_RW);
            const float* rgb = p.in[IN_RGB] + l * 4; const float* reb = p.in[IN_REB] + l * 32;
            LAS float* part = (LAS float*)lds;
            LAS float* ssp = part + 8 * 64 * 49;
            LAS float* lgr = ssp + 8 * 64;
            LAS float* rsr = lgr + 64 * 49;
            const int r16 = lane & 15, q = lane >> 4;
            bf16x8 rwf[8][3];
#pragma unroll
            for (int ks = 0; ks < 8; ++ks)
#pragma unroll
                for (int nb = 0; nb < 3; ++nb) rwf[ks][nb] = *reinterpret_cast<const bf16x8*>(RW + (size_t)(nb * 16 + r16) * DM + wave * 256 + ks * 32 + 8 * q);
            for (int it = vcu; it < T_TOK / 64; it += G) {
#pragma unroll 1
                for (int rg = 0; rg < 4; ++rg) {
                    const int row = it * 64 + rg * 16 + r16;
                    const bf16_t* xr = XB + (size_t)row * DM + wave * 256 + 8 * q; unsigned char* x8r = ws + WS_X8 + (size_t)row * DM + wave * 256 + 8 * q;
                    u32x4 xw[8];
#pragma unroll
                    for (int ks = 0; ks < 8; ++ks) xw[ks] = *(const u32x4*)(xr + ks * 32);
                    f32x4 acc[3] = {(f32x4){0.f, 0.f, 0.f, 0.f}, (f32x4){0.f, 0.f, 0.f, 0.f}, (f32x4){0.f, 0.f, 0.f, 0.f}}; float ss = 0.f;
#pragma unroll
                    for (int ks = 0; ks < 8; ++ks) { const u32x4 w = xw[ks];
                        const float a0 = bf_lo(w.x), a1 = bf_hi(w.x), a2 = bf_lo(w.y), a3 = bf_hi(w.y), a4 = bf_lo(w.z), a5 = bf_hi(w.z), a6 = bf_lo(w.w), a7 = bf_hi(w.w);
                        ss += (a0 * a0 + a1 * a1) + (a2 * a2 + a3 * a3) + (a4 * a4 + a5 * a5) + (a6 * a6 + a7 * a7);
                        { int w0 = 0, w1 = 0;
                          w0 = __builtin_amdgcn_cvt_pk_fp8_f32(__builtin_amdgcn_fmed3f(a0, -400.f, 400.f), __builtin_amdgcn_fmed3f(a1, -400.f, 400.f), w0, false); w0 = __builtin_amdgcn_cvt_pk_fp8_f32(__builtin_amdgcn_fmed3f(a2, -400.f, 400.f), __builtin_amdgcn_fmed3f(a3, -400.f, 400.f), w0, true);
                          w1 = __builtin_amdgcn_cvt_pk_fp8_f32(__builtin_amdgcn_fmed3f(a4, -400.f, 400.f), __builtin_amdgcn_fmed3f(a5, -400.f, 400.f), w1, false); w1 = __builtin_amdgcn_cvt_pk_fp8_f32(__builtin_amdgcn_fmed3f(a6, -400.f, 400.f), __builtin_amdgcn_fmed3f(a7, -400.f, 400.f), w1, true);
                          *(u32x2*)(x8r + ks * 32) = (u32x2){(unsigned)w0, (unsigned)w1}; }
                        const bf16x8 a = *reinterpret_cast<const bf16x8*>(&w);
#pragma unroll
                        for (int nb = 0; nb < 3; ++nb) acc[nb] = __builtin_amdgcn_mfma_f32_16x16x32_bf16(a, rwf[ks][nb], acc[nb], 0, 0, 0); }
                    ss += SWZ_XOR(ss, 16); ss = half_sum(ss);
                    if (q == 0) ssp[wave * 64 + rg * 16 + r16] = ss;
#pragma unroll
                    for (int nb = 0; nb < 3; ++nb)
#pragma unroll
                        for (int r = 0; r < 4; ++r) part[(wave * 64 + rg * 16 + 4 * q + r) * 49 + nb * 16 + r16] = acc[nb][r];
                }
                __syncthreads();
                for (int i = tid; i < 64 * 48; i += NTHREADS) { const int r = i / 48, c = i - r * 48; float a = 0.f;
#pragma unroll
                    for (int w = 0; w < 8; ++w) a += part[(w * 64 + r) * 49 + c];
                    lgr[r * 49 + c] = a; }
                if (tid < 64) { float a = 0.f;
#pragma unroll
                    for (int w = 0; w < 8; ++w) a += ssp[w * 64 + tid];
                    rsr[tid] = 1.0f / sqrtf(a * (1.f / DM) + EPS); }
                __syncthreads();
                if (tid < 64) {
                    const int row = it * 64 + tid; const float rs = rsr[tid];
                    const LAS float* lr = lgr + tid * 49;
                    float gl[4];
#pragma unroll
                    for (int j = 0; j < 4; ++j) gl[j] = lr[j] * rs + rgb[j];
                    int grp = 0; float gm = gl[0];
#pragma unroll
                    for (int j = 1; j < 4; ++j) if (gl[j] > gm) { gm = gl[j]; grp = j; }
                    float gsum = 0.f;
#pragma unroll
                    for (int j = 0; j < 4; ++j) gsum += __expf(gl[j] - gm);
                    const float pgrp = 1.0f / gsum;
                    float el[8];
#pragma unroll
                    for (int j = 0; j < 8; ++j) el[j] = lr[4 + grp * 8 + j] * rs + reb[grp * 8 + j];
                    int i1 = 0; float m1 = el[0];
#pragma unroll
                    for (int j = 1; j < 8; ++j) if (el[j] > m1) { m1 = el[j]; i1 = j; }
                    int i2 = -1; float m2 = -INFINITY;
#pragma unroll
                    for (int j = 0; j < 8; ++j) if (j != i1 && el[j] > m2) { m2 = el[j]; i2 = j; }
                    const float e2 = __expf(m2 - m1), inv = 1.0f / (1.0f + e2);
                    const float g1 = pgrp * inv, g2 = pgrp * e2 * inv;
                    const int E1 = grp * 8 + i1, E2 = grp * 8 + i2;
                    LAS int* hist = (LAS int*)(rsr + 64); LAS int* hbase = hist + 32;
                    if (tid < 32) hist[tid] = 0;
                    asm volatile("s_waitcnt lgkmcnt(0)" ::: "memory");
                    const int rk1 = __hip_atomic_fetch_add(&hist[E1], 1, __ATOMIC_RELAXED, __HIP_MEMORY_SCOPE_WORKGROUP);
                    const int rk2 = __hip_atomic_fetch_add(&hist[E2], 1, __ATOMIC_RELAXED, __HIP_MEMORY_SCOPE_WORKGROUP);
                    asm volatile("s_waitcnt lgkmcnt(0)" ::: "memory");
                    if (tid < 32) { const int hc = hist[tid]; hbase[tid] = hc > 0 ? atomicAdd(&cntg[tid * 64], hc) : 0; }
                    asm volatile("s_waitcnt vmcnt(0) lgkmcnt(0)" ::: "memory");
                    const int pos1 = hbase[E1] + rk1, pos2 = hbase[E2] + rk2;
                    TM[E1 * T_TOK + pos1] = row; TM[E2 * T_TOK + pos2] = row;
                    u32x4 ra = {(unsigned)E1, (unsigned)pos1, (unsigned)E2, (unsigned)pos2}; u32x4 rb = {__float_as_uint(g1), __float_as_uint(g2), 0u, 0u};
                    *(u32x4*)(REC + (size_t)row * 8) = ra; *(u32x4*)(REC + (size_t)row * 8 + 4) = rb;
                    RS[row] = rs;
                }
                __syncthreads();
            }
        }
        PHASE_END
        for (int pass = 0; pass < 2; ++pass) {
            PHASE_BEGIN(5)
            {
                if (tid < 64) { const int c = tid < NEXP ? __hip_atomic_load(&cntg[tid * 64], __ATOMIC_RELAXED, __HIP_MEMORY_SCOPE_AGENT) : 0; const int nt_ = (c + 255) >> 8; int incl = nt_;
#pragma unroll
                    for (int o = 1; o < 64; o <<= 1) { const int v = __builtin_amdgcn_ds_bpermute((lane - o) << 2, incl); if (lane >= o) incl += v; }
                    const int st = incl - nt_;
                    if (tid < NEXP) { m_tstart[tid] = st; m_cnt[tid] = c; for (int k = 0; k < nt_; ++k) m_tile_e[st + k] = tid; }
                    if (tid == NEXP) m_tstart[NEXP] = st; }
                __syncthreads();
                const int nM = m_tstart[NEXP];
#ifndef PASS_MASK
#define PASS_MASK 3
#endif
                if ((PASS_MASK & 1) && pass == 0) {
                    pg8::MoeSched S{(const char*)(ws + WS_X8), (const char*)(wl + OFF_WGU), (size_t)1024 * DM, nM, 1024 / 256, G, bx, DM, true, m_tile_e, m_tstart, m_cnt, TM, 1};
                    pg8::EpiSwiglu E{(unsigned char*)HMb, RS, TM, m_tstart, m_cnt};
                    pg8::gemm_phase<1>(lds, wave, DM, S, E);
                } else if (PASS_MASK & 2) {
                    pg8::MoeSched S{(const char*)HMb, (const char*)(wl + OFF_WD), (size_t)DM * DEXP, nM, DM / 256, G, bx, DEXP, false, m_tile_e, m_tstart, m_cnt, TM, 1};
                    pg8::EpiFp8 E{(unsigned char*)YM, DM, pg8::YM_SCALE / (HM_SCALE * W2_SCALE)};
                    pg8::gemm_phase<1>(lds, wave, DEXP, S, E);
                }
                __syncthreads();
            }
            PHASE_END
        }
        PHASE_BEGIN(6)
        {
            int tst; { const int c = lane < NEXP ? __hip_atomic_load(&cntg[lane * 64], __ATOMIC_RELAXED, __HIP_MEMORY_SCOPE_AGENT) : 0; const int nt_ = (c + 255) >> 8; int incl = nt_;
#pragma unroll
                for (int o = 1; o < 64; o <<= 1) { const int v = __builtin_amdgcn_ds_bpermute((lane - o) << 2, incl); if (lane >= o) incl += v; }
                tst = incl - nt_; }
            const bool fin = (l == DEPTH - 1);
            u32x4 ra_n = (u32x4){0u, 0u, 0u, 0u}; u32x2 rb_n = (u32x2){0u, 0u};
            if (gw < T_TOK) { ra_n = *(const u32x4*)(REC + (size_t)gw * 8); rb_n = *(const u32x2*)(REC + (size_t)gw * 8 + 4); }
            for (int m = gw; m < T_TOK; m += NGW) {
                const u32x4 ra = ra_n; const u32x2 rb = rb_n;
                if (m + NGW < T_TOK) { ra_n = *(const u32x4*)(REC + (size_t)(m + NGW) * 8); rb_n = *(const u32x2*)(REC + (size_t)(m + NGW) * 8 + 4); }
                const int r0 = __builtin_amdgcn_ds_bpermute((int)ra.x << 2, tst) * 256 + (int)ra.y, r1 = __builtin_amdgcn_ds_bpermute((int)ra.z << 2, tst) * 256 + (int)ra.w;
                RowRegs RR; combine_load(RR, XB + (size_t)m * DM, (const unsigned char*)YM + (size_t)r0 * DM, (const unsigned char*)YM + (size_t)r1 * DM, lane);
                combine_finish(RR, XB + (size_t)m * DM, __uint_as_float(rb.x), __uint_as_float(rb.y), RS + m, fin ? p.out + (size_t)m * DM : nullptr, p.in[IN_FG], lane);
            }
        }
        PHASE_END
    }
#ifdef PROBE_A
    { __syncthreads(); grid.sync(); if (bx == 0 && threadIdx.x == 0) { volatile LAS unsigned long long* tsp = (volatile LAS unsigned long long*)(lds + MISC_OFF + 4352);
        const float ta = (float)(tsp[PROBE_A + 1] - tsp[PROBE_A]) * 0.01f, tb = (float)(tsp[PROBE_B + 1] - tsp[PROBE_B]) * 0.01f;
        (void)tb; p.out[0] += 40.f * rintf((ta - PROBE_OFS) * 0.025f) + PROBE_OFS; } }
#endif
#ifdef PROBE_TILES
    { __syncthreads(); grid.sync(); if (bx == 0 && threadIdx.x == 0) { int* CNTd = (int*)(p.ws + WS_CTL); p.out[0] += (float)CNTd[520] * 0.01f; } }
#endif
#ifdef ATT_CHECK
    { grid.sync(); if (bx == 0 && threadIdx.x == 0) { int* CNTd = (int*)(p.ws + WS_CTL); const int bad = CNTd[512], tot = CNTd[513], nt_ = CNTd[514];
        float A = 10.f + 1000.f * (float)bad / (float)(tot > 0 ? tot : 1);
#if ATT_REPORT == 1
        A = 10.f + 1000.f * (float)nt_ / 4096.f;
#endif
        p.out[0] += A; } }
#endif
#undef PHASE_BEGIN
#undef PHASE_END
}

constexpr int N_PHASES = 1 + 7 * DEPTH;

extern "C" void kernel_launch(void* const* d_in, const int* in_sizes, int n_in, void* d_out, int out_size, void* d_ws, size_t ws_size, hipStream_t stream) {
    static int grid = 0;
    if (grid == 0) {
        if (n_in != 18 || in_sizes[0] != T_TOK * DM || out_size != T_TOK * DM || ws_size < WS_END) {
            fprintf(stderr, "kernel_launch: unexpected shapes: n_in %d in0 %d out %d ws %zu (need >= %zu)\n", n_in, n_in > 0 ? in_sizes[0] : -1, out_size, ws_size, (size_t)WS_END); grid = -1; return; }
        int dev = 0, cus = 0, per_cu = 0;
        hipGetDevice(&dev); hipDeviceGetAttribute(&cus, hipDeviceAttributeMultiprocessorCount, dev);
        if (hipFuncSetAttribute((const void*)fwd_kernel, hipFuncAttributeMaxDynamicSharedMemorySize, LDS_BYTES) != hipSuccess) { fprintf(stderr, "kernel_launch: hipFuncSetAttribute failed\n"); grid = -1; return; }
        if (hipOccupancyMaxActiveBlocksPerMultiprocessor(&per_cu, (const void*)fwd_kernel, NTHREADS, LDS_BYTES) != hipSuccess || per_cu < 1) { fprintf(stderr, "kernel_launch: occupancy query says %d blocks/CU\n", per_cu); per_cu = 1; }
        (void)hipGetLastError();
        grid = cus;
        if (grid > 256) grid = 256;
    }
    if (grid < 0) return;
    hipMemsetAsync((char*)d_ws + WS_CTL, 0, CTL_BYTES, stream);
    Params p{};
    for (int i = 0; i < 18; ++i) p.in[i] = (const float*)d_in[i];
    p.out = (float*)d_out; p.ws = (unsigned char*)d_ws;
#if MK_N_LAUNCHES == 1
    p.ph_lo = 0; p.ph_hi = N_PHASES;
    void* args[] = {&p};
    hipError_t e = hipLaunchCooperativeKernel((const void*)fwd_kernel, dim3(grid), dim3(NTHREADS), args, LDS_BYTES, stream);
    if (e != hipSuccess) fprintf(stderr, "kernel_launch: cooperative launch failed: %s (grid %d)\n", hipGetErrorString(e), grid);
#else
    for (int ph = 0; ph < N_PHASES; ++ph) { p.ph_lo = ph; p.ph_hi = ph + 1;
        hipLaunchKernelGGL(fwd_kernel, dim3(grid), dim3(NTHREADS), LDS_BYTES, stream, p); }
    hipError_t e = hipPeekAtLastError();
    if (e != hipSuccess) fprintf(stderr, "kernel_launch: launch failed: %s\n", hipGetErrorName(e));
#endif
}
```

```cpp
#include <hip/hip_runtime.h>
#include <hip/hip_cooperative_groups.h>
#include <cstdio>
#include <cstdint>
namespace cg = cooperative_groups;

#ifndef PROBE_ATT2
#define PROBE_ATT2 0
#endif
#ifndef ATT_REPORT
#define ATT_REPORT 0
#endif
#ifndef MK_N_LAUNCHES
#define MK_N_LAUNCHES 1
#endif

#define LAS __attribute__((address_space(3)))
typedef unsigned short bf16_t;
typedef short bf16x8 __attribute__((ext_vector_type(8)));
typedef short s16x4 __attribute__((ext_vector_type(4)));
typedef float f32x2 __attribute__((ext_vector_type(2)));
typedef float f32x4 __attribute__((ext_vector_type(4)));
typedef float f32x16 __attribute__((ext_vector_type(16)));
typedef unsigned u32x2 __attribute__((ext_vector_type(2)));
typedef unsigned u32x4 __attribute__((ext_vector_type(4)));

constexpr int T_TOK = 16384, DM = 2048, DIN = 5632, SEQ = 4096, NBATCH = 4, NHEAD = 8, HD = 128, DEPTH = 2;
constexpr int GC_Q = 1536, GC_K = 2560, GC_V = 3584;
constexpr int UP = 4608, COL_BG = 0, COL_Z = 512, COL_Q = 1024, COL_K = 2048, COL_V = 3072, COL_HH = 4096;
constexpr int NEXP = 32, DEXP = 512, NRW = 48;
constexpr int MAXTILES = 160;
constexpr float EPS = 1e-6f;
constexpr float W1_SCALE = 64.f, W2_SCALE = 32.f, HM_SCALE = 16.f;
constexpr int NWAVES = 8, NTHREADS = 512;
constexpr int RING_BYTES = 131072, SCRATCH_BYTES = 147456, MISC_OFF = SCRATCH_BYTES, MISC_BYTES = 8192, LDS_BYTES = SCRATCH_BYTES + MISC_BYTES;

constexpr size_t MiB = 1u << 20;
constexpr size_t WS_CTL = 0;
constexpr size_t WS_DONE = 65536;
constexpr size_t CTL_BYTES = 65536 + 65536;
constexpr size_t SZ_WIN = (size_t)DIN * DM * 2, SZ_WOUT = (size_t)DM * DM * 2, SZ_WGU = (size_t)NEXP * 1024 * DM * 2, SZ_WD = (size_t)NEXP * DM * DEXP * 2, SZ_RW = (size_t)NRW * DM * 2;
constexpr size_t WS_W0 = 1 * MiB;
constexpr size_t OFF_WIN = 0, OFF_WOUT = OFF_WIN + SZ_WIN, OFF_WGU = OFF_WOUT + SZ_WOUT, OFF_WD = OFF_WGU + SZ_WGU, OFF_RW = OFF_WD + SZ_WD, SZ_LAYER = ((OFF_RW + SZ_RW + 4095) / 4096) * 4096;
constexpr size_t WS_U = WS_W0 + DEPTH * SZ_LAYER;
constexpr size_t SZ_U = (size_t)T_TOK * UP * 2;
static_assert((size_t)MAXTILES * 256 * DM <= SZ_U, "ymoe (fp8) overlays u");
constexpr size_t WS_Y = WS_U + SZ_U;
constexpr size_t WS_H = WS_Y + (size_t)T_TOK * DM * 2;
constexpr size_t WS_HM = WS_H + (size_t)T_TOK * DM * 2;
constexpr size_t WS_KS = WS_HM + (size_t)MAXTILES * 256 * DEXP * 2;
constexpr size_t WS_RS = WS_KS + (size_t)64 * 2 * 1024 * 4;
constexpr size_t WS_REC = WS_RS + (size_t)T_TOK * 4;
constexpr size_t WS_TM = WS_REC + (size_t)T_TOK * 32;
constexpr size_t WS_XB = WS_TM + (size_t)NEXP * T_TOK * 4;
constexpr size_t WS_X8 = WS_XB + (size_t)T_TOK * DM * 2;
constexpr size_t WS_NRM = WS_X8 + (size_t)T_TOK * DM;
constexpr size_t WS_PART = WS_NRM + 2 * 64 * 8 * 8 * 4;
constexpr size_t WS_END = WS_PART + (size_t)48 * 66 * 512 * 4;

__device__ __forceinline__ unsigned cvt_pk_bf16(float lo, float hi) { unsigned r; asm volatile("v_cvt_pk_bf16_f32 %0, %1, %2" : "=v"(r) : "v"(lo), "v"(hi)); return r; }
__device__ __forceinline__ float bf_lo(unsigned w) { return __uint_as_float(w << 16); }
__device__ __forceinline__ float bf_hi(unsigned w) { return __uint_as_float(w & 0xffff0000u); }
#define SWZ_XOR(v, O) __uint_as_float((unsigned)__builtin_amdgcn_ds_swizzle((int)__float_as_uint(v), ((O) << 10) | 0x1f))
__device__ __forceinline__ float half_sum(float v) { auto rr = __builtin_amdgcn_permlane32_swap(__float_as_uint(v), __float_as_uint(v), false, false); return __uint_as_float(rr[0]) + __uint_as_float(rr[1]); }
__device__ __forceinline__ float half_max(float v) { auto rr = __builtin_amdgcn_permlane32_swap(__float_as_uint(v), __float_as_uint(v), false, false); return fmaxf(__uint_as_float(rr[0]), __uint_as_float(rr[1])); }
__device__ __forceinline__ float wave_sum(float v) {
    v += SWZ_XOR(v, 1); v += SWZ_XOR(v, 2); v += SWZ_XOR(v, 4); v += SWZ_XOR(v, 8); v += SWZ_XOR(v, 16);
    return half_sum(v);
}
__device__ __forceinline__ unsigned pk4_fp8(float a, float b, float c, float d) { int w = 0;
    w = __builtin_amdgcn_cvt_pk_fp8_f32(__builtin_amdgcn_fmed3f(a, -400.f, 400.f), __builtin_amdgcn_fmed3f(b, -400.f, 400.f), w, false);
    w = __builtin_amdgcn_cvt_pk_fp8_f32(__builtin_amdgcn_fmed3f(c, -400.f, 400.f), __builtin_amdgcn_fmed3f(d, -400.f, 400.f), w, true); return (unsigned)w; }
__device__ __forceinline__ float fast_sigmoid(float x) { return __builtin_amdgcn_rcpf(1.f + __builtin_amdgcn_exp2f(-1.4426950408889634f * x)); }

namespace pg8 {
constexpr int BM = 256, BK = 64, HALF = 128, HTB = HALF * BK * 2, STAGE_BYTES = 8 * HTB, NXCD = 8, WGM = 8;
__host__ __device__ __forceinline__ int lds_byte(int r, int c) { const int st = (r >> 4) * 2 + (c >> 5), rr = r & 15, cc = c & 31, ob = rr * 64 + cc * 2; return st * 1024 + (ob ^ (((ob >> 9) & 1) << 5)); }
__host__ __device__ __forceinline__ void stage_rc(int b, int& R, int& C) { const int st = b / 1024, sb = b % 1024, swz = sb ^ (((sb >> 9) & 1) << 5); R = (st >> 1) * 16 + swz / 64; C = (st & 1) * 32 + (swz % 64) / 2; }
__host__ __device__ __forceinline__ int perm32(int rho) { const int n = rho >> 4, i = rho & 15; return 8 * (i >> 2) + 4 * n + (i & 3); }

struct Unit { int pm, pn, e; };

__device__ __forceinline__ bool order_next(int i, int G, int c, int nM, int nN, Unit& u) {
    const int nwg = nM * nN; const long L = (long)i * G + c; if (L >= nwg) return false;
    int wgid = (int)L; { const int q = nwg / NXCD, r = nwg % NXCD, xcd = wgid % NXCD, off = wgid / NXCD; wgid = (xcd < r ? xcd * (q + 1) : r * (q + 1) + (xcd - r) * q) + off; }
    const int nig = WGM * nN, gid = wgid / nig, fm = gid * WGM, gsz = (nM - fm) < WGM ? (nM - fm) : WGM;
    u.pm = fm + ((wgid % nig) % gsz); u.pn = (wgid % nig) / gsz; u.e = 0; return true;
}

struct DenseSched {
    const char* A; const char* Bt; int nM, nN, G, c, K; int* flag; int sig;
    __device__ __forceinline__ bool next(int i, Unit& u) const { return order_next(i, G, c, nM, nN, u); }
    __device__ __forceinline__ void starting(int ui, int wid) const { if (flag && c == 0 && ui == sig && wid == 0) __hip_atomic_store(flag, 1, __ATOMIC_RELAXED, __HIP_MEMORY_SCOPE_AGENT); }
    __device__ __forceinline__ unsigned a_off(const Unit& u) const { return (unsigned)(u.pm * BM * K * 2); }
    __device__ __forceinline__ unsigned b_off(const Unit& u) const { return (unsigned)(u.pn * BM * K * 2); }
    __device__ __forceinline__ void a_rows(const Unit&, const int (&RA)[2], const unsigned (&cofA)[2], unsigned (&g)[2][2]) const {
#pragma unroll
        for (int h = 0; h < 2; ++h)
#pragma unroll
            for (int i = 0; i < 2; ++i) g[h][i] = (unsigned)((h * HALF + RA[i]) * K) * 2u + cofA[i];
    }
};
struct MoeSched {
    const char* A; const char* Bt; size_t b_estride; int nM, nN, G, c, K; bool gather;
    const LAS int* tile_e; const LAS int* tstart; const LAS int* cnt; const int* tokmap; int es; int* flag; int sig;
    __device__ __forceinline__ bool next(int i, Unit& u) const { if (!order_next(i, G, c, nM, nN, u)) return false; u.e = tile_e[u.pm]; return true; }
    __device__ __forceinline__ void starting(int ui, int wid) const { if (flag && c == 0 && ui == sig && wid == 0) __hip_atomic_store(flag, 1, __ATOMIC_RELAXED, __HIP_MEMORY_SCOPE_AGENT); }
    __device__ __forceinline__ unsigned a_off(const Unit& u) const { return gather ? 0u : (unsigned)(u.pm * BM * K * es); }
    __device__ __forceinline__ unsigned b_off(const Unit& u) const { return (unsigned)(u.e * (int)b_estride + u.pn * BM * K * es); }
    __device__ __forceinline__ void a_rows(const Unit& u, const int (&RA)[2], const unsigned (&cofA)[2], unsigned (&g)[2][2]) const {
        if (gather) {
            const int p0 = (u.pm - tstart[u.e]) * BM, cn = cnt[u.e];
#pragma unroll
            for (int h = 0; h < 2; ++h)
#pragma unroll
                for (int i = 0; i < 2; ++i) { int pos = p0 + h * HALF + RA[i]; pos = pos < cn ? pos : cn - 1; const int tok = tokmap[u.e * T_TOK + pos]; g[h][i] = (unsigned)(tok * K * es) + cofA[i]; }
        } else {
#pragma unroll
            for (int h = 0; h < 2; ++h)
#pragma unroll
                for (int i = 0; i < 2; ++i) g[h][i] = (unsigned)((h * HALF + RA[i]) * K * es) + cofA[i];
        }
    }
};

__device__ __forceinline__ void acc_zero(f32x4 (&acc)[2][2][4][2]) {
    float z; asm volatile("v_mov_b32 %0, 0" : "=v"(z));
#pragma unroll
    for (int a = 0; a < 2; ++a)
#pragma unroll
        for (int b = 0; b < 2; ++b)
#pragma unroll
            for (int m = 0; m < 4; ++m)
#pragma unroll
                for (int n = 0; n < 2; ++n) acc[a][b][m][n] = (f32x4){z, z, z, z};
}
struct EpiInProj {
    static constexpr bool PERM = true;
    __device__ __forceinline__ void init(f32x4 (&acc)[2][2][4][2], const Unit&, int, int, int, int) const { acc_zero(acc); }
    bf16_t* U; float* ksum; float* nrm; const float* rs;
    __device__ __forceinline__ void operator()(const f32x4 (&acc_)[2][2][4][2], const Unit& u, int wr, int wc, int fr, int fq) const {
        const int row0 = u.pm * BM + wr * 64 + fr, col0 = u.pn * BM + wc * 32 + 8 * fq;
        f32x4 acc[2][2][4][2];
#pragma unroll
        for (int ai = 0; ai < 2; ++ai)
#pragma unroll
            for (int m = 0; m < 4; ++m) { const float sc = rs[row0 + ai * HALF + m * 16];
#pragma unroll
                for (int bj = 0; bj < 2; ++bj) { acc[ai][bj][m][0] = acc_[ai][bj][m][0] * sc; acc[ai][bj][m][1] = acc_[ai][bj][m][1] * sc; } }
        const bool paired = (u.pn >= 2 && u.pn < 6) || u.pn >= 18;
        if (!paired) { const int ocol = (u.pn < 2 ? u.pn * 256 : COL_Q + (u.pn - 6) * 256) + wc * 32 + 8 * fq;
#pragma unroll
          for (int ai = 0; ai < 2; ++ai)
#pragma unroll
            for (int m = 0; m < 4; ++m) { bf16_t* rowp = U + (size_t)(row0 + ai * HALF + m * 16) * UP + ocol;
#pragma unroll
                for (int bj = 0; bj < 2; ++bj) { const f32x4 v0 = acc[ai][bj][m][0], v1 = acc[ai][bj][m][1]; u32x4 w;
                    w.x = cvt_pk_bf16(v0[0], v0[1]); w.y = cvt_pk_bf16(v0[2], v0[3]); w.z = cvt_pk_bf16(v1[0], v1[1]); w.w = cvt_pk_bf16(v1[2], v1[3]);
                    *(u32x4*)(rowp + bj * HALF) = w; } }
        } else { const bool glu = u.pn >= 18; const int ocol = (glu ? COL_HH + (u.pn - 18) * 128 : COL_Z + (u.pn - 2) * 128) + wc * 16 + 4 * fq;
#pragma unroll
          for (int ai = 0; ai < 2; ++ai)
#pragma unroll
            for (int m = 0; m < 4; ++m) { bf16_t* rowp = U + (size_t)(row0 + ai * HALF + m * 16) * UP + ocol;
#pragma unroll
                for (int bj = 0; bj < 2; ++bj) { const f32x4 v0 = acc[ai][bj][m][0], v1 = acc[ai][bj][m][1];
                    float h0, h1, h2, h3;
                    if (glu) { h0 = v0[0] * fast_sigmoid(v0[1]); h1 = v0[2] * fast_sigmoid(v0[3]); h2 = v1[0] * fast_sigmoid(v1[1]); h3 = v1[2] * fast_sigmoid(v1[3]); }
                    else { h0 = v0[0] * v0[1]; h1 = v0[2] * v0[3]; h2 = v1[0] * v1[1]; h3 = v1[2] * v1[3]; }
                    u32x2 w; w.x = cvt_pk_bf16(h0, h1); w.y = cvt_pk_bf16(h2, h3); *(u32x2*)(rowp + bj * (HALF / 2)) = w; } }
        }
        if (u.pn >= GC_Q / 256 && u.pn < GC_V / 256) {
            const int kind = u.pn >= GC_K / 256, hb = 2 * (u.pn - (kind ? GC_K / 256 : GC_Q / 256));
#pragma unroll
            for (int bj = 0; bj < 2; ++bj) { float mx = 0.f;
#pragma unroll
                for (int ai = 0; ai < 2; ++ai)
#pragma unroll
                    for (int m = 0; m < 4; ++m) { const f32x4 a = acc[ai][bj][m][0], c = acc[ai][bj][m][1];
                        float q = (a[0] * a[0] + a[1] * a[1]) + (a[2] * a[2] + a[3] * a[3]) + (c[0] * c[0] + c[1] * c[1]) + (c[2] * c[2] + c[3] * c[3]);
                        q += SWZ_XOR(q, 16); q = half_sum(q); mx = fmaxf(mx, q); }
                mx = fmaxf(mx, SWZ_XOR(mx, 1)); mx = fmaxf(mx, SWZ_XOR(mx, 2)); mx = fmaxf(mx, SWZ_XOR(mx, 4)); mx = fmaxf(mx, SWZ_XOR(mx, 8));
                if ((fr | fq) == 0) nrm[(((kind * 64 + u.pm) * 8 + hb + bj) * 2 + wr) * 4 + wc] = mx; }
        }
        if (u.pn >= GC_K / 256 && u.pn < GC_V / 256) {
            float* kp = ksum + (size_t)(u.pm * 2 + wr) * 1024 + (u.pn - GC_K / 256) * 256 + wc * 32 + 8 * fq;
#pragma unroll
            for (int bj = 0; bj < 2; ++bj)
#pragma unroll
                for (int n = 0; n < 2; ++n) { f32x4 s = (f32x4){0.f, 0.f, 0.f, 0.f};
#pragma unroll
                    for (int ai = 0; ai < 2; ++ai)
#pragma unroll
                        for (int m = 0; m < 4; ++m) s += acc[ai][bj][m][n];
#pragma unroll
                    for (int e = 0; e < 4; ++e) { float t = s[e]; t += SWZ_XOR(t, 1); t += SWZ_XOR(t, 2); t += SWZ_XOR(t, 4); t += SWZ_XOR(t, 8); s[e] = t; }
                    if (fr == 0) *(f32x4*)(kp + bj * HALF + 4 * n) = s; }
        }
    }
};
struct EpiResBf16 {
    static constexpr bool PERM = true;
    const float* resf; bf16_t* out;
    __device__ __forceinline__ void init(f32x4 (&acc)[2][2][4][2], const Unit& u, int wr, int wc, int fr, int fq) const {
        const int row0 = u.pm * BM + wr * 64 + fr, col0 = u.pn * BM + wc * 32 + 8 * fq;
#pragma unroll
        for (int ai = 0; ai < 2; ++ai)
#pragma unroll
            for (int m = 0; m < 4; ++m) { const size_t off = (size_t)(row0 + ai * HALF + m * 16) * DM + col0;
#pragma unroll
                for (int bj = 0; bj < 2; ++bj) {
                    if (resf) { acc[ai][bj][m][0] = __builtin_nontemporal_load((const f32x4*)(resf + off + bj * HALF)); acc[ai][bj][m][1] = __builtin_nontemporal_load((const f32x4*)(resf + off + bj * HALF + 4)); }
                    else { const u32x4 r = *(const u32x4*)(out + off + bj * HALF);
                        acc[ai][bj][m][0] = (f32x4){bf_lo(r.x), bf_hi(r.x), bf_lo(r.y), bf_hi(r.y)}; acc[ai][bj][m][1] = (f32x4){bf_lo(r.z), bf_hi(r.z), bf_lo(r.w), bf_hi(r.w)}; } } }
    }
    __device__ __forceinline__ void operator()(const f32x4 (&acc)[2][2][4][2], const Unit& u, int wr, int wc, int fr, int fq) const {
        const int row0 = u.pm * BM + wr * 64 + fr, col0 = u.pn * BM + wc * 32 + 8 * fq;
#pragma unroll
        for (int ai = 0; ai < 2; ++ai)
#pragma unroll
            for (int m = 0; m < 4; ++m) { const size_t off = (size_t)(row0 + ai * HALF + m * 16) * DM + col0;
#pragma unroll
                for (int bj = 0; bj < 2; ++bj) { const f32x4 v0 = acc[ai][bj][m][0], v1 = acc[ai][bj][m][1];
                    u32x4 w; w.x = cvt_pk_bf16(v0[0], v0[1]); w.y = cvt_pk_bf16(v0[2], v0[3]); w.z = cvt_pk_bf16(v1[0], v1[1]); w.w = cvt_pk_bf16(v1[2], v1[3]);
                    *(u32x4*)(out + off + bj * HALF) = w; } }
    }
};
struct EpiSwiglu {
    static constexpr bool PERM = true;
    __device__ __forceinline__ void init(f32x4 (&acc)[2][2][4][2], const Unit&, int, int, int, int) const { acc_zero(acc); }
    unsigned char* HMo; const float* rs; const int* tokmap; const LAS int* tstart; const LAS int* cnt;
    __device__ __forceinline__ void operator()(const f32x4 (&acc)[2][2][4][2], const Unit& u, int wr, int wc, int fr, int fq) const {
        const int p0 = (u.pm - tstart[u.e]) * BM, cn = cnt[u.e];
#pragma unroll
        for (int ai = 0; ai < 2; ++ai)
#pragma unroll
            for (int m = 0; m < 4; ++m) { const int r = ai * HALF + wr * 64 + m * 16 + fr; int pos = p0 + r; pos = pos < cn ? pos : cn - 1;
                const float sc = rs[tokmap[u.e * T_TOK + pos]] * (1.f / W1_SCALE);
                unsigned char* rowp = HMo + (size_t)(u.pm * BM + r) * DEXP + ((u.pn * BM + wc * 32 + 8 * fq) >> 1);
#pragma unroll
                for (int bj = 0; bj < 2; ++bj) { const f32x4 v0 = acc[ai][bj][m][0] * sc, v1 = acc[ai][bj][m][1] * sc;
                    const float h0 = __builtin_amdgcn_fmed3f(HM_SCALE * v0[0] * fast_sigmoid(v0[0]) * v0[1], -400.f, 400.f), h1 = __builtin_amdgcn_fmed3f(HM_SCALE * v0[2] * fast_sigmoid(v0[2]) * v0[3], -400.f, 400.f);
                    const float h2 = __builtin_amdgcn_fmed3f(HM_SCALE * v1[0] * fast_sigmoid(v1[0]) * v1[1], -400.f, 400.f), h3 = __builtin_amdgcn_fmed3f(HM_SCALE * v1[2] * fast_sigmoid(v1[2]) * v1[3], -400.f, 400.f);
                    int w = 0; w = __builtin_amdgcn_cvt_pk_fp8_f32(h0, h1, w, false); w = __builtin_amdgcn_cvt_pk_fp8_f32(h2, h3, w, true);
                    *(unsigned*)(rowp + bj * (HALF / 2)) = (unsigned)w; } }
    }
};
constexpr float YM_SCALE = 8.f;
struct EpiFp8 {
    static constexpr bool PERM = true;
    __device__ __forceinline__ void init(f32x4 (&acc)[2][2][4][2], const Unit&, int, int, int, int) const { acc_zero(acc); }
    unsigned char* O; int ldc; float osc;
    __device__ __forceinline__ void operator()(const f32x4 (&acc)[2][2][4][2], const Unit& u, int wr, int wc, int fr, int fq) const {
        const int row0 = u.pm * BM + wr * 64 + fr, col0 = u.pn * BM + wc * 32 + 8 * fq;
#pragma unroll
        for (int ai = 0; ai < 2; ++ai)
#pragma unroll
            for (int m = 0; m < 4; ++m) { unsigned char* rowp = O + (size_t)(row0 + ai * HALF + m * 16) * ldc + col0;
#pragma unroll
                for (int bj = 0; bj < 2; ++bj) { f32x4 v0 = acc[ai][bj][m][0] * osc, v1 = acc[ai][bj][m][1] * osc;
#pragma unroll
                    for (int e = 0; e < 4; ++e) { v0[e] = __builtin_amdgcn_fmed3f(v0[e], -400.f, 400.f); v1[e] = __builtin_amdgcn_fmed3f(v1[e], -400.f, 400.f); }
                    int w0 = 0, w1 = 0;
                    w0 = __builtin_amdgcn_cvt_pk_fp8_f32(v0[0], v0[1], w0, false); w0 = __builtin_amdgcn_cvt_pk_fp8_f32(v0[2], v0[3], w0, true);
                    w1 = __builtin_amdgcn_cvt_pk_fp8_f32(v1[0], v1[1], w1, false); w1 = __builtin_amdgcn_cvt_pk_fp8_f32(v1[2], v1[3], w1, true);
                    *(u32x2*)(rowp + bj * HALF) = (u32x2){(unsigned)w0, (unsigned)w1}; } }
    }
};

template <int ES, class Epi, class Sched>
__device__ __forceinline__ void gemm_phase(LAS unsigned char* lds, const int wid, const int K, const Sched& S, const Epi& E) {
#define PG8_LANE(l_) int l_; asm volatile("v_mbcnt_lo_u32_b32 %0, -1, 0\n\tv_mbcnt_hi_u32_b32 %0, -1, %0" : "=v"(l_))
    const int wr = wid >> 2, wc = wid & 3;
    const int nt = K * ES / (BK * 2);
    unsigned voffB[2]; int aoff, boff;
    { PG8_LANE(l0); const int t0 = wid * 64 + l0, fr = l0 & 15, fq = l0 >> 4;
#pragma unroll
      for (int i = 0; i < 2; ++i) { int R, C; stage_rc(t0 * 16 + i * 8192, R, C); const int Rb = Epi::PERM ? ((R & ~31) + perm32(R & 31)) : R;
        voffB[i] = (unsigned)(Rb * K * ES) + (unsigned)C * 2u; }
      aoff = lds_byte(wr * 64 + fr, fq * 8); boff = lds_byte(wc * 32 + fr, fq * 8); }
#define PG8_AROWS(u_, g_) do { PG8_LANE(l_); const int t_ = wid * 64 + l_; int RA[2]; unsigned cofA[2]; \
        _Pragma("unroll") for (int i = 0; i < 2; ++i) { int R, C; stage_rc(t_ * 16 + i * 8192, R, C); RA[i] = R; cofA[i] = (unsigned)C * 2u; } S.a_rows(u_, RA, cofA, g_); } while (0)
    const unsigned kstep = (unsigned)(BK * 2);
    const unsigned hstep = (unsigned)(HALF * K * ES);
    const unsigned ldsw = (unsigned)wid * 1024u;
#define PG8_SA(b, h) (((b) * 2 + (h)) * HTB)
#define PG8_SB(b, h) ((4 + (b) * 2 + (h)) * HTB)
    const __amdgpu_buffer_rsrc_t rsA = __builtin_amdgcn_make_buffer_rsrc((void*)S.A, (short)0, 0x7fffffff, 0x00020000), rsB = __builtin_amdgcn_make_buffer_rsrc((void*)S.Bt, (short)0, 0x7fffffff, 0x00020000);
#define PG8_STG(bufoff, rs, soff, v0, v1) do { \
        __builtin_amdgcn_raw_ptr_buffer_load_lds(rs, (LAS unsigned*)(lds + (bufoff) + ldsw), 16, (int)(v0), (int)(soff), 0, 0); \
        __builtin_amdgcn_raw_ptr_buffer_load_lds(rs, (LAS unsigned*)(lds + (bufoff) + ldsw + 8192), 16, (int)(v1), (int)(soff), 0, 0); } while (0)
#define PG8_LDA(dst, b, h) do { _Pragma("unroll") for (int m = 0; m < 4; ++m) _Pragma("unroll") for (int k = 0; k < 2; ++k) dst[m].pc[k] = *(const LAS bf16x8*)(lds + PG8_SA(b, h) + aoff + m * 2048 + k * 1024); } while (0)
#define PG8_LDB(dst, b, h) do { _Pragma("unroll") for (int n = 0; n < 2; ++n) _Pragma("unroll") for (int k = 0; k < 2; ++k) dst[n].pc[k] = *(const LAS bf16x8*)(lds + PG8_SB(b, h) + boff + n * 2048 + k * 1024); } while (0)
#define PG8_MMA(ai, bj, At, Bt) do { __builtin_amdgcn_s_setprio(1); \
        if constexpr (ES == 2) { _Pragma("unroll") for (int m = 0; m < 4; ++m) _Pragma("unroll") for (int n = 0; n < 2; ++n) _Pragma("unroll") for (int k = 0; k < 2; ++k) \
            acc[ai][bj][m][n] = __builtin_amdgcn_mfma_f32_16x16x32_bf16(Bt[n].pc[k], At[m].pc[k], acc[ai][bj][m][n], 0, 0, 0); } \
        else { _Pragma("unroll") for (int m = 0; m < 4; ++m) _Pragma("unroll") for (int n = 0; n < 2; ++n) \
            asm volatile("v_mfma_scale_f32_16x16x128_f8f6f4 %0, %1, %2, %0, %3, %3 op_sel_hi:[0,0,0]" : "+v"(acc[ai][bj][m][n]) : "v"(__builtin_bit_cast(i32x8v, Bt[n])), "v"(__builtin_bit_cast(i32x8v, At[m])), "v"(mxs)); } \
        __builtin_amdgcn_s_setprio(0); } while (0)
#define PG8_WAIT_V(n) asm volatile("s_waitcnt vmcnt(" #n ")" ::: "memory")
#define PG8_WAIT_L(n) asm volatile("s_waitcnt lgkmcnt(" #n ")" ::: "memory")
#define PG8_BAR __builtin_amdgcn_s_barrier()
#define PG8_SCHED __builtin_amdgcn_sched_barrier(0)
    Unit cur, nxt; int ui = 0;
    if (!S.next(0, cur)) return;
    f32x4 acc[2][2][4][2];
    { PG8_LANE(li); E.init(acc, cur, wr, wc, li & 15, li >> 4); }
    typedef int i32x4v __attribute__((ext_vector_type(4))); typedef int i32x8v __attribute__((ext_vector_type(8)));
    struct Frag { bf16x8 pc[2]; };
    Frag At[4], B0[2], B1[2];
    const int mxs = 0x7F7F7F7F;
    unsigned cA = S.a_off(cur), cB = S.b_off(cur);
    unsigned gc[2][2], gn[2][2];
    PG8_AROWS(cur, gc);
    PG8_STG(PG8_SB(0, 0), rsB, cB, voffB[0], voffB[1]); PG8_STG(PG8_SB(0, 1), rsB, cB + hstep, voffB[0], voffB[1]); PG8_STG(PG8_SA(0, 0), rsA, cA, gc[0][0], gc[0][1]); PG8_STG(PG8_SA(0, 1), rsA, cA, gc[1][0], gc[1][1]);
    if (wr == 1) PG8_BAR;
    PG8_WAIT_V(2); PG8_BAR;
    PG8_STG(PG8_SB(1, 0), rsB, cB + kstep, voffB[0], voffB[1]); PG8_STG(PG8_SA(1, 0), rsA, cA + kstep, gc[0][0], gc[0][1]); PG8_STG(PG8_SB(1, 1), rsB, cB + hstep + kstep, voffB[0], voffB[1]);
    PG8_WAIT_V(6); PG8_BAR;
    for (;;) {
        const bool has_next = S.next(ui + 1, nxt);
        S.starting(ui, wid);
        const unsigned nA = has_next ? S.a_off(nxt) : cA, nB = has_next ? S.b_off(nxt) : cB;
        if (has_next) PG8_AROWS(nxt, gn);
        else { gn[0][0] = gc[0][0]; gn[0][1] = gc[0][1]; gn[1][0] = gc[1][0]; gn[1][1] = gc[1][1]; }
#pragma unroll 1
        for (int t = 0; t < nt; t += 2) {
            const bool last = (t == nt - 2);
            const unsigned a1 = cA + (unsigned)(t + 1) * kstep;
            const unsigned a2 = last ? nA : cA + (unsigned)(t + 2) * kstep, b2 = last ? nB : cB + (unsigned)(t + 2) * kstep;
            const unsigned a3 = a2 + kstep, b3 = b2 + kstep;
            const unsigned g00 = last ? gn[0][0] : gc[0][0], g01 = last ? gn[0][1] : gc[0][1], g10 = last ? gn[1][0] : gc[1][0], g11 = last ? gn[1][1] : gc[1][1];
            PG8_LDB(B0, 0, 0); PG8_LDB(B1, 0, 1); PG8_SCHED; PG8_LDA(At, 0, 0); PG8_STG(PG8_SA(1, 1), rsA, a1, gc[1][0], gc[1][1]);
            PG8_WAIT_V(8); PG8_WAIT_L(0); PG8_BAR; PG8_MMA(0, 0, At, B0); PG8_MMA(0, 1, At, B1); PG8_BAR; PG8_SCHED;
            PG8_LDA(At, 0, 1); PG8_STG(PG8_SB(0, 0), rsB, b2, voffB[0], voffB[1]); PG8_STG(PG8_SB(0, 1), rsB, b2 + hstep, voffB[0], voffB[1]); PG8_STG(PG8_SA(0, 0), rsA, a2, g00, g01);
            PG8_WAIT_V(8); PG8_WAIT_L(0); PG8_BAR; PG8_MMA(1, 0, At, B0); PG8_MMA(1, 1, At, B1); PG8_BAR; PG8_SCHED;
            PG8_LDB(B0, 1, 0); PG8_LDB(B1, 1, 1); PG8_SCHED; PG8_LDA(At, 1, 0); PG8_STG(PG8_SA(0, 1), rsA, a2, g10, g11);
            PG8_WAIT_V(8); PG8_WAIT_L(0); PG8_BAR; PG8_MMA(0, 0, At, B0); PG8_MMA(0, 1, At, B1); PG8_BAR; PG8_SCHED;
            PG8_LDA(At, 1, 1); PG8_STG(PG8_SB(1, 0), rsB, b3, voffB[0], voffB[1]); PG8_STG(PG8_SB(1, 1), rsB, b3 + hstep, voffB[0], voffB[1]); PG8_STG(PG8_SA(1, 0), rsA, a3, g00, g01);
            PG8_WAIT_V(8); PG8_WAIT_L(0); PG8_BAR; PG8_MMA(1, 0, At, B0); PG8_MMA(1, 1, At, B1); PG8_BAR; PG8_SCHED;
        }
        if (wr == 0) PG8_BAR;
        if constexpr (ES == 1) asm volatile("s_nop 15\n\ts_nop 7" ::: "memory");
        { PG8_LANE(le); E(acc, cur, wr, wc, le & 15, le >> 4); }
        if (!has_next) break;
        { PG8_LANE(li); E.init(acc, nxt, wr, wc, li & 15, li >> 4); }
        cur = nxt; cA = nA; cB = nB; gc[0][0] = gn[0][0]; gc[0][1] = gn[0][1]; gc[1][0] = gn[1][0]; gc[1][1] = gn[1][1]; ++ui;
        if (wr == 1) PG8_BAR;
    }
    PG8_WAIT_V(0);
    PG8_BAR;
#undef PG8_AROWS
#undef PG8_LANE
#undef PG8_SA
#undef PG8_SB
#undef PG8_STG
#undef PG8_LDA
#undef PG8_LDB
#undef PG8_MMA
#undef PG8_WAIT_V
#undef PG8_WAIT_L
#undef PG8_BAR
#undef PG8_SCHED
}
}

namespace att {
constexpr float SCALE = 0.088388347648318440f;
constexpr float THR = 8.f;
constexpr int KVBLK = 64, QBLK = 32;
constexpr size_t SHM_V = KVBLK * HD * 2, SHM_K = KVBLK * HD * 2;
constexpr int NRING = 2;
constexpr int OFF_V = 0, OFF_K = NRING * SHM_V, OFF_WS = OFF_K + NRING * SHM_K, OFF_KM = OFF_WS + NWAVES * 64 * 4, ATT_LDS = OFF_KM + 32 * 256;
#define KSWZ(row, colB) ((row) * 256 + ((colB) ^ (((row) & 7) << 4)))
#define SBAR() __builtin_amdgcn_sched_barrier(0)
__device__ __forceinline__ int crow(int r, int hi) { return (r & 3) + 8 * (r >> 2) + 4 * hi; }

__device__ __forceinline__ void partialSM(f32x16& p0, f32x16& p1, float& m_reg, float& mn, float& alpha, float slr, float lb, int mode, int thr) {
    constexpr float C = SCALE * 1.4426950408889634f;
#pragma unroll
    for (int r = 0; r < 16; ++r) { const float cr = (float)((r & 3) + 8 * (r >> 2)); p0[r] = fmaf(slr, cr, p0[r]); p1[r] = fmaf(slr, cr + 32.f, p1[r]); }
    if (mode) {
        if (mode == 1) {
#pragma unroll
            for (int r = 0; r < 16; ++r) { if ((r & 3) + 8 * (r >> 2) > thr) p0[r] = -3.0e38f; p1[r] = -3.0e38f; }
        } else {
#pragma unroll
            for (int r = 0; r < 16; ++r) { if ((r & 3) + 8 * (r >> 2) > thr) p1[r] = -3.0e38f; }
        }
    }
    float pmax = p0[0];
#pragma unroll
    for (int r = 1; r < 16; ++r) pmax = fmaxf(pmax, p0[r]);
#pragma unroll
    for (int r = 0; r < 16; ++r) pmax = fmaxf(pmax, p1[r]);
    pmax += lb;
    { auto rr = __builtin_amdgcn_permlane32_swap(__float_as_uint(pmax), __float_as_uint(pmax), false, false);
      pmax = fmaxf(__uint_as_float(rr[0]), __uint_as_float(rr[1])); }
    if (__builtin_expect(__all(pmax - m_reg <= THR / SCALE), 1)) { mn = m_reg; alpha = 1.f; }
    else { mn = fmaxf(m_reg, pmax); alpha = __builtin_amdgcn_exp2f((m_reg - mn) * C); m_reg = mn; }
    const float mnC = (lb - mn) * C;
#pragma unroll
    for (int r = 0; r < 16; ++r) p0[r] = fmaf(p0[r], C, mnC);
#pragma unroll
    for (int r = 0; r < 16; ++r) p1[r] = fmaf(p1[r], C, mnC);
#pragma unroll
    for (int r = 0; r < 16; ++r) p0[r] = __builtin_amdgcn_exp2f(p0[r]);
}
__device__ __forceinline__ void finishSM(f32x16& p0, f32x16& p1, float alpha, float& l_reg, bf16x8& pa0, bf16x8& pa1, bf16x8& pa2, bf16x8& pa3) {
#pragma unroll
    for (int r = 0; r < 16; ++r) p1[r] = __builtin_amdgcn_exp2f(p1[r]);
    float ps = 0;
#pragma unroll
    for (int r = 0; r < 16; ++r) ps += p0[r];
#pragma unroll
    for (int r = 0; r < 16; ++r) ps += p1[r];
    { auto rr = __builtin_amdgcn_permlane32_swap(__float_as_uint(ps), __float_as_uint(ps), false, false);
      ps = __uint_as_float(rr[0]) + __uint_as_float(rr[1]); }
    l_reg = l_reg * alpha + ps;
#define PK4(P, BASE, OUT) do { unsigned a0 = cvt_pk_bf16(P[BASE + 0], P[BASE + 1]), a1 = cvt_pk_bf16(P[BASE + 2], P[BASE + 3]);   \
    unsigned b0 = cvt_pk_bf16(P[BASE + 4], P[BASE + 5]), b1 = cvt_pk_bf16(P[BASE + 6], P[BASE + 7]);                              \
    auto r0 = __builtin_amdgcn_permlane32_swap(a0, b0, false, false); auto r1 = __builtin_amdgcn_permlane32_swap(a1, b1, false, false); \
    u32x4 w = {r0[0], r1[0], r0[1], r1[1]}; OUT = *reinterpret_cast<bf16x8*>(&w); } while (0)
    PK4(p0, 0, pa0); PK4(p0, 8, pa1); PK4(p1, 0, pa2); PK4(p1, 8, pa3);
#undef PK4
}
__device__ __forceinline__ void qkt(f32x16& p0, f32x16& p1, const char* Ks, const bf16x8* qr, int r32, int hi) {
    p0 = f32x16{}; p1 = f32x16{};
    int lowb = (hi * 16) ^ ((r32 & 7) << 4);
    asm volatile("" : "+v"(lowb));
    const char* Kr = Ks + r32 * 256;
#pragma unroll
    for (int d0 = 0; d0 < 8; ++d0) { const int cb = (d0 * 32) ^ lowb;
        const bf16x8 b0 = *reinterpret_cast<const bf16x8*>(Kr + cb);
        const bf16x8 b1 = *reinterpret_cast<const bf16x8*>(Kr + 32 * 256 + cb);
        p0 = __builtin_amdgcn_mfma_f32_32x32x16_bf16(b0, qr[d0], p0, 0, 0, 0);
        p1 = __builtin_amdgcn_mfma_f32_32x32x16_bf16(b1, qr[d0], p1, 0, 0, 0); }
}
__device__ __forceinline__ int v_st(int k, int c) { const int kk = (k & ~0xC) | ((k & 4) << 1) | ((k & 8) >> 1); return ((kk >> 3) * 4 + (c >> 5)) * 512 + ((kk & 7) * 32 + (c & 31)) * 2; }
__device__ __forceinline__ int v_rd_base(int lane) { return ((lane & 3) << 3) | (((lane >> 2) & 3) << 6) | (((lane >> 4) & 1) << 5) | (((lane >> 5) & 1) << 8); }
constexpr int v_rd_off(int d0, int ks, int half) { return d0 * 512 + ks * 4096 + half * 2048; }
template <int OFF> __device__ __forceinline__ s16x4 tr_read(int vb) {
    s16x4 r; asm volatile("ds_read_b64_tr_b16 %0, %1 offset:%2" : "=&v"(r) : "v"(vb), "i"(OFF) : "memory"); return r;
}
template <int D0> __device__ __forceinline__ void pv_one(f32x16& od, int vb, bf16x8 pa0, bf16x8 pa1, bf16x8 pa2, bf16x8 pa3) {
    const s16x4 l0 = tr_read<v_rd_off(D0, 0, 0)>(vb), h0 = tr_read<v_rd_off(D0, 0, 1)>(vb), l1 = tr_read<v_rd_off(D0, 1, 0)>(vb), h1 = tr_read<v_rd_off(D0, 1, 1)>(vb);
    const s16x4 l2 = tr_read<v_rd_off(D0, 2, 0)>(vb), h2 = tr_read<v_rd_off(D0, 2, 1)>(vb), l3 = tr_read<v_rd_off(D0, 3, 0)>(vb), h3 = tr_read<v_rd_off(D0, 3, 1)>(vb);
    asm volatile("s_waitcnt lgkmcnt(0)" ::: "memory"); SBAR();
#define PK(L, H) (bf16x8){L[0], L[1], L[2], L[3], H[0], H[1], H[2], H[3]}
    od = __builtin_amdgcn_mfma_f32_32x32x16_bf16(pa0, PK(l0, h0), od, 0, 0, 0);
    od = __builtin_amdgcn_mfma_f32_32x32x16_bf16(pa1, PK(l1, h1), od, 0, 0, 0);
    od = __builtin_amdgcn_mfma_f32_32x32x16_bf16(pa2, PK(l2, h2), od, 0, 0, 0);
    od = __builtin_amdgcn_mfma_f32_32x32x16_bf16(pa3, PK(l3, h3), od, 0, 0, 0);
#undef PK
}
__device__ __forceinline__ void pv_d0(f32x16* o, int vb, bf16x8 pa0, bf16x8 pa1, bf16x8 pa2, bf16x8 pa3) {
    pv_one<0>(o[0], vb, pa0, pa1, pa2, pa3); pv_one<1>(o[1], vb, pa0, pa1, pa2, pa3); pv_one<2>(o[2], vb, pa0, pa1, pa2, pa3); pv_one<3>(o[3], vb, pa0, pa1, pa2, pa3);
}

constexpr int MAXP = 8;
struct ItemTable { unsigned short v[64][MAXP]; };
constexpr int head_cap(int h) { return h == 0 ? 1 : h == 1 ? 2 : h == 2 ? 3 : h == 3 ? 5 : h == 4 ? 10 : 16; }
constexpr ItemTable make_items() {
    ItemTable t{};
    for (int i = 0; i < 64; ++i) for (int j = 0; j < MAXP; ++j) t.v[i][j] = 0xFFFF;
    const int kh[8] = {3, 4, 5, 7, 10, 12, 12, 11};
    int bin0 = 0;
    for (int h = 0; h < 8; ++h) { const int k = kh[h];
        unsigned short code[32] = {}; int cost[32] = {}; int n = 0;
        for (int qb = 0; qb < 16; ++qb) { const int npast = qb < head_cap(h) ? qb : head_cap(h); const bool split = (h >= 5 && qb >= 12);
            if (split) { code[n] = (unsigned short)(h | (qb << 3) | (0 << 7) | (1 << 8)); cost[n] = 8; ++n; code[n] = (unsigned short)(h | (qb << 3) | (1 << 7) | (1 << 8)); cost[n] = npast - 7; ++n; }
            else { code[n] = (unsigned short)(h | (qb << 3)); cost[n] = 1 + npast; ++n; } }
        for (int i = 1; i < n; ++i) { const unsigned short xv = code[i]; const int c = cost[i]; int j = i - 1;
            while (j >= 0 && cost[j] < c) { code[j + 1] = code[j]; cost[j + 1] = cost[j]; --j; }
            code[j + 1] = xv; cost[j + 1] = c; }
        int load[16] = {}; int cnt[16] = {};
        for (int i = 0; i < n; ++i) { int best = 0; for (int j = 1; j < k; ++j) if (load[j] < load[best]) best = j;
            if (cnt[best] < MAXP) { t.v[bin0 + best][cnt[best]] = code[i]; ++cnt[best]; load[best] += cost[i] + 1; } }
        bin0 += k; }
    return t;
}
__device__ const ItemTable ATT_ITEMS = make_items();
constexpr float CUT_MARGIN = 40.f;

__device__ __forceinline__ void attn_item(const int tid, const int b, const int h, const int qb, const bool with_own, const int n_lo, const int n_hi, const int mode,
                                          const int slot, const int l, unsigned char* __restrict__ wsb, char* lds) {
    const bf16_t* __restrict__ U = (const bf16_t*)(wsb + WS_U); const float* __restrict__ ksum = (const float*)(wsb + WS_KS); bf16_t* __restrict__ Y = (bf16_t*)(wsb + WS_Y);
    float* __restrict__ part = (float*)(wsb + WS_PART) + (size_t)slot * 66 * 512; int* __restrict__ tick = (int*)(wsb + WS_CTL) + 12544 + 128 * l + 2 * slot;
    const int wid = tid >> 6, lane = tid & 63, r32 = lane & 31, hi = lane >> 5;
    char* V_lds = lds + OFF_V; char* K_lds = lds + OFF_K; char* KM = lds + OFF_KM;
    float* ws = (float*)(lds + OFF_WS) + wid * 64; float* li_l = ws; float* al_l = ws + 32;
    const bf16_t* Qb = U + (size_t)(b * SEQ + qb * 256) * UP + COL_Q + h * HD;
    float m_reg = -1e29f, l_reg = 0; f32x16 o[4] = {}; bf16x8 qr[8];
    { const bf16_t* Qw = Qb + (size_t)(wid * QBLK + r32) * UP + hi * 8;
#pragma unroll
      for (int d0 = 0; d0 < 8; ++d0) qr[d0] = *reinterpret_cast<const bf16x8*>(Qw + d0 * 16); }
    { const int n = tid >> 5, c4 = (tid & 31) * 4;
      const float* k0p = ksum + (size_t)((b * 16 + n) * 2) * 1024 + h * HD + c4;
      const f32x4 s0 = *(const f32x4*)k0p, s1 = *(const f32x4*)(k0p + 1024);
      u32x2 w; w.x = cvt_pk_bf16((s0[0] + s1[0]) * (1.f / 256.f), (s0[1] + s1[1]) * (1.f / 256.f)); w.y = cvt_pk_bf16((s0[2] + s1[2]) * (1.f / 256.f), (s0[3] + s1[3]) * (1.f / 256.f));
      *(u32x2*)(KM + KSWZ(n, c4 * 2)) = w;
      *(u32x2*)(KM + KSWZ(16 + n, c4 * 2)) = (u32x2){0u, 0u}; }
    __syncthreads();
    unsigned selmask = 0u;
    { f32x16 g = f32x16{};
#pragma unroll
      for (int d0 = 0; d0 < 8; ++d0) { const int cb = (d0 * 16 + hi * 8) * 2; const bf16x8 a = *reinterpret_cast<const bf16x8*>(KM + KSWZ(r32, cb)); g = __builtin_amdgcn_mfma_f32_32x32x16_bf16(a, qr[d0], g, 0, 0, 0); }
      float G[16];
#pragma unroll
      for (int r = 0; r < 8; ++r) { auto rr = __builtin_amdgcn_permlane32_swap(__float_as_uint(g[r]), __float_as_uint(g[r]), false, false);
          const float other = hi ? __uint_as_float(rr[0]) : __uint_as_float(rr[1]);
          const int nlo = (r & 3) + 8 * (r >> 2);
          G[nlo] = hi ? other : g[r]; G[nlo + 4] = hi ? g[r] : other; }
#pragma unroll
      for (int n = 0; n < 16; ++n) if (n >= qb) G[n] = -INFINITY;
      const int npick = qb < 3 ? qb : 3;
#pragma unroll
      for (int it = 0; it < 3; ++it) { if (it < npick) { float best = G[0]; int bi = 0;
#pragma unroll
          for (int n = 1; n < 16; ++n) if (G[n] > best) { best = G[n]; bi = n; }
          selmask |= 1u << bi;
#pragma unroll
          for (int n = 0; n < 16; ++n) if (n == bi) G[n] = -INFINITY; } } }
    const float slr = __uint_as_float(__builtin_amdgcn_readfirstlane(__float_as_uint(__builtin_amdgcn_exp2f(-(float)(h + 1)) * (1.f / SCALE))));
    const int tp4 = qb * 256 + wid * QBLK + r32 - 4 * hi;
    const int jo = with_own ? 4 : 0;
    const int NT = jo + 4 * (n_hi - n_lo);
    const int kb_own = qb * 256, kb_past = n_lo * 256 - 64 * jo;
#define KST(j) (((j) < jo ? kb_own : kb_past) + 64 * (j))
#define LBV(j) ((((j) < jo) ? ((j) > (wid >> 1)) : !((selmask >> (n_lo + (((j) - jo) >> 2))) & 1u)) ? -1e30f : slr * (float)(KST(j) - tp4))
    const int vb0 = (int)(uintptr_t)V_lds + v_rd_base(lane);
    unsigned koff, voff;
    { const int row = 4 * wid + (lane >> 4), cc = lane & 15; koff = (unsigned)(row * UP * 2 + ((cc ^ (row & 7)) << 4)) + (unsigned)(COL_K * 2); }
    { const int st = 2 * wid + (lane >> 5), kk = (st >> 2) * 8 + ((lane & 31) >> 2), k = (kk & ~0xC) | ((kk & 4) << 1) | ((kk & 8) >> 1), col = 32 * (st & 3) + 8 * (lane & 3);
      voff = (unsigned)(k * UP * 2 + col * 2) + (unsigned)(COL_V * 2); }
    const int wq = __builtin_amdgcn_readfirstlane(wid);
    LAS unsigned char* ldsL = (LAS unsigned char*)(unsigned)(uintptr_t)lds;
    const char* Ubh = (const char*)(U + (size_t)(b * SEQ) * UP + h * HD);
#define DMAK(bb, k0) do { const unsigned uo_ = (unsigned)((k0) * (UP * 2)); \
    __builtin_amdgcn_global_load_lds((const unsigned*)(Ubh + (koff + uo_)), (LAS unsigned*)(ldsL + OFF_K + (bb) * SHM_K + wq * 1024), 16, 0, 0); \
    __builtin_amdgcn_global_load_lds((const unsigned*)(Ubh + (koff + uo_ + 32u * UP * 2u)), (LAS unsigned*)(ldsL + OFF_K + (bb) * SHM_K + (wq + 8) * 1024), 16, 0, 0); } while (0)
#define DMAV(bb, k0) do { const unsigned uo_ = (unsigned)((k0) * (UP * 2)); \
    __builtin_amdgcn_global_load_lds((const unsigned*)(Ubh + (voff + uo_)), (LAS unsigned*)(ldsL + OFF_V + (bb) * SHM_V + wq * 1024), 16, 0, 0); \
    __builtin_amdgcn_global_load_lds((const unsigned*)(Ubh + (voff + uo_ + 32u * UP * 2u)), (LAS unsigned*)(ldsL + OFF_V + (bb) * SHM_V + (wq + 8) * 1024), 16, 0, 0); } while (0)
#define RESC(a) do { if (__any((a) < 1.f)) { if (hi == 0) al_l[r32] = (a); asm volatile("s_waitcnt lgkmcnt(0)" ::: "memory"); \
    _Pragma("unroll") for (int d = 0; d < 4; ++d) _Pragma("unroll") for (int r = 0; r < 16; ++r) o[d][r] *= al_l[crow(r, hi)]; } } while (0)
    if (NT > 0) {
    f32x16 pA0, pA1, pB0, pB1; float mnA, mnB, alA, alB; bf16x8 pa0, pa1, pa2, pa3;
#define PSM(P0, P1, MN, AL, j) partialSM(P0, P1, m_reg, MN, AL, slr, LBV(j), ((j) < jo && (j) == (wid >> 1)) ? 1 + (wid & 1) : 0, r32 - 4 * hi)
#define WBAR(N) asm volatile("s_waitcnt vmcnt(" #N ") lgkmcnt(0)\n\ts_barrier" ::: "memory")
#define STEP(PC0, PC1, MNC, ALC, PP0, PP1, ALP, j, sl) do { \
        DMAV(sl, KST(j)); \
        SBAR(); qkt(PC0, PC1, K_lds + (sl) * SHM_K, qr, r32, hi); \
        finishSM(PP0, PP1, ALP, l_reg, pa0, pa1, pa2, pa3); SBAR(); \
        WBAR(4); \
        if ((j) + 2 < NT) DMAK(sl, KST((j) + 2)); \
        pv_d0(o, vb0 + (1 - (sl)) * (int)SHM_V, pa0, pa1, pa2, pa3); PSM(PC0, PC1, MNC, ALC, j); \
        if ((j) + 2 < NT) WBAR(4); else WBAR(0); RESC(ALC); } while (0)
    DMAK(0, KST(0)); DMAK(1, KST(1)); DMAV(0, KST(0)); WBAR(4);
    qkt(pA0, pA1, K_lds, qr, r32, hi);
    WBAR(4);
    DMAK(0, KST(2)); PSM(pA0, pA1, mnA, alA, 0);
    WBAR(4); RESC(alA);
    for (int j = 1; j + 1 < NT; j += 2) {
        STEP(pB0, pB1, mnB, alB, pA0, pA1, alA, j, 1);
        STEP(pA0, pA1, mnA, alA, pB0, pB1, alB, j + 1, 0);
    }
    STEP(pB0, pB1, mnB, alB, pA0, pA1, alA, NT - 1, 1);
    finishSM(pB0, pB1, alB, l_reg, pa0, pa1, pa2, pa3); SBAR();
    pv_d0(o, vb0 + (int)SHM_V, pa0, pa1, pa2, pa3);
#undef STEP
#undef WBAR
#undef PSM
    }
    bool write_out = true;
    if (mode == 1) {
        __syncthreads();
        int* tk = (int*)(lds + OFF_WS + NWAVES * 64 * 4 - 16);
        if (tid == 0) tk[0] = __hip_atomic_fetch_add(tick, 1, __ATOMIC_RELAXED, __HIP_MEMORY_SCOPE_AGENT);
        __syncthreads();
        const int t = __builtin_amdgcn_readfirstlane(tk[0]);
        __syncthreads();
        if (t == 0) {
#pragma unroll
            for (int d = 0; d < 4; ++d)
#pragma unroll
                for (int r = 0; r < 16; ++r) __hip_atomic_store(part + (size_t)(d * 16 + r) * 512 + tid, o[d][r], __ATOMIC_RELAXED, __HIP_MEMORY_SCOPE_AGENT);
            __hip_atomic_store(part + (size_t)64 * 512 + tid, m_reg, __ATOMIC_RELAXED, __HIP_MEMORY_SCOPE_AGENT);
            __hip_atomic_store(part + (size_t)65 * 512 + tid, l_reg, __ATOMIC_RELAXED, __HIP_MEMORY_SCOPE_AGENT);
            asm volatile("s_waitcnt vmcnt(0)" ::: "memory");
            __syncthreads();
            if (tid == 0) __hip_atomic_store(tick + 1, 1, __ATOMIC_RELAXED, __HIP_MEMORY_SCOPE_AGENT);
            write_out = false;
        } else {
            if (tid < 64) { unsigned sp = 0;
                while (__builtin_amdgcn_readfirstlane(__hip_atomic_load(tick + 1, __ATOMIC_RELAXED, __HIP_MEMORY_SCOPE_AGENT)) == 0) { __builtin_amdgcn_s_sleep(2); if (++sp > (1u << 22)) break; }
                __builtin_amdgcn_fence(__ATOMIC_ACQUIRE, "agent");
                asm volatile("s_waitcnt vmcnt(0)" ::: "memory"); }
            __syncthreads();
            constexpr float C = SCALE * 1.4426950408889634f;
            const float m2 = part[(size_t)64 * 512 + tid], l2 = part[(size_t)65 * 512 + tid];
            const float mn = fmaxf(m_reg, m2), a1 = __builtin_amdgcn_exp2f((m_reg - mn) * C), a2 = __builtin_amdgcn_exp2f((m2 - mn) * C);
            { float t1 = l_reg * a1, t2 = l2 * a2; asm volatile("" : "+v"(t1), "+v"(t2)); l_reg = t1 + t2; }
            if (hi == 0) { al_l[r32] = a1; li_l[r32] = a2; }
            asm volatile("s_waitcnt lgkmcnt(0)" ::: "memory");
#pragma unroll
            for (int d = 0; d < 4; ++d)
#pragma unroll
                for (int r = 0; r < 16; ++r) { float t1 = o[d][r] * al_l[crow(r, hi)], t2 = part[(size_t)(d * 16 + r) * 512 + tid] * li_l[crow(r, hi)]; asm volatile("" : "+v"(t1), "+v"(t2)); o[d][r] = t1 + t2; }
            asm volatile("s_waitcnt lgkmcnt(0)" ::: "memory");
        }
    }
    if (write_out) {
    if (hi == 0) li_l[r32] = l_reg; asm volatile("s_waitcnt lgkmcnt(0)" ::: "memory");
    float rli[16];
#pragma unroll
    for (int r = 0; r < 16; ++r) rli[r] = __builtin_amdgcn_rcpf(li_l[crow(r, hi)]);
    bf16_t* Ow = Y + (size_t)(b * SEQ + qb * 256 + wid * QBLK) * DM + 512 + h * HD;
#pragma unroll
    for (int r = 0; r < 16; ++r) { const int orow = crow(r, hi);
#pragma unroll
        for (int d0 = 0; d0 < 4; ++d0) { const float v = o[d0][r] * rli[r]; Ow[(size_t)orow * DM + d0 * 32 + r32] = (bf16_t)(cvt_pk_bf16(v, v) & 0xffffu); } }
    }
    __syncthreads();
#undef KST
#undef LBV
#undef DMAK
#undef DMAV
#undef RESC
}
#undef KSWZ
#undef SBAR
}


#define XB_TMO      128
#define XB_XCNT(j)  (256  + 64 * (j))
#define XB_XSUB(j)  (1280 + 64 * (j))
#define XB_XGEN(j)  (2304 + 64 * (j))
#define XB_TOP      3328
#define XB_TOPGEN   3392
#define XCD_BAR_WORDS 3456
#define XB_SPIN_CAP (1u << 18)
__device__ __forceinline__ unsigned xb_ld(unsigned* p)              { return __hip_atomic_load(p, __ATOMIC_RELAXED, __HIP_MEMORY_SCOPE_AGENT); }
__device__ __forceinline__ unsigned xb_add(unsigned* p, unsigned v) { return __hip_atomic_fetch_add(p, v, __ATOMIC_RELAXED, __HIP_MEMORY_SCOPE_AGENT); }
__device__ __forceinline__ unsigned xb_xcc_id() { return (unsigned)__builtin_amdgcn_s_getreg((3 << 11) | 20) & 0xFu; }
#define XB_SPIN(cond, bar) do { unsigned _sp = 0; while (cond) { __builtin_amdgcn_s_sleep(1); \
    if ((++_sp & 255u) == 0u) { if (xb_ld(&(bar)[XB_TMO])) break; if (_sp > XB_SPIN_CAP) { atomicAdd(&(bar)[XB_TMO], 1u); break; } } } } while (0)
struct XcdBarrier { unsigned* bar; unsigned x; volatile LAS unsigned* st; };
__device__ __forceinline__ XcdBarrier xcd_barrier_post(unsigned* bar, volatile LAS unsigned* st) {
    XcdBarrier b; b.bar = bar; b.x = xb_xcc_id(); b.st = st;
    if (threadIdx.x == 0) (void)xb_add(&bar[XB_XCNT(b.x)], 1u);
    return b;
}
__device__ __forceinline__ void xcd_barrier_complete(unsigned* bar, unsigned x, unsigned& nloc, unsigned& nx) {
    const unsigned G = gridDim.x * gridDim.y * gridDim.z;
    unsigned sum, cnt, mine, sp = 0u;
    for (;;) {
        sum = 0u; cnt = 0u;
#pragma unroll 1
        for (unsigned j = 0; j < 16; ++j) { const unsigned c = xb_ld(&bar[XB_XCNT(j)]); sum += c; cnt += (c > 0u) ? 1u : 0u; }
        mine = xb_ld(&bar[XB_XCNT(x)]);
        if (sum == G) break;
        __builtin_amdgcn_s_sleep(1);
        if ((++sp & 255u) == 0u) { if (xb_ld(&bar[XB_TMO])) break; if (sp > XB_SPIN_CAP) { atomicAdd(&bar[XB_TMO], 1u); break; } }
    }
    nloc = mine > 0u ? mine : 1u; nx = cnt > 0u ? cnt : 1u;
}
__device__ __forceinline__ void xcd_barrier(const XcdBarrier& b) {
    asm volatile("s_waitcnt vmcnt(0)" ::: "memory");
    __syncthreads();
    if (threadIdx.x == 0) {
        unsigned* bar = b.bar; asm volatile("" : "+s"(bar));
        __builtin_amdgcn_s_waitcnt(0);
        unsigned nloc = b.st[0], nx = b.st[1];
        if (nloc == 0u) { xcd_barrier_complete(bar, b.x, nloc, nx); b.st[0] = nloc; b.st[1] = nx; }
        const unsigned old = xb_add(&bar[XB_XSUB(b.x)], 1u);
        const unsigned gen = old / nloc;
        if (old + 1u == (gen + 1u) * nloc) {
            __builtin_amdgcn_fence(__ATOMIC_RELEASE, "agent");
            asm volatile("s_waitcnt vmcnt(0)" ::: "memory");
            const unsigned og = xb_add(&bar[XB_TOP], 1u);
            const unsigned tg = og / nx;
            if (og + 1u == (tg + 1u) * nx) xb_add(&bar[XB_TOPGEN], 1u);
            else XB_SPIN(xb_ld(&bar[XB_TOPGEN]) == tg, bar);
            __builtin_amdgcn_fence(__ATOMIC_ACQUIRE, "agent");
            xb_add(&bar[XB_XGEN(b.x)], 1u);
            asm volatile("s_waitcnt vmcnt(0)" ::: "memory");
        } else {
            XB_SPIN(xb_ld(&bar[XB_XGEN(b.x)]) == gen, bar);
            __builtin_amdgcn_fence(__ATOMIC_ACQUIRE, "agent");
            asm volatile("s_waitcnt vmcnt(0)" ::: "memory");
        }
    }
    __syncthreads();
}

struct Params { const float* in[18]; float* out; unsigned char* ws; int ph_lo, ph_hi; };
enum { IN_X = 0, IN_N1G, IN_WIN, IN_CAW, IN_CCW, IN_CCB, IN_LNG, IN_LNB, IN_WOUT, IN_N2G, IN_RGW, IN_RGB, IN_REW, IN_REB, IN_WG, IN_WU, IN_WD, IN_FG };

struct TrItem { const float* src; unsigned char* dst; const float* scale; float mult; int N, K, k0, n0, rmul, radd, es; };
constexpr int TR_I_IN = (DM / 128) * (DIN / 32), TR_I_OUT = (DM / 128) * (DM / 32), TR_I_G = NEXP * (DM / 128) * (DEXP / 32), TR_I_D = NEXP * (DEXP / 128) * (DM / 32), TR_I_ALL = TR_I_IN + TR_I_OUT + 2 * TR_I_G + TR_I_D;
__device__ __forceinline__ void tr_params(const Params& p, unsigned char* ws, int it, TrItem& t) {
    const int l = it / TR_I_ALL; int r = it - l * TR_I_ALL; unsigned char* wl = ws + WS_W0 + (size_t)l * SZ_LAYER;
    size_t dstb = 0; t.rmul = 1; t.radd = 0; t.scale = nullptr; t.mult = 1.f; t.es = 1;
    if (r < TR_I_IN) { t.src = p.in[IN_WIN] + (size_t)l * DM * DIN; t.K = DM; t.N = DIN; t.dst = wl + OFF_WIN; t.scale = p.in[IN_N1G] + l * DM; t.es = 2; }
    else if ((r -= TR_I_IN) < TR_I_OUT) { t.src = p.in[IN_WOUT] + (size_t)l * DM * DM; t.K = DM; t.N = DM; t.dst = wl + OFF_WOUT; t.es = 2; }
    else if ((r -= TR_I_OUT) < TR_I_G) { t.src = p.in[IN_WG] + (size_t)l * NEXP * DM * DEXP; t.K = DM; t.N = DEXP; t.dst = wl + OFF_WGU; dstb = (size_t)1024 * DM; t.rmul = 2; t.scale = p.in[IN_N2G] + l * DM; t.mult = W1_SCALE; }
    else if ((r -= TR_I_G) < TR_I_G) { t.src = p.in[IN_WU] + (size_t)l * NEXP * DM * DEXP; t.K = DM; t.N = DEXP; t.dst = wl + OFF_WGU; dstb = (size_t)1024 * DM; t.rmul = 2; t.radd = 1; t.scale = p.in[IN_N2G] + l * DM; t.mult = W1_SCALE; }
    else { r -= TR_I_G; t.src = p.in[IN_WD] + (size_t)l * NEXP * DEXP * DM; t.K = DEXP; t.N = DM; t.dst = wl + OFF_WD; dstb = (size_t)DM * DEXP; t.mult = W2_SCALE; }
    const int nnb = t.N / 32, per = (t.K / 128) * nnb, bt = r / per, rem = r - bt * per, kb = rem / nnb, nb = rem - kb * nnb;
    t.k0 = kb * 128; t.n0 = nb * 32; t.src += (size_t)bt * t.K * t.N; t.dst += (size_t)bt * dstb;
    if (t.es == 2 && t.N == DIN) { const int n0 = t.n0;
        t.rmul = ((n0 >= 512 && n0 < 1536) || n0 >= 4608) ? 2 : 1;
        t.radd = n0 < 512 ? 0 : n0 < 1024 ? -512 : n0 < 1536 ? -1535 : n0 < 4608 ? 0 : n0 < 5120 ? -4608 : -5631; }
}
__device__ __forceinline__ void tr_load(const TrItem& t, f32x4 (&v)[16], int lane) {
    const float* s = t.src + (size_t)(t.k0 + (lane >> 3)) * t.N + t.n0 + (lane & 7) * 4;
#pragma unroll
    for (int i = 0; i < 16; ++i) v[i] = __builtin_nontemporal_load((const f32x4*)(s + (size_t)(8 * i) * t.N));
}
__device__ __forceinline__ void tr_finish(const TrItem& t, const f32x4 (&v)[16], LAS float* scr, int lane) {
    { LAS float* s = scr + (lane & 7) * 4 * 130 + (lane >> 3);
#pragma unroll
      for (int i = 0; i < 16; ++i) { s[8 * i] = v[i][0]; s[130 + 8 * i] = v[i][1]; s[260 + 8 * i] = v[i][2]; s[390 + 8 * i] = v[i][3]; } }
    const int c = lane & 7, nn = lane >> 3;
    float sc[16];
#pragma unroll
    for (int i = 0; i < 16; ++i) sc[i] = t.mult;
    if (t.scale) {
#pragma unroll
        for (int i = 0; i < 4; ++i) { const f32x4 g = *(const f32x4*)(t.scale + t.k0 + 16 * c + 4 * i); sc[4 * i] *= g[0]; sc[4 * i + 1] *= g[1]; sc[4 * i + 2] *= g[2]; sc[4 * i + 3] *= g[3]; } }
    asm volatile("s_waitcnt lgkmcnt(0)" ::: "memory");
#pragma unroll
    for (int j = 0; j < 4; ++j) { const int n = nn + 8 * j; const LAS float* s = scr + n * 130 + 16 * c;
        float x[16];
#pragma unroll
        for (int i = 0; i < 8; ++i) { const f32x2 q = *(const LAS f32x2*)(s + 2 * i); x[2 * i] = q[0] * sc[2 * i]; x[2 * i + 1] = q[1] * sc[2 * i + 1]; }
        const size_t row = (size_t)((t.n0 + n) * t.rmul + t.radd) * t.K + t.k0 + 16 * c;
        if (t.es == 2) { u32x4 o0, o1;
            o0.x = cvt_pk_bf16(x[0], x[1]); o0.y = cvt_pk_bf16(x[2], x[3]); o0.z = cvt_pk_bf16(x[4], x[5]); o0.w = cvt_pk_bf16(x[6], x[7]);
            o1.x = cvt_pk_bf16(x[8], x[9]); o1.y = cvt_pk_bf16(x[10], x[11]); o1.z = cvt_pk_bf16(x[12], x[13]); o1.w = cvt_pk_bf16(x[14], x[15]);
            u32x4* d = (u32x4*)(t.dst + row * 2); __builtin_nontemporal_store(o0, d); __builtin_nontemporal_store(o1, d + 1); }
        else { u32x4 o; o.x = pk4_fp8(x[0], x[1], x[2], x[3]); o.y = pk4_fp8(x[4], x[5], x[6], x[7]); o.z = pk4_fp8(x[8], x[9], x[10], x[11]); o.w = pk4_fp8(x[12], x[13], x[14], x[15]);
            __builtin_nontemporal_store(o, (u32x4*)(t.dst + row)); } }
    asm volatile("s_waitcnt lgkmcnt(0)" ::: "memory");
}
constexpr int TR_TOTAL = DEPTH * TR_I_ALL;
constexpr int QW_FLAG = 12800;
__device__ __forceinline__ int gemm_wgs(int units, int G) {
    if (G % 8 != 0 || units <= 0) return G;
    const int rounds = (units + G - 1) / G; int g = (units + rounds - 1) / rounds; g = (g + 7) & ~7; return g < G ? g : G;
}
__device__ __forceinline__ int sig_unit(int units, int Gg, int lead) { const int rounds = (units + Gg - 1) / Gg; const int sg = rounds - 1 - lead; return sg > 0 ? sg : 0; }
__device__ __forceinline__ void convert_range(const Params& p, unsigned char* ws, LAS float* scr, int lane, int lo, int hi, int j, int n, int* stop) {
    unsigned char* done = ws + WS_DONE;
    for (int kb = 0; lo + j + kb * n < hi; kb += 64) {
        const int il = lo + j + (kb + lane) * n; const bool inr = il < hi;
        const unsigned char f = inr ? done[il] : (unsigned char)1;
        unsigned long long m = __builtin_amdgcn_ballot_w64(inr && f == 0);
        while (m) {
            if (stop && __builtin_amdgcn_readfirstlane(__hip_atomic_load(stop, __ATOMIC_RELAXED, __HIP_MEMORY_SCOPE_AGENT)) != 0) return;
            const int b0 = __builtin_ctzll(m); m &= m - 1; const int i0 = lo + j + (kb + b0) * n;
            const bool two = m != 0; int i1 = i0;
            if (two) { const int b1 = __builtin_ctzll(m); m &= m - 1; i1 = lo + j + (kb + b1) * n; }
            f32x4 va[16], vb[16]; TrItem ta, tb;
            tr_params(p, ws, i0, ta); tr_load(ta, va, lane);
            if (two) { tr_params(p, ws, i1, tb); tr_load(tb, vb, lane); }
            tr_finish(ta, va, scr, lane); if (lane == 0) done[i0] = 1;
            if (two) { tr_finish(tb, vb, scr, lane); if (lane == 0) done[i1] = 1; }
        }
    }
}
__device__ __forceinline__ void norm_row_f32(const float* __restrict__ xrow, bf16_t* __restrict__ xout, float* __restrict__ rsout, int lane) {
    f32x4 v[8]; float ss = 0.f;
#pragma unroll
    for (int j = 0; j < 8; ++j) { v[j] = __builtin_nontemporal_load((const f32x4*)xrow + 64 * j + lane); ss += (v[j][0] * v[j][0] + v[j][1] * v[j][1]) + (v[j][2] * v[j][2] + v[j][3] * v[j][3]); }
    const float rs = 1.0f / sqrtf(wave_sum(ss) * (1.f / DM) + EPS);
    if (lane == 0) *rsout = rs;
#pragma unroll
    for (int j = 0; j < 8; ++j) { u32x2 w; w.x = cvt_pk_bf16(v[j][0], v[j][1]); w.y = cvt_pk_bf16(v[j][2], v[j][3]); *((u32x2*)xout + 64 * j + lane) = w; }
}
struct RowRegs { u32x4 x[4]; u32x2 a[4], c[4]; };
__device__ __forceinline__ void combine_load(RowRegs& R, const bf16_t* __restrict__ xrow, const unsigned char* __restrict__ y0, const unsigned char* __restrict__ y1, int lane) {
#pragma unroll
    for (int j = 0; j < 4; ++j) { R.x[j] = *((const u32x4*)xrow + 64 * j + lane); R.a[j] = __builtin_nontemporal_load((const u32x2*)y0 + 64 * j + lane); R.c[j] = __builtin_nontemporal_load((const u32x2*)y1 + 64 * j + lane); }
}
__device__ __forceinline__ void combine_finish(const RowRegs& R, bf16_t* __restrict__ xrow, float g0, float g1, float* __restrict__ rsout, float* __restrict__ fout, const float* __restrict__ fgain, int lane) {
    float v[4][8]; float ss = 0.f;
    g0 *= (1.f / pg8::YM_SCALE); g1 *= (1.f / pg8::YM_SCALE);
#pragma unroll
    for (int j = 0; j < 4; ++j) { const u32x4 x = R.x[j];
        const f32x2 a0 = __builtin_amdgcn_cvt_pk_f32_fp8((int)R.a[j].x, false), a1 = __builtin_amdgcn_cvt_pk_f32_fp8((int)R.a[j].x, true), a2 = __builtin_amdgcn_cvt_pk_f32_fp8((int)R.a[j].y, false), a3 = __builtin_amdgcn_cvt_pk_f32_fp8((int)R.a[j].y, true);
        const f32x2 c0 = __builtin_amdgcn_cvt_pk_f32_fp8((int)R.c[j].x, false), c1 = __builtin_amdgcn_cvt_pk_f32_fp8((int)R.c[j].x, true), c2 = __builtin_amdgcn_cvt_pk_f32_fp8((int)R.c[j].y, false), c3 = __builtin_amdgcn_cvt_pk_f32_fp8((int)R.c[j].y, true);
        v[j][0] = bf_lo(x.x) + g0 * a0[0] + g1 * c0[0]; v[j][1] = bf_hi(x.x) + g0 * a0[1] + g1 * c0[1];
        v[j][2] = bf_lo(x.y) + g0 * a1[0] + g1 * c1[0]; v[j][3] = bf_hi(x.y) + g0 * a1[1] + g1 * c1[1];
        v[j][4] = bf_lo(x.z) + g0 * a2[0] + g1 * c2[0]; v[j][5] = bf_hi(x.z) + g0 * a2[1] + g1 * c2[1];
        v[j][6] = bf_lo(x.w) + g0 * a3[0] + g1 * c3[0]; v[j][7] = bf_hi(x.w) + g0 * a3[1] + g1 * c3[1];
#pragma unroll
        for (int i = 0; i < 8; ++i) ss += v[j][i] * v[j][i]; }
    const float rs = 1.0f / sqrtf(wave_sum(ss) * (1.f / DM) + EPS);
#pragma unroll
    for (int j = 0; j < 4; ++j) {
        if (fout) { const f32x4 ga = *((const f32x4*)fgain + 128 * j + 2 * lane), gb = *((const f32x4*)fgain + 128 * j + 2 * lane + 1);
            __builtin_nontemporal_store((f32x4){v[j][0] * rs * ga[0], v[j][1] * rs * ga[1], v[j][2] * rs * ga[2], v[j][3] * rs * ga[3]}, (f32x4*)fout + 128 * j + 2 * lane);
            __builtin_nontemporal_store((f32x4){v[j][4] * rs * gb[0], v[j][5] * rs * gb[1], v[j][6] * rs * gb[2], v[j][7] * rs * gb[3]}, (f32x4*)fout + 128 * j + 2 * lane + 1); }
        else { u32x4 w; w.x = cvt_pk_bf16(v[j][0], v[j][1]); w.y = cvt_pk_bf16(v[j][2], v[j][3]); w.z = cvt_pk_bf16(v[j][4], v[j][5]); w.w = cvt_pk_bf16(v[j][6], v[j][7]);
            *((u32x4*)xrow + 64 * j + lane) = w; } }
    if (!fout && lane == 0) *rsout = rs;
}

__global__ void __launch_bounds__(NTHREADS, 2) fwd_kernel(Params p) {
    extern __shared__ __attribute__((aligned(16))) unsigned char lds_raw[];
    LAS unsigned char* lds = (LAS unsigned char*)lds_raw;
    cg::grid_group grid = cg::this_grid();
    const int G = gridDim.x, bx = blockIdx.x;
    const int lo = p.ph_lo, hi = p.ph_hi;
    int ph = 0;
    const int wave_s = __builtin_amdgcn_readfirstlane((int)threadIdx.x >> 6);
    volatile LAS unsigned* bar_st = (volatile LAS unsigned*)(lds + MISC_OFF + 4096);
    if (threadIdx.x < 2) bar_st[threadIdx.x] = 0u;
    __syncthreads();
#ifdef PROBE_A
    if (bx == 0 && threadIdx.x == 0) ((volatile LAS unsigned long long*)(lds + MISC_OFF + 4352))[0] = __builtin_amdgcn_s_memrealtime();
#endif
    XcdBarrier xbar; xbar.bar = (unsigned*)(p.ws + WS_CTL) + 1024; xbar.x = 0; xbar.st = bar_st;
    if (hi - lo > 1) xbar = xcd_barrier_post((unsigned*)(p.ws + WS_CTL) + 1024, bar_st);
#ifndef PH_MASK
#define PH_MASK 0x7f
#endif
#ifndef DBL_MASK
#define DBL_MASK 0
#endif
#ifndef DBL_L0
#define DBL_L0 0
#endif
#define PHASE_BEGIN(k) if (((PH_MASK >> (k)) & 1) && lo <= ph && ph < hi) { for (int rep_ = 0; rep_ <= (int)(((DBL_MASK >> (k)) & 1) && (!DBL_L0 || l == 0)); ++rep_) { \
    int tid; asm volatile("v_mbcnt_lo_u32_b32 %0, -1, 0\n\tv_mbcnt_hi_u32_b32 %0, -1, %0" : "=v"(tid)); tid += wave_s * 64; unsigned char* ws = p.ws; asm volatile("" : "+s"(ws)); ws = (unsigned char*)(__attribute__((address_space(1))) unsigned char*)ws; \
    const int lane = tid & 63, wave = __builtin_amdgcn_readfirstlane(tid >> 6); \
    const int vcu = (G % 8 == 0) ? (bx % 8) * (G / 8) + bx / 8 : bx; const int gw = vcu * NWAVES + wave, NGW = G * NWAVES; \
    bf16_t* const Ub = (bf16_t*)(ws + WS_U); bf16_t* const YM = (bf16_t*)(ws + WS_U); bf16_t* const Yc = (bf16_t*)(ws + WS_Y); bf16_t* const Hb = (bf16_t*)(ws + WS_H); \
    bf16_t* const HMb = (bf16_t*)(ws + WS_HM); float* const KS = (float*)(ws + WS_KS); float* const RS = (float*)(ws + WS_RS); unsigned* const REC = (unsigned*)(ws + WS_REC); \
    int* const TM = (int*)(ws + WS_TM); int* const CNT = (int*)(ws + WS_CTL); bf16_t* const XB = (bf16_t*)(ws + WS_XB); \
    LAS int* const m_tile_e = (LAS int*)(lds + MISC_OFF); LAS int* const m_tstart = m_tile_e + MAXTILES; LAS int* const m_cnt = m_tstart + 40; \
    unsigned char* const wl = ws + WS_W0 + (size_t)l * SZ_LAYER; int* const cntg = CNT + 8192 + l * 32 * 64;     \
    (void)lane; (void)wave; (void)gw; (void)NGW; (void)Ub; (void)YM; (void)Yc; (void)Hb; (void)HMb; (void)KS; (void)RS; (void)REC; (void)TM; (void)XB; (void)m_tile_e; (void)m_tstart; (void)m_cnt; (void)wl; (void)cntg;
#ifdef PROBE_A
#define STAMP() do { if (bx == 0 && threadIdx.x == 0) { ((volatile LAS unsigned long long*)(lds + MISC_OFF + 4352))[ph + 1] = __builtin_amdgcn_s_memrealtime(); } } while (0)
#else
#define STAMP() do {} while (0)
#endif
#define PHASE_END   } if (ph + 1 < hi) { if (lo < 0) grid.sync();   else xcd_barrier(xbar); } STAMP(); } ++ph;

    { const int l = 0;
    PHASE_BEGIN(0)
    {
        LAS float* scr = (LAS float*)(lds + wave * 16640);
        convert_range(p, ws, scr, lane, 0, TR_I_IN, gw, NGW, nullptr);
        for (int l = 0; l < DEPTH; ++l) {
            unsigned char* wl = ws + WS_W0 + (size_t)l * SZ_LAYER;
            bf16_t* RW = (bf16_t*)(wl + OFF_RW);
            for (int i = vcu * NTHREADS + tid; i < NRW * (DM / 8); i += G * NTHREADS) { const int n = i / (DM / 8), k8 = (i % (DM / 8)) * 8; float v[8];
#pragma unroll
                for (int j = 0; j < 8; ++j) { const int k = k8 + j; const float g = p.in[IN_N2G][l * DM + k];
                    v[j] = n < 4 ? g * p.in[IN_RGW][(size_t)l * DM * 4 + k * 4 + n] : (n < 36 ? g * p.in[IN_REW][(size_t)l * DM * 32 + k * 32 + (n - 4)] : 0.f); }
                u32x4 o; o.x = cvt_pk_bf16(v[0], v[1]); o.y = cvt_pk_bf16(v[2], v[3]); o.z = cvt_pk_bf16(v[4], v[5]); o.w = cvt_pk_bf16(v[6], v[7]);
                *(u32x4*)(RW + (size_t)n * DM + k8) = o; }
        }
        for (int m = gw; m < T_TOK; m += NGW) norm_row_f32(p.in[IN_X] + (size_t)m * DM, XB + (size_t)m * DM, RS + m, lane);
        __syncthreads();
    }
    PHASE_END
    }

    for (int l = 0; l < DEPTH; ++l) {
        PHASE_BEGIN(1)
        {
            const int Gg = gemm_wgs((T_TOK / 256) * (DIN / 256), G); int* const flg = CNT + QW_FLAG + 64 * (l * 4 + 0);
            if (bx >= Gg) convert_range(p, ws, (LAS float*)(lds + wave * 16640), lane, l * TR_I_ALL + TR_I_IN, TR_TOTAL, (bx - Gg) * NWAVES + wave, (G - Gg) * NWAVES, flg);
            else {
            pg8::DenseSched S{(const char*)XB, (const char*)(wl + OFF_WIN), T_TOK / 256, DIN / 256, Gg, bx, DM, flg, sig_unit((T_TOK / 256) * (DIN / 256), Gg, 0)};
            pg8::EpiInProj E{Ub, KS, (float*)(ws + WS_NRM), RS};
            pg8::gemm_phase<2>(lds, wave, DM, S, E); }
        }
        PHASE_END
        PHASE_BEGIN(2)
        {
            convert_range(p, ws, (LAS float*)(lds + wave * 16640), lane, l * TR_I_ALL + TR_I_IN, l * TR_I_ALL + TR_I_IN + TR_I_OUT, gw, NGW, nullptr);
            __syncthreads();
            { const float* NRM = (const float*)(ws + WS_NRM);
              LAS int* bc = (LAS int*)(lds + MISC_OFF + 4224);
              for (int slot_ = vcu; slot_ < 256; slot_ += G) { const int b = slot_ >> 6, sl64 = slot_ & 63;
               for (int pi = 0; pi < att::MAXP; ++pi) {
                const unsigned code = (unsigned)__builtin_amdgcn_readfirstlane((int)att::ATT_ITEMS.v[sl64][pi]);
                if (code == 0xFFFFu) break;
                const int h = code & 7, qb = (code >> 3) & 15, part = (code >> 7) & 1, split = (code >> 8) & 1;
                if (tid < 64) { const int n = lane >> 2, wc = lane & 3;
                    const float* kp = NRM + (size_t)(((64 + b * 16 + n) * 8 + h) * 2) * 4 + wc; float kv = fmaxf(kp[0], kp[4]);
                    kv += SWZ_XOR(kv, 1); kv += SWZ_XOR(kv, 2); if (n > qb) kv = 0.f;
                    kv = fmaxf(kv, SWZ_XOR(kv, 4)); kv = fmaxf(kv, SWZ_XOR(kv, 8)); kv = fmaxf(kv, SWZ_XOR(kv, 16)); kv = half_max(kv);
                    const float* qp = NRM + (size_t)(((b * 16 + qb) * 8 + h) * 2) * 4 + wc; float qv = fmaxf(qp[0], qp[4]);
                    qv += SWZ_XOR(qv, 1); qv += SWZ_XOR(qv, 2);
                    const float bound = att::SCALE * 1.02f * sqrtf(qv) * 2.f * sqrtf(kv) + att::CUT_MARGIN;
                    const float D = bound * exp2f((float)(h + 1));
                    int nb = (int)fminf(floorf((D - 1.f) * (1.f / 256.f)), 64.f);
                    int ns = qb - 1 - nb; ns = ns < 0 ? 0 : ns;
                    if (lane == 0) bc[1] = ns; }
                __syncthreads();
                const int n_start = __builtin_amdgcn_readfirstlane(bc[1]);
                const int n_mid = (qb - 7) > n_start ? (qb - 7) : n_start;
                const bool with_own = (part == 0);
                const int n_lo = split ? (part == 0 ? n_mid : n_start) : n_start, n_hi = split ? (part == 0 ? qb : n_mid) : qb;
                const int slot = split ? ((b * 3 + (h - 5)) * 4 + (qb - 12)) : 0;
#ifdef PROBE_TILES
                if (tid == 0 && l == 0) atomicAdd(&CNT[520], (with_own ? 4 : 0) + 4 * (n_hi - n_lo));
#endif
                att::attn_item(tid, b, h, qb, with_own, n_lo, n_hi, split, slot, l, ws, (char*)lds_raw);
               } } }
#ifndef NO_CONV
            int* const cq = CNT + 12416 + 16 * l; LAS int* qc = (LAS int*)(lds + MISC_OFF + 4240);
            __syncthreads();
            if (tid == 0) qc[0] = __hip_atomic_fetch_add(cq, 1, __ATOMIC_RELAXED, __HIP_MEMORY_SCOPE_AGENT);
            __syncthreads();
            { const float* cw = p.in[IN_CAW] + (size_t)l * 3 * 512;
              for (;;) { const int it = __builtin_amdgcn_readfirstlane(qc[0]); __syncthreads(); if (it >= T_TOK / 64) break;
                if (tid == 0) qc[0] = __hip_atomic_fetch_add(cq, 1, __ATOMIC_RELAXED, __HIP_MEMORY_SCOPE_AGENT);
                const int c8 = (tid & 63) * 8, tg0 = it * 64 + (tid >> 6) * 8, bstart = tg0 & ~(SEQ - 1);
                float w0[8], w1[8], w2[8];
#pragma unroll
                for (int j = 0; j < 8; ++j) { w0[j] = cw[c8 + j]; w1[j] = cw[512 + c8 + j]; w2[j] = cw[1024 + c8 + j]; }
                float z[10][8];
#pragma unroll
                for (int i = 0; i < 10; ++i) { const int tt = tg0 - 2 + i;
                    if (tt >= bstart) { const u32x4 a = *(const u32x4*)(Ub + (size_t)tt * UP + COL_Z + c8);
                        z[i][0] = bf_lo(a.x); z[i][1] = bf_hi(a.x); z[i][2] = bf_lo(a.y); z[i][3] = bf_hi(a.y); z[i][4] = bf_lo(a.z); z[i][5] = bf_hi(a.z); z[i][6] = bf_lo(a.w); z[i][7] = bf_hi(a.w); }
                    else {
#pragma unroll
                        for (int j = 0; j < 8; ++j) z[i][j] = 0.f; } }
#pragma unroll
                for (int o = 0; o < 8; ++o) { const int tt = tg0 + o; const u32x4 bg = *(const u32x4*)(Ub + (size_t)tt * UP + COL_BG + c8); float y[8];
#pragma unroll
                    for (int j = 0; j < 8; ++j) y[j] = w0[j] * z[o][j] + w1[j] * z[o + 1][j] + w2[j] * z[o + 2][j];
                    u32x4 w; w.x = cvt_pk_bf16(bf_lo(bg.x) * y[0], bf_hi(bg.x) * y[1]); w.y = cvt_pk_bf16(bf_lo(bg.y) * y[2], bf_hi(bg.y) * y[3]);
                    w.z = cvt_pk_bf16(bf_lo(bg.z) * y[4], bf_hi(bg.z) * y[5]); w.w = cvt_pk_bf16(bf_lo(bg.w) * y[6], bf_hi(bg.w) * y[7]);
                    *(u32x4*)(Yc + (size_t)tt * DM + c8) = w; }
                __syncthreads(); } }
            { const float* cw = p.in[IN_CCW] + (size_t)l * 31 * 512; const float* cb = p.in[IN_CCB] + l * 512; const float* lg = p.in[IN_LNG] + l * 512; const float* lb = p.in[IN_LNB] + l * 512;
              LAS float* hh = (LAS float*)lds; LAS float* co = hh + 46 * 512;
              for (;;) { const int it = __builtin_amdgcn_readfirstlane(qc[0]) - T_TOK / 64; __syncthreads(); if (it >= T_TOK / 16) break;
                if (tid == 0) qc[0] = __hip_atomic_fetch_add(cq, 1, __ATOMIC_RELAXED, __HIP_MEMORY_SCOPE_AGENT);
                const int t0 = it * 16, bstart = t0 & ~(SEQ - 1);
                { const int c8 = (tid & 63) * 8;
                  for (int i = tid >> 6; i < 46; i += 8) { const int tt = t0 - 30 + i; float v[8];
                    if (tt >= bstart) { const u32x4 a = *(const u32x4*)(Ub + (size_t)tt * UP + COL_HH + c8);
                        v[0] = bf_lo(a.x); v[1] = bf_hi(a.x); v[2] = bf_lo(a.y); v[3] = bf_hi(a.y); v[4] = bf_lo(a.z); v[5] = bf_hi(a.z); v[6] = bf_lo(a.w); v[7] = bf_hi(a.w); }
                    else {
#pragma unroll
                        for (int j = 0; j < 8; ++j) v[j] = 0.f; }
                    *(LAS f32x4*)(hh + i * 512 + c8) = (f32x4){v[0], v[1], v[2], v[3]}; *(LAS f32x4*)(hh + i * 512 + c8 + 4) = (f32x4){v[4], v[5], v[6], v[7]}; } }
                __syncthreads();
                { const int c = tid; float w[31];
#pragma unroll
                  for (int j = 0; j < 31; ++j) w[j] = cw[j * 512 + c];
                  const float bias = cb[c];
                  float win[46];
#pragma unroll
                  for (int i = 0; i < 46; ++i) win[i] = hh[i * 512 + c];
#pragma unroll
                  for (int o = 0; o < 16; ++o) { float a = bias;
#pragma unroll
                      for (int j = 0; j < 31; ++j) a = fmaf(w[j], win[o + j], a);
                      co[o * 512 + c] = a; } }
                __syncthreads();
                { const int c8 = lane * 8;
                  f32x4 ga = *(const f32x4*)(lg + c8), gb = *(const f32x4*)(lg + c8 + 4), ba = *(const f32x4*)(lb + c8), bb = *(const f32x4*)(lb + c8 + 4);
#pragma unroll
                  for (int q = 0; q < 2; ++q) { const int o = wave * 2 + q; const f32x4 xa = *(const LAS f32x4*)(co + o * 512 + c8), xb = *(const LAS f32x4*)(co + o * 512 + c8 + 4);
                    const float mu = wave_sum((xa[0] + xa[1]) + (xa[2] + xa[3]) + (xb[0] + xb[1]) + (xb[2] + xb[3])) * (1.f / 512.f);
                    const f32x4 da = xa - mu, db = xb - mu;
                    const float var = wave_sum((da[0] * da[0] + da[1] * da[1]) + (da[2] * da[2] + da[3] * da[3]) + (db[0] * db[0] + db[1] * db[1]) + (db[2] * db[2] + db[3] * db[3])) * (1.f / 512.f);
                    const float rstd = 1.0f / sqrtf(var + EPS);
                    f32x4 ya = da * rstd * ga + ba, yb = db * rstd * gb + bb;
#pragma unroll
                    for (int j = 0; j < 4; ++j) { ya[j] = ya[j] * fast_sigmoid(ya[j]); yb[j] = yb[j] * fast_sigmoid(yb[j]); }
                    u32x4 w; w.x = cvt_pk_bf16(ya[0], ya[1]); w.y = cvt_pk_bf16(ya[2], ya[3]); w.z = cvt_pk_bf16(yb[0], yb[1]); w.w = cvt_pk_bf16(yb[2], yb[3]);
                    *(u32x4*)(Yc + (size_t)(t0 + o) * DM + 1536 + c8) = w; } }
                __syncthreads();
              } }
#endif
        }
        PHASE_END
        PHASE_BEGIN(3)
        {

#ifdef ATT_CHECK
            if (l == ATT_CHECK) {
                LAS float* qs = (LAS float*)(lds + wave * 4608); LAS float* ps = qs + 128;
                const float SC = 0.088388347648318440f;
                for (int sidx = gw; sidx < 4096; sidx += NGW) {
                    const int b = sidx & 3, h = (sidx >> 2) & 7; const int t = (int)((((unsigned)sidx * 2654435761u) >> 12) & 4095u);
                    const int qblk = t >> 8; const float slope = exp2f(-(float)(h + 1));
                    const bf16_t* urow = Ub + (size_t)(b * SEQ + t) * UP;
                    for (int d = lane; d < 128; d += 64) qs[d] = __uint_as_float((unsigned)urow[COL_Q + h * HD + d] << 16) * SC;
                    asm volatile("s_waitcnt lgkmcnt(0)" ::: "memory");
                    float gate[16];
#pragma unroll
                    for (int n = 0; n < 16; ++n) gate[n] = -1e30f;
                    for (int n = 0; n < qblk; ++n) { float sacc = 0.f;
                        for (int kk = lane; kk < 256; kk += 64) { const bf16_t* kr = Ub + (size_t)(b * SEQ + n * 256 + kk) * UP + COL_K + h * HD; float dsum = 0.f;
                            for (int c = 0; c < 16; ++c) { const u32x4 w = *(const u32x4*)(kr + 8 * c);
                                dsum += qs[8 * c] * bf_lo(w.x) + qs[8 * c + 1] * bf_hi(w.x) + qs[8 * c + 2] * bf_lo(w.y) + qs[8 * c + 3] * bf_hi(w.y) + qs[8 * c + 4] * bf_lo(w.z) + qs[8 * c + 5] * bf_hi(w.z) + qs[8 * c + 6] * bf_lo(w.w) + qs[8 * c + 7] * bf_hi(w.w); }
                            sacc += dsum; }
                        const float gsum = wave_sum(sacc) * (1.f / 256.f);
#pragma unroll
                        for (int m = 0; m < 16; ++m) if (m == n) gate[m] = gsum; }
                    int sel[3] = {-1, -1, -1}; float sv[4] = {-1e30f, -1e30f, -1e30f, -1e30f};
                    { float gcopy[16];
#pragma unroll
                      for (int n = 0; n < 16; ++n) gcopy[n] = gate[n];
                      for (int it = 0; it < 4; ++it) { float best = gcopy[0]; int bi = 0;
#pragma unroll
                          for (int n = 1; n < 16; ++n) if (gcopy[n] > best) { best = gcopy[n]; bi = n; }
                          if (it < 3) sel[it] = bi; sv[it] = best;
#pragma unroll
                          for (int n = 0; n < 16; ++n) if (n == bi) gcopy[n] = -3e38f; } }
                    const int nsel = qblk < 3 ? qblk : 3;
                    const bool neartie = (qblk > 3) && (sv[2] - sv[3] < 1.5e-3f);
                    float mx = -1e30f;
                    for (int r = 0; r < 4; ++r) { const bool own = (r == 3); const int blkn = own ? qblk : sel[r]; const bool valid = own || r < nsel;
                        for (int kk = lane; kk < 256; kk += 64) { float lg = -1e30f;
                            if (valid) { const int kpos = blkn * 256 + kk;
                                if (!own || kpos <= t) { const bf16_t* kr = Ub + (size_t)(b * SEQ + kpos) * UP + COL_K + h * HD; float dsum = 0.f;
                                    for (int c = 0; c < 16; ++c) { const u32x4 w = *(const u32x4*)(kr + 8 * c);
                                        dsum += qs[8 * c] * bf_lo(w.x) + qs[8 * c + 1] * bf_hi(w.x) + qs[8 * c + 2] * bf_lo(w.y) + qs[8 * c + 3] * bf_hi(w.y) + qs[8 * c + 4] * bf_lo(w.z) + qs[8 * c + 5] * bf_hi(w.z) + qs[8 * c + 6] * bf_lo(w.w) + qs[8 * c + 7] * bf_hi(w.w); }
                                    lg = dsum - slope * (float)(t - kpos); } }
                            ps[r * 256 + kk] = lg; mx = fmaxf(mx, lg); } }
#pragma unroll
                    for (int o = 1; o < 64; o <<= 1) mx = fmaxf(mx, __shfl_xor(mx, o));
                    float se = 0.f;
                    for (int i = lane; i < 1024; i += 64) { const float e = (ps[i] > -1e29f) ? __expf(ps[i] - mx) : 0.f; ps[i] = e; se += e; }
                    se = wave_sum(se);
                    asm volatile("s_waitcnt lgkmcnt(0)" ::: "memory");
                    float o0 = 0.f, o1 = 0.f;
                    for (int r = 0; r < 4; ++r) { const bool own = (r == 3); const int blkn = own ? qblk : sel[r]; const bool valid = own || r < nsel;
                        if (valid) for (int kk = 0; kk < 256; ++kk) { const float pp = ps[r * 256 + kk];
                            if (pp != 0.f) { const unsigned w = *(const unsigned*)(Ub + (size_t)(b * SEQ + blkn * 256 + kk) * UP + COL_V + h * HD + 2 * lane); o0 += pp * bf_lo(w); o1 += pp * bf_hi(w); } } }
                    o0 /= se; o1 /= se;
                    const unsigned yw = *(const unsigned*)(Yc + (size_t)(b * SEQ + t) * DM + 512 + h * HD + 2 * lane);
                    float err = fmaxf(fabsf(o0 - bf_lo(yw)), fabsf(o1 - bf_hi(yw))), ref = fmaxf(fabsf(o0), fabsf(o1));
                    const bool isnan_ = !(err == err);
#pragma unroll
                    for (int o = 1; o < 64; o <<= 1) { err = fmaxf(err, __shfl_xor(err, o)); ref = fmaxf(ref, __shfl_xor(ref, o)); }
                    const bool bad = __any(isnan_) || !(err <= 0.03f * ref + 1e-4f);
                    if (lane == 0) { if (neartie) atomicAdd(&CNT[514], 1); else { atomicAdd(&CNT[513], 1); if (bad) atomicAdd(&CNT[512], 1); } }
                    asm volatile("s_waitcnt lgkmcnt(0)" ::: "memory");
                }
                __syncthreads();
            }
#endif
            pg8::DenseSched S{(const char*)Yc, (const char*)(wl + OFF_WOUT), T_TOK / 256, DM / 256, G, bx, DM, nullptr, 0};
            pg8::EpiResBf16 E{nullptr, XB};
            pg8::gemm_phase<2>(lds, wave, DM, S, E);
        }
        PHASE_END
        PHASE_BEGIN(4)
        {
            convert_range(p, ws, (LAS float*)(lds + wave * 16640), lane, l * TR_I_ALL + TR_I_IN + TR_I_OUT, (l + 1) * TR_I_ALL, gw, NGW, nullptr);
            __syncthreads();
            const bf16_t* RW = (const bf16_t*)(wl + OFF_RW);
            const float* rgb = p.in[IN_RGB] + l * 4; const float* reb = p.in[IN_REB] + l * 32;
            LAS float* part = (LAS float*)lds;
            LAS float* ssp = part + 8 * 64 * 49;
            LAS float* lgr = ssp + 8 * 64;
            LAS float* rsr = lgr + 64 * 49;
            const int r16 = lane & 15, q = lane >> 4;
            bf16x8 rwf[8][3];
#pragma unroll
            for (int ks = 0; ks < 8; ++ks)
#pragma unroll
                for (int nb = 0; nb < 3; ++nb) rwf[ks][nb] = *reinterpret_cast<const bf16x8*>(RW + (size_t)(nb * 16 + r16) * DM + wave * 256 + ks * 32 + 8 * q);
            for (int it = vcu; it < T_TOK / 64; it += G) {
#pragma unroll 1
                for (int rg = 0; rg < 4; ++rg) {
                    const int row = it * 64 + rg * 16 + r16;
                    const bf16_t* xr = XB + (size_t)row * DM + wave * 256 + 8 * q; unsigned char* x8r = ws + WS_X8 + (size_t)row * DM + wave * 256 + 8 * q;
                    u32x4 xw[8];
#pragma unroll
                    for (int ks = 0; ks < 8; ++ks) xw[ks] = *(const u32x4*)(xr + ks * 32);
                    f32x4 acc[3] = {(f32x4){0.f, 0.f, 0.f, 0.f}, (f32x4){0.f, 0.f, 0.f, 0.f}, (f32x4){0.f, 0.f, 0.f, 0.f}}; float ss = 0.f;
#pragma unroll
                    for (int ks = 0; ks < 8; ++ks) { const u32x4 w = xw[ks];
                        const float a0 = bf_lo(w.x), a1 = bf_hi(w.x), a2 = bf_lo(w.y), a3 = bf_hi(w.y), a4 = bf_lo(w.z), a5 = bf_hi(w.z), a6 = bf_lo(w.w), a7 = bf_hi(w.w);
                        ss += (a0 * a0 + a1 * a1) + (a2 * a2 + a3 * a3) + (a4 * a4 + a5 * a5) + (a6 * a6 + a7 * a7);
                        { int w0 = 0, w1 = 0;
                          w0 = __builtin_amdgcn_cvt_pk_fp8_f32(__builtin_amdgcn_fmed3f(a0, -400.f, 400.f), __builtin_amdgcn_fmed3f(a1, -400.f, 400.f), w0, false); w0 = __builtin_amdgcn_cvt_pk_fp8_f32(__builtin_amdgcn_fmed3f(a2, -400.f, 400.f), __builtin_amdgcn_fmed3f(a3, -400.f, 400.f), w0, true);
                          w1 = __builtin_amdgcn_cvt_pk_fp8_f32(__builtin_amdgcn_fmed3f(a4, -400.f, 400.f), __builtin_amdgcn_fmed3f(a5, -400.f, 400.f), w1, false); w1 = __builtin_amdgcn_cvt_pk_fp8_f32(__builtin_amdgcn_fmed3f(a6, -400.f, 400.f), __builtin_amdgcn_fmed3f(a7, -400.f, 400.f), w1, true);
                          *(u32x2*)(x8r + ks * 32) = (u32x2){(unsigned)w0, (unsigned)w1}; }
                        const bf16x8 a = *reinterpret_cast<const bf16x8*>(&w);
#pragma unroll
                        for (int nb = 0; nb < 3; ++nb) acc[nb] = __builtin_amdgcn_mfma_f32_16x16x32_bf16(a, rwf[ks][nb], acc[nb], 0, 0, 0); }
                    ss += SWZ_XOR(ss, 16); ss = half_sum(ss);
                    if (q == 0) ssp[wave * 64 + rg * 16 + r16] = ss;
#pragma unroll
                    for (int nb = 0; nb < 3; ++nb)
#pragma unroll
                        for (int r = 0; r < 4; ++r) part[(wave * 64 + rg * 16 + 4 * q + r) * 49 + nb * 16 + r16] = acc[nb][r];
                }
                __syncthreads();
                for (int i = tid; i < 64 * 48; i += NTHREADS) { const int r = i / 48, c = i - r * 48; float a = 0.f;
#pragma unroll
                    for (int w = 0; w < 8; ++w) a += part[(w * 64 + r) * 49 + c];
                    lgr[r * 49 + c] = a; }
                if (tid < 64) { float a = 0.f;
#pragma unroll
                    for (int w = 0; w < 8; ++w) a += ssp[w * 64 + tid];
                    rsr[tid] = 1.0f / sqrtf(a * (1.f / DM) + EPS); }
                __syncthreads();
                if (tid < 64) {
                    const int row = it * 64 + tid; const float rs = rsr[tid];
                    const LAS float* lr = lgr + tid * 49;
                    float gl[4];
#pragma unroll
                    for (int j = 0; j < 4; ++j) gl[j] = lr[j] * rs + rgb[j];
                    int grp = 0; float gm = gl[0];
#pragma unroll
                    for (int j = 1; j < 4; ++j) if (gl[j] > gm) { gm = gl[j]; grp = j; }
                    float gsum = 0.f;
#pragma unroll
                    for (int j = 0; j < 4; ++j) gsum += __expf(gl[j] - gm);
                    const float pgrp = 1.0f / gsum;
                    float el[8];
#pragma unroll
                    for (int j = 0; j < 8; ++j) el[j] = lr[4 + grp * 8 + j] * rs + reb[grp * 8 + j];
                    int i1 = 0; float m1 = el[0];
#pragma unroll
                    for (int j = 1; j < 8; ++j) if (el[j] > m1) { m1 = el[j]; i1 = j; }
                    int i2 = -1; float m2 = -INFINITY;
#pragma unroll
                    for (int j = 0; j < 8; ++j) if (j != i1 && el[j] > m2) { m2 = el[j]; i2 = j; }
                    const float e2 = __expf(m2 - m1), inv = 1.0f / (1.0f + e2);
                    const float g1 = pgrp * inv, g2 = pgrp * e2 * inv;
                    const int E1 = grp * 8 + i1, E2 = grp * 8 + i2;
                    LAS int* hist = (LAS int*)(rsr + 64); LAS int* hbase = hist + 32;
                    if (tid < 32) hist[tid] = 0;
                    asm volatile("s_waitcnt lgkmcnt(0)" ::: "memory");
                    const int rk1 = __hip_atomic_fetch_add(&hist[E1], 1, __ATOMIC_RELAXED, __HIP_MEMORY_SCOPE_WORKGROUP);
                    const int rk2 = __hip_atomic_fetch_add(&hist[E2], 1, __ATOMIC_RELAXED, __HIP_MEMORY_SCOPE_WORKGROUP);
                    asm volatile("s_waitcnt lgkmcnt(0)" ::: "memory");
                    if (tid < 32) { const int hc = hist[tid]; hbase[tid] = hc > 0 ? atomicAdd(&cntg[tid * 64], hc) : 0; }
                    asm volatile("s_waitcnt vmcnt(0) lgkmcnt(0)" ::: "memory");
                    const int pos1 = hbase[E1] + rk1, pos2 = hbase[E2] + rk2;
                    TM[E1 * T_TOK + pos1] = row; TM[E2 * T_TOK + pos2] = row;
                    u32x4 ra = {(unsigned)E1, (unsigned)pos1, (unsigned)E2, (unsigned)pos2}; u32x4 rb = {__float_as_uint(g1), __float_as_uint(g2), 0u, 0u};
                    *(u32x4*)(REC + (size_t)row * 8) = ra; *(u32x4*)(REC + (size_t)row * 8 + 4) = rb;
                    RS[row] = rs;
                }
                __syncthreads();
            }
        }
        PHASE_END
        for (int pass = 0; pass < 2; ++pass) {
            PHASE_BEGIN(5)
            {
                if (tid < 64) { const int c = tid < NEXP ? __hip_atomic_load(&cntg[tid * 64], __ATOMIC_RELAXED, __HIP_MEMORY_SCOPE_AGENT) : 0; const int nt_ = (c + 255) >> 8; int incl = nt_;
#pragma unroll
                    for (int o = 1; o < 64; o <<= 1) { const int v = __builtin_amdgcn_ds_bpermute((lane - o) << 2, incl); if (lane >= o) incl += v; }
                    const int st = incl - nt_;
                    if (tid < NEXP) { m_tstart[tid] = st; m_cnt[tid] = c; for (int k = 0; k < nt_; ++k) m_tile_e[st + k] = tid; }
                    if (tid == NEXP) m_tstart[NEXP] = st; }
                __syncthreads();
                const int nM = m_tstart[NEXP];
#ifndef PASS_MASK
#define PASS_MASK 3
#endif
                const int Gg = gemm_wgs(nM * (pass == 0 ? 1024 / 256 : DM / 256), G); int* const flg = CNT + QW_FLAG + 64 * (l * 4 + 1 + pass);
                if (bx >= Gg) convert_range(p, ws, (LAS float*)(lds + wave * 16640), lane, (l + 1) * TR_I_ALL, TR_TOTAL, (bx - Gg) * NWAVES + wave, (G - Gg) * NWAVES, flg);
                else if ((PASS_MASK & 1) && pass == 0) {
                    pg8::MoeSched S{(const char*)(ws + WS_X8), (const char*)(wl + OFF_WGU), (size_t)1024 * DM, nM, 1024 / 256, Gg, bx, DM, true, m_tile_e, m_tstart, m_cnt, TM, 1, flg, sig_unit(nM * (1024 / 256), Gg, 0)};
                    pg8::EpiSwiglu E{(unsigned char*)HMb, RS, TM, m_tstart, m_cnt};
                    pg8::gemm_phase<1>(lds, wave, DM, S, E);
                } else if (PASS_MASK & 2) {
                    pg8::MoeSched S{(const char*)HMb, (const char*)(wl + OFF_WD), (size_t)DM * DEXP, nM, DM / 256, Gg, bx, DEXP, false, m_tile_e, m_tstart, m_cnt, TM, 1, flg, sig_unit(nM * (DM / 256), Gg, 3)};
                    pg8::EpiFp8 E{(unsigned char*)YM, DM, pg8::YM_SCALE / (HM_SCALE * W2_SCALE)};
                    pg8::gemm_phase<1>(lds, wave, DEXP, S, E);
                }
                __syncthreads();
            }
            PHASE_END
        }
        PHASE_BEGIN(6)
        {
            if (l + 1 < DEPTH) { convert_range(p, ws, (LAS float*)(lds + wave * 16640), lane, (l + 1) * TR_I_ALL, (l + 1) * TR_I_ALL + TR_I_IN, gw, NGW, nullptr); __syncthreads(); }
            int tst; { const int c = lane < NEXP ? __hip_atomic_load(&cntg[lane * 64], __ATOMIC_RELAXED, __HIP_MEMORY_SCOPE_AGENT) : 0; const int nt_ = (c + 255) >> 8; int incl = nt_;
#pragma unroll
                for (int o = 1; o < 64; o <<= 1) { const int v = __builtin_amdgcn_ds_bpermute((lane - o) << 2, incl); if (lane >= o) incl += v; }
                tst = incl - nt_; }
            const bool fin = (l == DEPTH - 1);
            u32x4 ra_n = (u32x4){0u, 0u, 0u, 0u}; u32x2 rb_n = (u32x2){0u, 0u};
            if (gw < T_TOK) { ra_n = *(const u32x4*)(REC + (size_t)gw * 8); rb_n = *(const u32x2*)(REC + (size_t)gw * 8 + 4); }
            for (int m = gw; m < T_TOK; m += NGW) {
                const u32x4 ra = ra_n; const u32x2 rb = rb_n;
                if (m + NGW < T_TOK) { ra_n = *(const u32x4*)(REC + (size_t)(m + NGW) * 8); rb_n = *(const u32x2*)(REC + (size_t)(m + NGW) * 8 + 4); }
                const int r0 = __builtin_amdgcn_ds_bpermute((int)ra.x << 2, tst) * 256 + (int)ra.y, r1 = __builtin_amdgcn_ds_bpermute((int)ra.z << 2, tst) * 256 + (int)ra.w;
                RowRegs RR; combine_load(RR, XB + (size_t)m * DM, (const unsigned char*)YM + (size_t)r0 * DM, (const unsigned char*)YM + (size_t)r1 * DM, lane);
                combine_finish(RR, XB + (size_t)m * DM, __uint_as_float(rb.x), __uint_as_float(rb.y), RS + m, fin ? p.out + (size_t)m * DM : nullptr, p.in[IN_FG], lane);
            }
        }
        PHASE_END
    }
#ifdef PROBE_A
    { __syncthreads(); grid.sync(); if (bx == 0 && threadIdx.x == 0) { volatile LAS unsigned long long* tsp = (volatile LAS unsigned long long*)(lds + MISC_OFF + 4352);
        const float ta = (float)(tsp[PROBE_A + 1] - tsp[PROBE_A]) * 0.01f, tb = (float)(tsp[PROBE_B + 1] - tsp[PROBE_B]) * 0.01f;
        (void)tb; p.out[0] += 40.f * rintf((ta - PROBE_OFS) * 0.025f) + PROBE_OFS; } }
#endif
#ifdef PROBE_TILES
    { __syncthreads(); grid.sync(); if (bx == 0 && threadIdx.x == 0) { int* CNTd = (int*)(p.ws + WS_CTL); p.out[0] += (float)CNTd[520] * 0.01f; } }
#endif
#ifdef ATT_CHECK
    { grid.sync(); if (bx == 0 && threadIdx.x == 0) { int* CNTd = (int*)(p.ws + WS_CTL); const int bad = CNTd[512], tot = CNTd[513], nt_ = CNTd[514];
        float A = 10.f + 1000.f * (float)bad / (float)(tot > 0 ? tot : 1);
#if ATT_REPORT == 1
        A = 10.f + 1000.f * (float)nt_ / 4096.f;
#endif
        p.out[0] += A; } }
#endif
#undef PHASE_BEGIN
#undef PHASE_END
}

constexpr int N_PHASES = 1 + 7 * DEPTH;

extern "C" void kernel_launch(void* const* d_in, const int* in_sizes, int n_in, void* d_out, int out_size, void* d_ws, size_t ws_size, hipStream_t stream) {
    static int grid = 0;
    if (grid == 0) {
        if (n_in != 18 || in_sizes[0] != T_TOK * DM || out_size != T_TOK * DM || ws_size < WS_END) {
            fprintf(stderr, "kernel_launch: unexpected shapes: n_in %d in0 %d out %d ws %zu (need >= %zu)\n", n_in, n_in > 0 ? in_sizes[0] : -1, out_size, ws_size, (size_t)WS_END); grid = -1; return; }
        int dev = 0, cus = 0, per_cu = 0;
        hipGetDevice(&dev); hipDeviceGetAttribute(&cus, hipDeviceAttributeMultiprocessorCount, dev);
        if (hipFuncSetAttribute((const void*)fwd_kernel, hipFuncAttributeMaxDynamicSharedMemorySize, LDS_BYTES) != hipSuccess) { fprintf(stderr, "kernel_launch: hipFuncSetAttribute failed\n"); grid = -1; return; }
        if (hipOccupancyMaxActiveBlocksPerMultiprocessor(&per_cu, (const void*)fwd_kernel, NTHREADS, LDS_BYTES) != hipSuccess || per_cu < 1) { fprintf(stderr, "kernel_launch: occupancy query says %d blocks/CU\n", per_cu); per_cu = 1; }
        (void)hipGetLastError();
        grid = cus;
        if (grid > 256) grid = 256;
    }
    if (grid < 0) return;
    hipMemsetAsync((char*)d_ws + WS_CTL, 0, CTL_BYTES, stream);
    Params p{};
    for (int i = 0; i < 18; ++i) p.in[i] = (const float*)d_in[i];
    p.out = (float*)d_out; p.ws = (unsigned char*)d_ws;
#if MK_N_LAUNCHES == 1
    p.ph_lo = 0; p.ph_hi = N_PHASES;
    void* args[] = {&p};
    hipError_t e = hipLaunchCooperativeKernel((const void*)fwd_kernel, dim3(grid), dim3(NTHREADS), args, LDS_BYTES, stream);
    if (e != hipSuccess) fprintf(stderr, "kernel_launch: cooperative launch failed: %s (grid %d)\n", hipGetErrorString(e), grid);
#else
    for (int ph = 0; ph < N_PHASES; ++ph) { p.ph_lo = ph; p.ph_hi = ph + 1;
        hipLaunchKernelGGL(fwd_kernel, dim3(grid), dim3(NTHREADS), LDS_BYTES, stream, p); }
    hipError_t e = hipPeekAtLastError();
    if (e != hipSuccess) fprintf(stderr, "kernel_launch: launch failed: %s\n", hipGetErrorName(e));
#endif
}
```
